# Optimizing an MI355X kernel written in HIP

```python
import math
import jax, jax.numpy as jnp
from jax import lax
import numpy as np


D_MODEL = 1024
BATCH = 8
SEQ = 2048
DEPTH = 4
DEC_BATCH = 32
DEC_SEQ = 8
PAST_LEN = 8192
PAGE_SIZE = 128

MIX_WIDTH = D_MODEL
ATTN_WIDTH = MIX_WIDTH // 2
SSM_WIDTH = MIX_WIDTH - ATTN_WIDTH
HEAD_DIM = 64
N_HEADS = ATTN_WIDTH // HEAD_DIM
BRANCHES = ((128, 1), (512, 4), (2048, 16))
WIN_MAX = max(w for w, _ in BRANCHES)
SSM_GROUP_CH = 16
N_SSM_GROUPS = SSM_WIDTH // SSM_GROUP_CH
STATE_N = 64
D_FF = ((-(-8 * D_MODEL // 3) + 255) // 256) * 256
IN_WIDTH = 3 * ATTN_WIDTH + SSM_WIDTH
EPS = 1e-6
LAMBDA_RE_MAX = -1e-4

kernel_name = 'hymba_dilated_attn_s5_decoder_step'

F32 = jnp.float32


def rmsnorm(x, g):
    xf = x.astype(F32)
    y = xf * lax.rsqrt(jnp.mean(xf * xf, axis=-1, keepdims=True) + EPS)
    return (y * g.astype(F32)).astype(x.dtype)


def _branch_prompt(q, k, v, window, dil):
    b, s, h, e = q.shape
    n = window // dil
    L = s // dil
    nb = -(-L // n)
    lp = nb * n

    def sub(t):
        t = t.reshape(b, L, dil, h, e).transpose(0, 2, 1, 3, 4)
        t = jnp.pad(t, ((0, 0), (0, 0), (0, lp - L), (0, 0), (0, 0)))
        return t.reshape(b, dil, nb, n, h, e)

    def with_prev(t):
        prev = jnp.pad(t, ((0, 0), (0, 0), (1, 0), (0, 0), (0, 0), (0, 0)))[:, :, :-1]
        return jnp.concatenate([prev, t], axis=3)

    qs = sub(q)
    kk = with_prev(sub(k))
    vv = with_prev(sub(v)).astype(F32)
    scores = jnp.einsum('brcqhe,brckhe->brchqk', qs, kk, preferred_element_type=F32) * (HEAD_DIM ** -0.5)
    qi = jnp.arange(n)[:, None]
    ki = jnp.arange(2 * n)[None, :]
    dist = qi + n - ki
    band = (dist >= 0) & (dist <= n)
    has_prev = (jnp.arange(nb) > 0)[:, None, None] | (ki >= n)[None]
    mask = band[None] & has_prev
    scores = jnp.where(mask[None, None, :, None], scores, -jnp.inf)
    m = jnp.max(scores, axis=-1, keepdims=True)
    p = jnp.exp(scores - m)
    den = jnp.sum(p, axis=-1, keepdims=True)
    lse = (m + jnp.log(den))[..., 0]
    out = jnp.einsum('brchqk,brckhe->brcqhe', p / den, vv)
    out = out.reshape(b, dil, lp, h, e)[:, :, :L].transpose(0, 2, 1, 3, 4).reshape(b, s, h, e)
    lse = lse.transpose(0, 1, 2, 4, 3).reshape(b, dil, lp, h)[:, :, :L].transpose(0, 2, 1, 3).reshape(b, s, h)
    return out, lse


def _branch_sample(q, k_all, v_all, window, dil):
    b, t, h, e = q.shape
    lbuf = k_all.shape[1] - t
    n = window // dil
    idx = lbuf + jnp.arange(t)[:, None] - dil * jnp.arange(n + 1)[None, :]
    valid = idx >= 0
    idx = jnp.maximum(idx, 0)
    kg = k_all[:, idx]
    vg = v_all[:, idx].astype(F32)
    scores = jnp.einsum('bthe,btkhe->bhtk', q, kg, preferred_element_type=F32) * (HEAD_DIM ** -0.5)
    scores = jnp.where(valid[None, None], scores, -jnp.inf)
    m = jnp.max(scores, axis=-1, keepdims=True)
    p = jnp.exp(scores - m)
    den = jnp.sum(p, axis=-1, keepdims=True)
    lse = (m + jnp.log(den))[..., 0].transpose(0, 2, 1)
    out = jnp.einsum('bhtk,btkhe->bthe', p / den, vg)
    return out, lse


def _combine_branches(outs, lses):
    w = jax.nn.softmax(jnp.stack(lses, axis=0), axis=0)
    return jnp.sum(w[..., None] * jnp.stack(outs, axis=0), axis=0)


def _cmul_combine(e1, e2):
    a1r, a1i, b1r, b1i = e1
    a2r, a2i, b2r, b2i = e2
    ar = a1r * a2r - a1i * a2i
    ai = a1r * a2i + a1i * a2r
    br = a2r * b1r - a2i * b1i + b2r
    bi = a2r * b1i + a2i * b1r + b2i
    return ar, ai, br, bi


def _s5(u, h0_re, h0_im, a_re, a_im, log_dt, b_re, b_im, c_re, c_im, d_skip, glu_w, glu_b):
    bsz, t, _ = u.shape
    uf = u.astype(F32).reshape(bsz, t, N_SSM_GROUPS, SSM_GROUP_CH)
    lam_re = jnp.minimum(a_re.astype(F32), LAMBDA_RE_MAX)
    lam_im = a_im.astype(F32)
    dt = jnp.exp(log_dt.astype(F32))[:, None]
    mag = jnp.exp(lam_re * dt)
    ab_re = mag * jnp.cos(lam_im * dt)
    ab_im = mag * jnp.sin(lam_im * dt)
    den = lam_re * lam_re + lam_im * lam_im
    f_re = ((ab_re - 1.0) * lam_re + ab_im * lam_im) / den
    f_im = (ab_im * lam_re - (ab_re - 1.0) * lam_im) / den
    br = b_re.astype(F32)
    bi = b_im.astype(F32)
    bb_re = f_re[..., None] * br - f_im[..., None] * bi
    bb_im = f_re[..., None] * bi + f_im[..., None] * br
    bu_re = jnp.einsum('btgc,gnc->btgn', uf, bb_re)
    bu_im = jnp.einsum('btgc,gnc->btgn', uf, bb_im)
    h0r = h0_re.astype(F32)
    h0i = h0_im.astype(F32)
    bu_re = bu_re.at[:, 0].add(ab_re * h0r - ab_im * h0i)
    bu_im = bu_im.at[:, 0].add(ab_re * h0i + ab_im * h0r)
    a_r = jnp.broadcast_to(ab_re, bu_re.shape)
    a_i = jnp.broadcast_to(ab_im, bu_im.shape)
    _, _, h_re, h_im = lax.associative_scan(_cmul_combine, (a_r, a_i, bu_re, bu_im), axis=1)
    y = (jnp.einsum('btgn,gcn->btgc', h_re, c_re.astype(F32))
         - jnp.einsum('btgn,gcn->btgc', h_im, c_im.astype(F32))
         + d_skip.astype(F32) * uf)
    y = y.reshape(bsz, t, SSM_WIDTH)
    z = jax.nn.gelu(y)
    out = z * jax.nn.sigmoid(z @ glu_w.astype(F32) + glu_b.astype(F32))
    return out, h_re[:, -1], h_im[:, -1]


def _layer(x, k_buf, v_buf, h0_re, h0_im, norm1_g, w_in, attn_out_g, a_re, a_im, log_dt,
           b_re, b_im, c_re, c_im, d_skip, glu_w, glu_b, ssm_out_g, w_out, norm2_g,
           w_gate, w_up, w_down):
    b, t, _ = x.shape
    xn = rmsnorm(x, norm1_g)
    z = xn @ w_in
    q = z[..., :ATTN_WIDTH].reshape(b, t, N_HEADS, HEAD_DIM)
    k = z[..., ATTN_WIDTH:2 * ATTN_WIDTH].reshape(b, t, N_HEADS, HEAD_DIM)
    v = z[..., 2 * ATTN_WIDTH:3 * ATTN_WIDTH].reshape(b, t, N_HEADS, HEAD_DIM)
    u = z[..., 3 * ATTN_WIDTH:]
    if k_buf is None:
        res = [_branch_prompt(q, k, v, w, d) for (w, d) in BRANCHES]
        new_k = k[:, -WIN_MAX:]
        new_v = v[:, -WIN_MAX:]
    else:
        k_all = jnp.concatenate([k_buf.astype(k.dtype), k], axis=1)
        v_all = jnp.concatenate([v_buf.astype(v.dtype), v], axis=1)
        res = [_branch_sample(q, k_all, v_all, w, d) for (w, d) in BRANCHES]
        new_k = k
        new_v = v
    attn = _combine_branches([r[0] for r in res], [r[1] for r in res])
    attn = attn.reshape(b, t, ATTN_WIDTH).astype(x.dtype)
    ssm, h_re, h_im = _s5(u, h0_re, h0_im, a_re, a_im, log_dt, b_re, b_im, c_re, c_im,
                          d_skip, glu_w, glu_b)
    ssm = ssm.astype(x.dtype)
    mixed = jnp.concatenate([rmsnorm(attn, attn_out_g), rmsnorm(ssm, ssm_out_g)], axis=-1) @ w_out
    h = x + mixed
    hn = rmsnorm(h, norm2_g)
    y = h + (jax.nn.silu(hn @ w_gate) * (hn @ w_up)) @ w_down
    return y, new_k, new_v, h_re, h_im


def setup_inputs(seed: int = 0) -> dict:
    key = jax.random.key(seed)
    ks = jax.random.split(key, 32)

    def nrm(k, shape, scale):
        return jax.random.normal(k, shape, F32) * scale

    lbuf = min(WIN_MAX, PAST_LEN)
    G, N, C = N_SSM_GROUPS, STATE_N, SSM_GROUP_CH
    a_im = (jnp.pi * jnp.arange(N, dtype=F32))[None, None, :] + nrm(ks[8], (DEPTH, G, N), 0.01)
    return {
        'x_prompt': nrm(ks[0], (BATCH, SEQ, D_MODEL), 1.0),
        'x_sample': nrm(ks[1], (DEC_BATCH, DEC_SEQ, D_MODEL), 1.0),
        'cache_attn_k': nrm(ks[2], (DEPTH, DEC_BATCH, lbuf, N_HEADS, HEAD_DIM), 1.0),
        'cache_attn_v': nrm(ks[3], (DEPTH, DEC_BATCH, lbuf, N_HEADS, HEAD_DIM), 1.0),
        'state_ssm_re': nrm(ks[4], (DEPTH, DEC_BATCH, G, N), 1.0),
        'state_ssm_im': nrm(ks[5], (DEPTH, DEC_BATCH, G, N), 1.0),
        'norm1_g': 1.0 + nrm(ks[6], (DEPTH, D_MODEL), 0.02),
        'w_in': nrm(ks[7], (DEPTH, D_MODEL, IN_WIDTH), D_MODEL ** -0.5),
        'attn_out_g': 1.0 + nrm(ks[9], (DEPTH, ATTN_WIDTH), 0.02),
        'ssm_a_re': -0.5 + nrm(ks[10], (DEPTH, G, N), 0.01),
        'ssm_a_im': a_im,
        'ssm_log_dt': jax.random.uniform(ks[11], (DEPTH, G), F32, math.log(1e-3), math.log(1e-1)),
        'ssm_b_re': nrm(ks[12], (DEPTH, G, N, C), (2 * C) ** -0.5),
        'ssm_b_im': nrm(ks[13], (DEPTH, G, N, C), (2 * C) ** -0.5),
        'ssm_c_re': nrm(ks[14], (DEPTH, G, C, N), (2 * N) ** -0.5),
        'ssm_c_im': nrm(ks[15], (DEPTH, G, C, N), (2 * N) ** -0.5),
        'ssm_d': nrm(ks[16], (DEPTH, G, C), 1.0),
        'ssm_glu_w': nrm(ks[17], (DEPTH, SSM_WIDTH, SSM_WIDTH), SSM_WIDTH ** -0.5),
        'ssm_glu_b': nrm(ks[18], (DEPTH, SSM_WIDTH), 0.02),
        'ssm_out_g': 1.0 + nrm(ks[19], (DEPTH, SSM_WIDTH), 0.02),
        'w_out': nrm(ks[20], (DEPTH, MIX_WIDTH, D_MODEL), MIX_WIDTH ** -0.5),
        'norm2_g': 1.0 + nrm(ks[21], (DEPTH, D_MODEL), 0.02),
        'ffn_w_gate': nrm(ks[22], (DEPTH, D_MODEL, D_FF), D_MODEL ** -0.5),
        'ffn_w_up': nrm(ks[23], (DEPTH, D_MODEL, D_FF), D_MODEL ** -0.5),
        'ffn_w_down': nrm(ks[24], (DEPTH, D_FF, D_MODEL), D_FF ** -0.5),
        'final_norm_g': 1.0 + nrm(ks[25], (D_MODEL,), 0.02),
    }


def reference(x_prompt, x_sample, cache_attn_k, cache_attn_v, state_ssm_re, state_ssm_im,
              norm1_g, w_in, attn_out_g, ssm_a_re, ssm_a_im, ssm_log_dt, ssm_b_re, ssm_b_im,
              ssm_c_re, ssm_c_im, ssm_d, ssm_glu_w, ssm_glu_b, ssm_out_g, w_out, norm2_g,
              ffn_w_gate, ffn_w_up, ffn_w_down, final_norm_g):
    xp = x_prompt
    xs = x_sample
    zeros_p = jnp.zeros((x_prompt.shape[0], N_SSM_GROUPS, STATE_N), F32)
    pk, pv, pr, pim = [], [], [], []
    sk, sv, sr, sim = [], [], [], []
    for l in range(DEPTH):
        lw = (norm1_g[l], w_in[l], attn_out_g[l], ssm_a_re[l], ssm_a_im[l], ssm_log_dt[l],
              ssm_b_re[l], ssm_b_im[l], ssm_c_re[l], ssm_c_im[l], ssm_d[l], ssm_glu_w[l],
              ssm_glu_b[l], ssm_out_g[l], w_out[l], norm2_g[l], ffn_w_gate[l], ffn_w_up[l],
              ffn_w_down[l])
        xp, k_p, v_p, r_p, i_p = _layer(xp, None, None, zeros_p, zeros_p, *lw)
        pk.append(k_p)
        pv.append(v_p)
        pr.append(r_p)
        pim.append(i_p)
        xs, k_s, v_s, r_s, i_s = _layer(xs, cache_attn_k[l], cache_attn_v[l],
                                        state_ssm_re[l], state_ssm_im[l], *lw)
        sk.append(k_s)
        sv.append(v_s)
        sr.append(r_s)
        sim.append(i_s)
    y_prompt = rmsnorm(xp, final_norm_g)
    y_sample = rmsnorm(xs, final_norm_g)
    return (y_prompt, y_sample,
            jnp.stack(pk), jnp.stack(pv), jnp.stack(pr), jnp.stack(pim),
            jnp.stack(sk), jnp.stack(sv), jnp.stack(sr), jnp.stack(sim))
```

```cpp
#include <hip/hip_runtime.h>
#include <cstdio>
#include <cstdint>
namespace nv {
constexpr int D = 1024, NH = 8, HD = 64, AW = 512, SW = 512, G = 32, GC = 16, SN = 64, FF = 2816, INW = 2048, DEPTH = 4;
constexpr int PB = 8, PT = 2048, SB = 32, ST = 8, LBUF = 2048;
constexpr float EPS = 1e-6f;

__device__ __forceinline__ float wsum(float v) {
#pragma unroll
    for (int o = 1; o < 64; o <<= 1) v += __shfl_xor(v, o);
    return v;
}
__device__ __forceinline__ float wmax(float v) {
#pragma unroll
    for (int o = 1; o < 64; o <<= 1) v = fmaxf(v, __shfl_xor(v, o));
    return v;
}
__global__ void k_rmsnorm(const float* x, int ldx, const float* g, float* y, int ldy, int Dn) {
    const int row = blockIdx.x; const float* xr = x + (size_t)row * ldx; float* yr = y + (size_t)row * ldy;
    float s = 0.f;
    for (int i = threadIdx.x; i < Dn; i += 256) { const float v = xr[i]; s += v * v; }
    __shared__ float red[4];
    s = wsum(s); if ((threadIdx.x & 63) == 0) red[threadIdx.x >> 6] = s; __syncthreads();
    const float tot = red[0] + red[1] + red[2] + red[3];
    const float r = 1.0f / sqrtf(tot / (float)Dn + EPS);
    for (int i = threadIdx.x; i < Dn; i += 256) yr[i] = xr[i] * r * g[i];
}
__global__ void k_gemm(const float* A, int lda, const float* B, int ldb, float* C, int ldc, int M, int N, int K) {
    __shared__ float As[16][64 + 4], Bs[16][64 + 4];
    const int tx = threadIdx.x & 15, ty = threadIdx.x >> 4;
    const int m0 = blockIdx.y * 64, n0 = blockIdx.x * 64;
    float acc[4][4] = {};
    for (int k0 = 0; k0 < K; k0 += 16) {
        for (int i = threadIdx.x; i < 64 * 16; i += 256) { const int r = i >> 4, c = i & 15; As[c][r] = A[(size_t)(m0 + r) * lda + k0 + c]; }
        for (int i = threadIdx.x; i < 16 * 64; i += 256) { const int r = i >> 6, c = i & 63; Bs[r][c] = B[(size_t)(k0 + r) * ldb + n0 + c]; }
        __syncthreads();
#pragma unroll
        for (int k = 0; k < 16; ++k) {
            float a[4], b[4];
#pragma unroll
            for (int i = 0; i < 4; ++i) { a[i] = As[k][ty * 4 + i]; b[i] = Bs[k][tx * 4 + i]; }
#pragma unroll
            for (int i = 0; i < 4; ++i)
#pragma unroll
                for (int j = 0; j < 4; ++j) acc[i][j] += a[i] * b[j];
        }
        __syncthreads();
    }
#pragma unroll
    for (int i = 0; i < 4; ++i)
#pragma unroll
        for (int j = 0; j < 4; ++j) C[(size_t)(m0 + ty * 4 + i) * ldc + n0 + tx * 4 + j] = acc[i][j];
}
__global__ void k_attn(const float* z, const float* ck, const float* cv, int T, int lbuf, float* out, int ldo) {
    const int row = blockIdx.x, h = blockIdx.y, lane = threadIdx.x;
    const int b = row / T, t = row % T;
    __shared__ float qs[64]; __shared__ float ps[3][192]; __shared__ int pidx[3][192];
    qs[lane] = z[(size_t)row * INW + h * 64 + lane];
    __syncthreads();
    float lse[3];
    for (int br = 0; br < 3; ++br) {
        const int dil = br == 0 ? 1 : (br == 1 ? 4 : 16);
        float s[3];
#pragma unroll
        for (int r = 0; r < 3; ++r) {
            const int j = lane + 64 * r; s[r] = -INFINITY;
            int idx = -1;
            if (j <= 128) { idx = lbuf + t - dil * j; }
            if (idx >= 0) {
                const float* kp = (idx < lbuf) ? ck + (((size_t)b * lbuf + idx) * 8 + h) * 64 : z + ((size_t)b * T + (idx - lbuf)) * INW + 512 + h * 64;
                float d = 0.f;
                for (int e = 0; e < 64; ++e) d += qs[e] * kp[e];
                s[r] = d * 0.125f;
            }
            pidx[br][j] = idx;
        }
        const float m = wmax(fmaxf(fmaxf(s[0], s[1]), s[2]));
        float p[3], den = 0.f;
#pragma unroll
        for (int r = 0; r < 3; ++r) { p[r] = (s[r] == -INFINITY) ? 0.f : expf(s[r] - m); den += p[r]; }
        den = wsum(den);
        lse[br] = m + logf(den);
#pragma unroll
        for (int r = 0; r < 3; ++r) ps[br][lane + 64 * r] = p[r] / den;
    }
    __syncthreads();
    const float mm = fmaxf(fmaxf(lse[0], lse[1]), lse[2]);
    float w[3]; float ws_ = 0.f;
    for (int br = 0; br < 3; ++br) { w[br] = expf(lse[br] - mm); ws_ += w[br]; }
    float o = 0.f;
    for (int br = 0; br < 3; ++br) {
        float ob = 0.f;
        for (int j = 0; j <= 128; ++j) {
            const int idx = pidx[br][j];
            if (idx >= 0) {
                const float* vp = (idx < lbuf) ? cv + (((size_t)b * lbuf + idx) * 8 + h) * 64 : z + ((size_t)b * T + (idx - lbuf)) * INW + 1024 + h * 64;
                ob += ps[br][j] * vp[lane];
            }
        }
        o += (w[br] / ws_) * ob;
    }
    out[(size_t)row * ldo + h * 64 + lane] = o;
}
__global__ void k_ssm_scan(const float* z, int T, const float* h0re, const float* h0im, const float* a_re, const float* a_im, const float* log_dt,
                           const float* b_re, const float* b_im, float* Hre, float* Him, float* fre, float* fim) {
    const int bg = blockIdx.x, b = bg / G, g = bg % G, n = threadIdx.x;
    const float lam_re = fminf(a_re[g * SN + n], -1e-4f), lam_im = a_im[g * SN + n];
    const float dt = expf(log_dt[g]);
    const float mag = expf(lam_re * dt);
    const float ab_re = mag * cosf(lam_im * dt), ab_im = mag * sinf(lam_im * dt);
    const float den = lam_re * lam_re + lam_im * lam_im;
    const float f_re = ((ab_re - 1.0f) * lam_re + ab_im * lam_im) / den;
    const float f_im = (ab_im * lam_re - (ab_re - 1.0f) * lam_im) / den;
    float bbr[GC], bbi[GC];
#pragma unroll
    for (int c = 0; c < GC; ++c) { const float br = b_re[(g * SN + n) * GC + c], bi = b_im[(g * SN + n) * GC + c]; bbr[c] = f_re * br - f_im * bi; bbi[c] = f_re * bi + f_im * br; }
    float hr = h0re ? h0re[(b * G + g) * SN + n] : 0.f, hi = h0im ? h0im[(b * G + g) * SN + n] : 0.f;
    for (int t = 0; t < T; ++t) {
        const float* up = z + ((size_t)b * T + t) * INW + 1536 + g * GC;
        float ur = 0.f, ui = 0.f;
#pragma unroll
        for (int c = 0; c < GC; ++c) { const float u = up[c]; ur += bbr[c] * u; ui += bbi[c] * u; }
        const float nr = ab_re * hr - ab_im * hi + ur, ni = ab_re * hi + ab_im * hr + ui;
        hr = nr; hi = ni;
        Hre[(((size_t)b * T + t) * G + g) * SN + n] = hr; Him[(((size_t)b * T + t) * G + g) * SN + n] = hi;
    }
    fre[(b * G + g) * SN + n] = hr; fim[(b * G + g) * SN + n] = hi;
}
__device__ __forceinline__ float gelu_tanh(float x) { const float k = 0.7978845608028654f; return 0.5f * x * (1.0f + tanhf(k * (x + 0.044715f * x * x * x))); }
__global__ void k_ssm_y(const float* z, const float* Hre, const float* Him, const float* c_re, const float* c_im, const float* dsk, float* zg, int rows) {
    const int i = blockIdx.x * blockDim.x + threadIdx.x; if (i >= rows * SW) return;
    const int row = i / SW, ch = i % SW, g = ch / GC, c = ch % GC;
    const float* hr = Hre + ((size_t)row * G + g) * SN; const float* hi = Him + ((size_t)row * G + g) * SN;
    const float* cr = c_re + (g * GC + c) * SN; const float* ci = c_im + (g * GC + c) * SN;
    float y = 0.f;
    for (int n = 0; n < SN; ++n) y += hr[n] * cr[n] - hi[n] * ci[n];
    y += dsk[g * GC + c] * z[(size_t)row * INW + 1536 + ch];
    zg[i] = gelu_tanh(y);
}
__global__ void k_glu(const float* zg, const float* tmp, const float* bias, float* out, int rows) {
    const int i = blockIdx.x * blockDim.x + threadIdx.x; if (i >= rows * SW) return;
    const float v = tmp[i] + bias[i % SW]; out[i] = zg[i] / (1.0f + expf(-v));
}
__global__ void k_add(const float* a, const float* b, float* o, size_t n) { size_t i = (size_t)blockIdx.x * blockDim.x + threadIdx.x; if (i < n) o[i] = a[i] + b[i]; }
__global__ void k_swiglu(const float* gt, const float* up, float* o, size_t n) { size_t i = (size_t)blockIdx.x * blockDim.x + threadIdx.x; if (i < n) { const float g = gt[i]; o[i] = g / (1.0f + expf(-g)) * up[i]; } }
__global__ void k_copy_cols(const float* z, int off, float* dst, int rows) { const int i = blockIdx.x * blockDim.x + threadIdx.x; if (i >= rows * 512) return; dst[i] = z[(size_t)(i / 512) * INW + off + (i % 512)]; }

struct Bufs { float *xn, *z, *cat, *tmp, *Hre, *Him, *zg, *glut, *mix, *h, *hn, *gt, *up, *ff, *dn, *xcur; };

static void layer(hipStream_t s, const float* xin, float* xout, int B, int T, int lbuf, const float* ck, const float* cv, const float* h0re, const float* h0im,
                  void* const* d_in, int l, const Bufs& w, float* out_k, float* out_v, float* out_sre, float* out_sim) {
    const int rows = B * T;
    const float* norm1_g = (const float*)d_in[6] + l * D; const float* w_in = (const float*)d_in[7] + (size_t)l * D * INW;
    const float* attn_out_g = (const float*)d_in[8] + l * AW; const float* a_re = (const float*)d_in[9] + l * G * SN; const float* a_im = (const float*)d_in[10] + l * G * SN;
    const float* log_dt = (const float*)d_in[11] + l * G; const float* b_re = (const float*)d_in[12] + l * G * SN * GC; const float* b_im = (const float*)d_in[13] + l * G * SN * GC;
    const float* c_re = (const float*)d_in[14] + l * G * GC * SN; const float* c_im = (const float*)d_in[15] + l * G * GC * SN; const float* dsk = (const float*)d_in[16] + l * G * GC;
    const float* glu_w = (const float*)d_in[17] + (size_t)l * SW * SW; const float* glu_b = (const float*)d_in[18] + l * SW; const float* ssm_out_g = (const float*)d_in[19] + l * SW;
    const float* w_out = (const float*)d_in[20] + (size_t)l * D * D; const float* norm2_g = (const float*)d_in[21] + l * D;
    const float* w_gate = (const float*)d_in[22] + (size_t)l * D * FF; const float* w_up = (const float*)d_in[23] + (size_t)l * D * FF; const float* w_down = (const float*)d_in[24] + (size_t)l * FF * D;
    k_rmsnorm<<<rows, 256, 0, s>>>(xin, D, norm1_g, w.xn, D, D);
    k_gemm<<<dim3(INW / 64, rows / 64), 256, 0, s>>>(w.xn, D, w_in, INW, w.z, INW, rows, INW, D);
    k_copy_cols<<<(rows * 512 + 255) / 256, 256, 0, s>>>(w.z, 512, out_k, rows);
    k_copy_cols<<<(rows * 512 + 255) / 256, 256, 0, s>>>(w.z, 1024, out_v, rows);
    k_attn<<<dim3(rows, 8), 64, 0, s>>>(w.z, ck, cv, T, lbuf, w.tmp, AW);
    k_rmsnorm<<<rows, 256, 0, s>>>(w.tmp, AW, attn_out_g, w.cat, D, AW);
    k_ssm_scan<<<B * G, 64, 0, s>>>(w.z, T, h0re, h0im, a_re, a_im, log_dt, b_re, b_im, w.Hre, w.Him, out_sre, out_sim);
    k_ssm_y<<<(rows * SW + 255) / 256, 256, 0, s>>>(w.z, w.Hre, w.Him, c_re, c_im, dsk, w.zg, rows);
    k_gemm<<<dim3(SW / 64, rows / 64), 256, 0, s>>>(w.zg, SW, glu_w, SW, w.glut, SW, rows, SW, SW);
    k_glu<<<(rows * SW + 255) / 256, 256, 0, s>>>(w.zg, w.glut, glu_b, w.tmp, rows);
    k_rmsnorm<<<rows, 256, 0, s>>>(w.tmp, SW, ssm_out_g, w.cat + AW, D, SW);
    k_gemm<<<dim3(D / 64, rows / 64), 256, 0, s>>>(w.cat, D, w_out, D, w.mix, D, rows, D, D);
    k_add<<<(unsigned)(((size_t)rows * D + 255) / 256), 256, 0, s>>>(xin, w.mix, w.h, (size_t)rows * D);
    k_rmsnorm<<<rows, 256, 0, s>>>(w.h, D, norm2_g, w.hn, D, D);
    k_gemm<<<dim3(FF / 64, rows / 64), 256, 0, s>>>(w.hn, D, w_gate, FF, w.gt, FF, rows, FF, D);
    k_gemm<<<dim3(FF / 64, rows / 64), 256, 0, s>>>(w.hn, D, w_up, FF, w.up, FF, rows, FF, D);
    k_swiglu<<<(unsigned)(((size_t)rows * FF + 255) / 256), 256, 0, s>>>(w.gt, w.up, w.ff, (size_t)rows * FF);
    k_gemm<<<dim3(D / 64, rows / 64), 256, 0, s>>>(w.ff, FF, w_down, D, w.dn, D, rows, D, FF);
    k_add<<<(unsigned)(((size_t)rows * D + 255) / 256), 256, 0, s>>>(w.h, w.dn, xout, (size_t)rows * D);
}

constexpr size_t O_YP = 0, O_YS = O_YP + (size_t)PB * PT * D, O_PK = O_YS + (size_t)SB * ST * D, O_PV = O_PK + (size_t)DEPTH * PB * PT * AW,
                 O_PR = O_PV + (size_t)DEPTH * PB * PT * AW, O_PI = O_PR + (size_t)DEPTH * PB * G * SN, O_SK = O_PI + (size_t)DEPTH * PB * G * SN,
                 O_SV = O_SK + (size_t)DEPTH * SB * ST * AW, O_SR = O_SV + (size_t)DEPTH * SB * ST * AW, O_SI = O_SR + (size_t)DEPTH * SB * G * SN,
                 O_END = O_SI + (size_t)DEPTH * SB * G * SN;

static size_t forward(hipStream_t s, void* const* d_in, float* out, float* wsb) {
    const int R = PB * PT;
    Bufs w; float* p = wsb;
    w.xn = p; p += (size_t)R * D; w.z = p; p += (size_t)R * INW; w.cat = p; p += (size_t)R * D; w.tmp = p; p += (size_t)R * AW;
    w.Hre = p; p += (size_t)R * G * SN; w.Him = p; p += (size_t)R * G * SN; w.zg = p; p += (size_t)R * SW; w.glut = p; p += (size_t)R * SW;
    w.mix = p; p += (size_t)R * D; w.h = p; p += (size_t)R * D; w.hn = p; p += (size_t)R * D; w.gt = p; p += (size_t)R * FF; w.up = p; p += (size_t)R * FF;
    w.ff = p; p += (size_t)R * FF; w.dn = p; p += (size_t)R * D; w.xcur = p; p += (size_t)R * D;
    float* xs_cur = p; p += (size_t)SB * ST * D;
    const float* xp = (const float*)d_in[0]; const float* xs = (const float*)d_in[1];
    for (int l = 0; l < DEPTH; ++l) {
        layer(s, l == 0 ? xp : w.xcur, w.xcur, PB, PT, 0, nullptr, nullptr, nullptr, nullptr, d_in, l, w,
              out + O_PK + (size_t)l * PB * PT * AW, out + O_PV + (size_t)l * PB * PT * AW, out + O_PR + (size_t)l * PB * G * SN, out + O_PI + (size_t)l * PB * G * SN);
    }
    k_rmsnorm<<<PB * PT, 256, 0, s>>>(w.xcur, D, (const float*)d_in[25], out + O_YP, D, D);
    for (int l = 0; l < DEPTH; ++l) {
        layer(s, l == 0 ? xs : xs_cur, xs_cur, SB, ST, LBUF, (const float*)d_in[2] + (size_t)l * SB * LBUF * AW, (const float*)d_in[3] + (size_t)l * SB * LBUF * AW,
              (const float*)d_in[4] + (size_t)l * SB * G * SN, (const float*)d_in[5] + (size_t)l * SB * G * SN, d_in, l, w,
              out + O_SK + (size_t)l * SB * ST * AW, out + O_SV + (size_t)l * SB * ST * AW, out + O_SR + (size_t)l * SB * G * SN, out + O_SI + (size_t)l * SB * G * SN);
    }
    k_rmsnorm<<<SB * ST, 256, 0, s>>>(xs_cur, D, (const float*)d_in[25], out + O_YS, D, D);
    return (size_t)(p - wsb);
}
}
extern "C" void kernel_launch(void* const* d_in, const int* in_sizes, int n_in,
                              void* d_out, int out_size, void* d_ws, size_t ws_size,
                              hipStream_t stream) {
    nv::forward(stream, d_in, (float*)d_out, (float*)d_ws);
}
```

```cpp
#include <hip/hip_runtime.h>
#include <hip/hip_bf16.h>
#include <cstdio>
#include <cstdint>
#include <cmath>
#ifndef DBG_SET
#define DBG_SET 0
#endif
#ifndef PHM
#define PHM 0xFFFF
#endif
#define GAS __attribute__((address_space(1)))
#define LAS __attribute__((address_space(3)))
constexpr int NWAVES = 8;
constexpr int MP = 16384, MS = 256, MT = MP + MS, DM_ = 1024, FF_ = 2816, INW_ = 2048, NLAYER = 4;
constexpr size_t MiB = 1u << 20;
constexpr size_t WS_CTL = 0, CTL_ZERO_BYTES = 1 * MiB;
constexpr size_t WS_WIN = 2 * MiB, WS_WOUT = 18 * MiB, WS_WGU = 26 * MiB, WS_WDN = 70 * MiB, WS_WGLU = 92 * MiB;
constexpr size_t WS_SSMT = 94 * MiB, WS_A32 = 130 * MiB;
constexpr size_t WS_XRES = 131 * MiB, WS_XB = 196 * MiB, WS_QB = 229 * MiB, WS_KB = 246 * MiB, WS_VB = 263 * MiB, WS_UB = 280 * MiB, WS_US = 296 * MiB;
constexpr size_t WS_MIX = 297 * MiB, WS_ZB = 330 * MiB, WS_GB = 347 * MiB, WS_SS1 = 437 * MiB, WS_SS2 = 439 * MiB, WS_SSA = 441 * MiB, WS_SSS = 442 * MiB, WS_SSC = 443 * MiB  , WS_END = 445 * MiB;
constexpr int CW_BAR = 4096;
constexpr size_t O_YP = 0, O_YS = O_YP + (size_t)MP * 1024, O_PK = O_YS + (size_t)MS * 1024, O_PV = O_PK + (size_t)NLAYER * MP * 512, O_PR = O_PV + (size_t)NLAYER * MP * 512,
                 O_PI = O_PR + (size_t)NLAYER * 8 * 32 * 64, O_SK = O_PI + (size_t)NLAYER * 8 * 32 * 64, O_SV = O_SK + (size_t)NLAYER * MS * 512, O_SR = O_SV + (size_t)NLAYER * MS * 512,
                 O_SI = O_SR + (size_t)NLAYER * 32 * 32 * 64, O_END = O_SI + (size_t)NLAYER * 32 * 32 * 64;
constexpr int RING_OFF = 0, RING_BYTES = 131072, RTAB_OFF = 131072, MISC_OFF = 135168, PTAB_OFF = MISC_OFF + 512, LDS_BYTES = 147456;
constexpr int MTAB_OFF = 86016, MTAB_N = 2304;

typedef unsigned short bf16;
typedef unsigned v4u __attribute__((ext_vector_type(4)));
typedef float f32x4 __attribute__((ext_vector_type(4)));
typedef GAS unsigned gu32;
#define RLX_AGENT __ATOMIC_RELAXED, __HIP_MEMORY_SCOPE_AGENT
#define LDS_WAIT() asm volatile("s_waitcnt lgkmcnt(0)" ::: "memory")
#define VM_WAIT() asm volatile("s_waitcnt vmcnt(0)" ::: "memory")
__device__ __forceinline__ unsigned f2bf(float f) { unsigned u = __builtin_bit_cast(unsigned, f); return (u + 0x7fffu + ((u >> 16) & 1u)) >> 16; }
__device__ __forceinline__ unsigned pk2(float lo, float hi) { return f2bf(lo) | (f2bf(hi) << 16); }
__device__ __forceinline__ float wave_sum(float v) {
#pragma unroll
    for (int o = 1; o < 64; o <<= 1) v += __shfl_xor(v, o);
    return v;
}
__device__ __forceinline__ float wave_max(float v) {
#pragma unroll
    for (int o = 1; o < 64; o <<= 1) v = fmaxf(v, __shfl_xor(v, o));
    return v;
}

namespace pg8 {
#define PG8_LAS __attribute__((address_space(3)))
typedef unsigned short bf16_t;
typedef short bf16x8 __attribute__((ext_vector_type(8)));
typedef float f32x4 __attribute__((ext_vector_type(4)));
typedef unsigned u32x4 __attribute__((ext_vector_type(4)));
constexpr int BM = 256, BK = 64, HALF = 128, HTB = HALF * BK * 2  , STAGE_BYTES = 8 * HTB, NXCD = 8, WGM = 8;

__host__ __device__ __forceinline__ int lds_byte(int r, int c) { const int st = (r >> 4) * 2 + (c >> 5), rr = r & 15, cc = c & 31, ob = rr * 64 + cc * 2; return st * 1024 + (ob ^ (((ob >> 9) & 1) << 5)); }
__host__ __device__ __forceinline__ void stage_rc(int b, int& R, int& C) { const int st = b / 1024, sb = b % 1024, swz = sb ^ (((sb >> 9) & 1) << 5); R = (st >> 1) * 16 + swz / 64; C = (st & 1) * 32 + (swz % 64) / 2; }
__host__ __device__ __forceinline__ int perm32(int rho) { const int n = rho >> 4, i = rho & 15; return 8 * (i >> 2) + 4 * n + (i & 3); }

struct Unit { int pm, pn; };
struct Gemm { const GAS bf16_t* A; const GAS bf16_t* Bt; int M, N, K; };

struct StaticOrder {
    int nM, nN, nwg, G, c;
    __host__ __device__ void init(int M, int N, int G_, int c_) { nM = M / BM; nN = N / BM; nwg = nM * nN; G = G_; c = c_; }
    __host__ __device__ bool next(int i, Unit& u) const {
        const int L = i * G + c; if (L >= nwg) return false;
        int wgid = L; { const int q = nwg / NXCD, r = nwg % NXCD, xcd = wgid % NXCD, off = wgid / NXCD; wgid = (xcd < r ? xcd * (q + 1) : r * (q + 1) + (xcd - r) * q) + off; }
        const int nig = WGM * nN, gid = wgid / nig, fm = gid * WGM, gsz = (nM - fm) < WGM ? (nM - fm) : WGM;
        u.pm = fm + ((wgid % nig) % gsz); u.pn = (wgid % nig) / gsz; return true;
    }
    __device__ __forceinline__ void a_ready(const Unit&) const {}
    __device__ __forceinline__ void done(const Unit&) const {}
};

__device__ __forceinline__ unsigned cvt_pk_bf16(float lo, float hi) { unsigned r; asm volatile("v_cvt_pk_bf16_f32 %0, %1, %2" : "=v"(r) : "v"(lo), "v"(hi)); return r; }
typedef float f32x2 __attribute__((ext_vector_type(2)));
constexpr int MP_ROWS = MP;
constexpr float RMS_EPS = 1e-6f;
constexpr float QSCALE = 0.125f * 1.4426950408889634f;
__device__ __forceinline__ u32x4 pack8(const f32x4 a, const f32x4 b) { u32x4 w; w.x = cvt_pk_bf16(a[0], a[1]); w.y = cvt_pk_bf16(a[2], a[3]); w.z = cvt_pk_bf16(b[0], b[1]); w.w = cvt_pk_bf16(b[2], b[3]); return w; }
__device__ __forceinline__ float sum8sq(const f32x4 a, const f32x4 b) { return (a[0] * a[0] + a[1] * a[1]) + (a[2] * a[2] + a[3] * a[3]) + (b[0] * b[0] + b[1] * b[1]) + (b[2] * b[2] + b[3] * b[3]); }
__device__ __forceinline__ GAS unsigned char* lau(GAS unsigned char* p) { asm volatile("" : "+s"(p)); return p; }
__device__ __forceinline__ GAS float* lauf(GAS float* p) { asm volatile("" : "+s"(p)); return p; }
__device__ __forceinline__ const GAS float* laucf(const GAS float* p) { asm volatile("" : "+s"(p)); return p; }
__device__ __forceinline__ float fq_reduce(float v) { v += __shfl_xor(v, 16); v += __shfl_xor(v, 32); return v; }
__device__ __forceinline__ float sum16(const GAS float* p) { const f32x4 a = *(const GAS f32x4*)p, b = *(const GAS f32x4*)(p + 4), c = *(const GAS f32x4*)(p + 8), d = *(const GAS f32x4*)(p + 12);
    return ((a[0] + a[1]) + (a[2] + a[3])) + ((b[0] + b[1]) + (b[2] + b[3])) + ((c[0] + c[1]) + (c[2] + c[3])) + ((d[0] + d[1]) + (d[2] + d[3])); }
__device__ __forceinline__ float sum8(const GAS float* p) { const f32x4 a = *(const GAS f32x4*)p, b = *(const GAS f32x4*)(p + 4); return ((a[0] + a[1]) + (a[2] + a[3])) + ((b[0] + b[1]) + (b[2] + b[3])); }

struct EpiInProj {
    static constexpr bool PERM = true, AFTER_DRAIN = false, MID = false;
    GAS unsigned char* ws; GAS float* out; int l; PG8_LAS f32x2* tab;
    __device__ __forceinline__ void begin(const Unit& u, int ui, int tid) const {
        const GAS float* ss = (const GAS float*)(lau(ws) + WS_SS1);
        if (tid < 256) { const int row = u.pm * BM + tid; const float s = sum16(ss + (size_t)row * 16); tab[(ui & 1) * 256 + tid] = (f32x2){__builtin_amdgcn_rsqf(s * (1.0f / 1024.0f) + RMS_EPS), 0.f}; }
    }
    __device__ __forceinline__ void mid(f32x4 (&)[2][2][4][2], const Unit&, int, int, int, int, int) const {}
    __device__ __forceinline__ void operator()(const f32x4 (&acc)[2][2][4][2], const Unit& u, int ui, int wr, int wc, int fr, int fq) const {
        const int seg = u.pn >> 1, col0 = (u.pn & 1) * BM + wc * 32 + 8 * fq;
        GAS unsigned char* w = lau(ws); GAS float* ob = lauf(out);
        GAS bf16_t* Q = (GAS bf16_t*)(w + WS_QB); GAS bf16_t* Kb = (GAS bf16_t*)(w + WS_KB); GAS bf16_t* Vb = (GAS bf16_t*)(w + WS_VB); GAS bf16_t* U = (GAS bf16_t*)(w + WS_UB); GAS float* Us = (GAS float*)(w + WS_US);
        GAS float* outKp = ob + O_PK + (size_t)l * MP * 512; GAS float* outVp = ob + O_PV + (size_t)l * MP * 512; GAS float* outKs = ob + O_SK + (size_t)l * MS * 512; GAS float* outVs = ob + O_SV + (size_t)l * MS * 512;
#pragma unroll
        for (int ai = 0; ai < 2; ++ai)
#pragma unroll
            for (int m = 0; m < 4; ++m) {
                const int rl = ai * HALF + wr * 64 + m * 16 + fr, row = u.pm * BM + rl; const float r = tab[(ui & 1) * 256 + rl].x;
#pragma unroll
                for (int bj = 0; bj < 2; ++bj) {
                    const int c = col0 + bj * HALF; f32x4 v0 = acc[ai][bj][m][0] * r, v1 = acc[ai][bj][m][1] * r;
                    if (seg == 0) { *(GAS u32x4*)(Q + (size_t)row * 512 + c) = pack8(v0 * QSCALE, v1 * QSCALE); }
                    else if (seg == 3) {
                        if (row < MP_ROWS) { *(GAS u32x4*)(U + (((size_t)(c >> 4) * MP_ROWS + row) * 16 + (c & 15))) = pack8(v0, v1); }
                        else { GAS float* p = Us + (size_t)(row - MP_ROWS) * 512 + c; *(GAS f32x4*)p = v0; *(GAS f32x4*)(p + 4) = v1; }
                    } else {
                        GAS bf16_t* bb = (seg == 1) ? Kb : Vb; *(GAS u32x4*)(bb + (size_t)row * 512 + c) = pack8(v0, v1);
                        GAS float* p = (row < MP_ROWS) ? ((seg == 1 ? outKp : outVp) + (size_t)row * 512 + c) : ((seg == 1 ? outKs : outVs) + (size_t)(row - MP_ROWS) * 512 + c);
                        *(GAS f32x4*)p = v0; *(GAS f32x4*)(p + 4) = v1;
                    }
                }
                asm volatile("" ::: "memory");
            }
    }
};

struct EpiGlu {
    static constexpr bool PERM = true, AFTER_DRAIN = false, MID = false;
    GAS unsigned char* ws; const GAS float* bias;
    __device__ __forceinline__ void begin(const Unit&, int, int) const {}
    __device__ __forceinline__ void mid(f32x4 (&)[2][2][4][2], const Unit&, int, int, int, int, int) const {}
    __device__ __forceinline__ void operator()(const f32x4 (&acc)[2][2][4][2], const Unit& u, int ui, int wr, int wc, int fr, int fq) const {
        const int col0 = u.pn * BM + wc * 32 + 8 * fq;
        GAS unsigned char* w = lau(ws); const GAS bf16_t* Z = (const GAS bf16_t*)(w + WS_ZB); GAS bf16_t* MIXs = (GAS bf16_t*)(w + WS_MIX) + 512; GAS float* sss = (GAS float*)(w + WS_SSS);
        f32x4 bv[2][2];
#pragma unroll
        for (int bj = 0; bj < 2; ++bj)
#pragma unroll
            for (int n = 0; n < 2; ++n) bv[bj][n] = *(const GAS f32x4*)(bias + col0 + bj * HALF + 4 * n);
#pragma unroll
        for (int ai = 0; ai < 2; ++ai)
#pragma unroll
            for (int m = 0; m < 4; ++m) {
                const int row = u.pm * BM + ai * HALF + wr * 64 + m * 16 + fr; float part = 0.f;
#pragma unroll
                for (int bj = 0; bj < 2; ++bj) {
                    const int c = col0 + bj * HALF; const u32x4 zz = *(const GAS u32x4*)(Z + (size_t)row * 512 + c);
                    f32x4 z0, z1; z0[0] = __uint_as_float(zz.x << 16); z0[1] = __uint_as_float(zz.x & 0xffff0000u); z0[2] = __uint_as_float(zz.y << 16); z0[3] = __uint_as_float(zz.y & 0xffff0000u);
                    z1[0] = __uint_as_float(zz.z << 16); z1[1] = __uint_as_float(zz.z & 0xffff0000u); z1[2] = __uint_as_float(zz.w << 16); z1[3] = __uint_as_float(zz.w & 0xffff0000u);
                    const f32x4 a0 = acc[ai][bj][m][0] + bv[bj][0], a1 = acc[ai][bj][m][1] + bv[bj][1]; f32x4 o0, o1;
#pragma unroll
                    for (int e = 0; e < 4; ++e) { o0[e] = z0[e] * __builtin_amdgcn_rcpf(1.0f + __builtin_amdgcn_exp2f(-1.4426950408889634f * a0[e])); o1[e] = z1[e] * __builtin_amdgcn_rcpf(1.0f + __builtin_amdgcn_exp2f(-1.4426950408889634f * a1[e])); }
                    part += sum8sq(o0, o1);
                    *(GAS u32x4*)(MIXs + (size_t)row * 1024 + c) = pack8(o0, o1);
                }
                part = fq_reduce(part); if (fq == 0) sss[(size_t)row * 8 + u.pn * 4 + wc] = part;
                asm volatile("" ::: "memory");
            }
    }
};

struct EpiWout {
    static constexpr bool PERM = true, AFTER_DRAIN = false, MID = true;
    GAS unsigned char* ws; const GAS float *xin_p, *xin_s; PG8_LAS f32x2* tab;
    __device__ __forceinline__ void begin(const Unit& u, int ui, int tid) const {
        GAS unsigned char* w0 = lau(ws); const GAS float* ssa = (const GAS float*)(w0 + WS_SSA); const GAS float* sss = (const GAS float*)(w0 + WS_SSS);
        if (tid < 256) { const int row = u.pm * BM + tid; const float sa = sum8(ssa + (size_t)row * 8), s2 = sum8(sss + (size_t)row * 8);
            const float va = sa * (1.0f / 512.0f) + RMS_EPS, vs = s2 * (1.0f / 512.0f) + RMS_EPS; const float rs = __builtin_amdgcn_rsqf(vs); tab[(ui & 1) * 256 + tid] = (f32x2){__builtin_amdgcn_rsqf(va) * vs * rs, rs}; }
    }
    __device__ __forceinline__ void mid(f32x4 (&acc)[2][2][4][2], const Unit& u, int ui, int wr, int wc, int fr, int fq) const {
#pragma unroll
        for (int ai = 0; ai < 2; ++ai)
#pragma unroll
            for (int m = 0; m < 4; ++m) { const float f = tab[(ui & 1) * 256 + ai * HALF + wr * 64 + m * 16 + fr].x;
#pragma unroll
                for (int bj = 0; bj < 2; ++bj)
#pragma unroll
                    for (int n = 0; n < 2; ++n) acc[ai][bj][m][n] = acc[ai][bj][m][n] * f; }
    }
    __device__ __forceinline__ void operator()(const f32x4 (&acc)[2][2][4][2], const Unit& u, int ui, int wr, int wc, int fr, int fq) const {
        const int col0 = u.pn * BM + wc * 32 + 8 * fq;
        GAS unsigned char* w = lau(ws); GAS float* xres = (GAS float*)(w + WS_XRES); GAS bf16_t* xb = (GAS bf16_t*)(w + WS_XB); GAS float* ss2 = (GAS float*)(w + WS_SS2);
        const GAS float* xp_p = xin_p ? laucf(xin_p) : xres; const GAS float* xp_s = xin_s ? laucf(xin_s) : xres + (size_t)MP_ROWS * 1024;
#pragma unroll
        for (int ai = 0; ai < 2; ++ai)
#pragma unroll
            for (int m = 0; m < 4; ++m) {
                const int rl = ai * HALF + wr * 64 + m * 16 + fr, row = u.pm * BM + rl; const float rs = tab[(ui & 1) * 256 + rl].y; float part = 0.f;
                const GAS float* xp = (row < MP_ROWS) ? xp_p + (size_t)row * 1024 : xp_s + (size_t)(row - MP_ROWS) * 1024;
#pragma unroll
                for (int bj = 0; bj < 2; ++bj) {
                    const int c = col0 + bj * HALF; const f32x4 x0 = *(const GAS f32x4*)(xp + c), x1 = *(const GAS f32x4*)(xp + c + 4);
                    const f32x4 h0 = x0 + acc[ai][bj][m][0] * rs, h1 = x1 + acc[ai][bj][m][1] * rs;
                    GAS float* o = xres + (size_t)row * 1024 + c; *(GAS f32x4*)o = h0; *(GAS f32x4*)(o + 4) = h1;
                    *(GAS u32x4*)(xb + (size_t)row * 1024 + c) = pack8(h0, h1); part += sum8sq(h0, h1);
                }
                part = fq_reduce(part); if (fq == 0) ss2[(size_t)row * 16 + u.pn * 4 + wc] = part;
                asm volatile("" ::: "memory");
            }
    }
};

struct EpiGateUp {
    static constexpr bool PERM = true, AFTER_DRAIN = false, MID = false;
    GAS unsigned char* ws; PG8_LAS f32x2* tab;
    __device__ __forceinline__ void begin(const Unit& u, int ui, int tid) const {
        const GAS float* ss = (const GAS float*)(lau(ws) + WS_SS2);
        if (tid < 256) { const int row = u.pm * BM + tid; const float s = sum16(ss + (size_t)row * 16); tab[(ui & 1) * 256 + tid] = (f32x2){__builtin_amdgcn_rsqf(s * (1.0f / 1024.0f) + RMS_EPS), 0.f}; }
    }
    __device__ __forceinline__ void mid(f32x4 (&)[2][2][4][2], const Unit&, int, int, int, int, int) const {}
    __device__ __forceinline__ void operator()(const f32x4 (&acc)[2][2][4][2], const Unit& u, int ui, int wr, int wc, int fr, int fq) const {
        const int c = u.pn * HALF + wc * 32 + 8 * fq; GAS bf16_t* G = (GAS bf16_t*)(lau(ws) + WS_GB);
#pragma unroll
        for (int ai = 0; ai < 2; ++ai)
#pragma unroll
            for (int m = 0; m < 4; ++m) {
                const int rl = ai * HALF + wr * 64 + m * 16 + fr, row = u.pm * BM + rl; const float r = tab[(ui & 1) * 256 + rl].x;
                f32x4 o[2];
#pragma unroll
                for (int n = 0; n < 2; ++n) { const f32x4 g = acc[ai][0][m][n] * r, up = acc[ai][1][m][n] * r;
#pragma unroll
                    for (int e = 0; e < 4; ++e) o[n][e] = g[e] * up[e] * __builtin_amdgcn_rcpf(1.0f + __builtin_amdgcn_exp2f(-1.4426950408889634f * g[e])); }
                *(GAS u32x4*)(G + (size_t)row * 2816 + c) = pack8(o[0], o[1]);
                asm volatile("" ::: "memory");
            }
    }
};

struct EpiDown {
    static constexpr bool PERM = true, AFTER_DRAIN = false, MID = false;
    GAS unsigned char* ws;
    __device__ __forceinline__ void begin(const Unit&, int, int) const {}
    __device__ __forceinline__ void mid(f32x4 (&)[2][2][4][2], const Unit&, int, int, int, int, int) const {}
    __device__ __forceinline__ void operator()(const f32x4 (&acc)[2][2][4][2], const Unit& u, int ui, int wr, int wc, int fr, int fq) const {
        const int col0 = u.pn * BM + wc * 32 + 8 * fq;
        GAS unsigned char* w = lau(ws); GAS float* xres = (GAS float*)(w + WS_XRES); GAS bf16_t* xb = (GAS bf16_t*)(w + WS_XB); GAS float* ss1 = (GAS float*)(w + WS_SS1);
#pragma unroll
        for (int ai = 0; ai < 2; ++ai)
#pragma unroll
            for (int m = 0; m < 4; ++m) {
                const int row = u.pm * BM + ai * HALF + wr * 64 + m * 16 + fr; float part = 0.f;
#pragma unroll
                for (int bj = 0; bj < 2; ++bj) {
                    const int c = col0 + bj * HALF; GAS float* o = xres + (size_t)row * 1024 + c;
                    const f32x4 y0 = *(const GAS f32x4*)o + acc[ai][bj][m][0], y1 = *(const GAS f32x4*)(o + 4) + acc[ai][bj][m][1];
                    *(GAS f32x4*)o = y0; *(GAS f32x4*)(o + 4) = y1; *(GAS u32x4*)(xb + (size_t)row * 1024 + c) = pack8(y0, y1); part += sum8sq(y0, y1);
                }
                part = fq_reduce(part); if (fq == 0) ss1[(size_t)row * 16 + u.pn * 4 + wc] = part;
                asm volatile("" ::: "memory");
            }
    }
};
template <class Epi, class Sched, bool ALIGN_EPI = false, bool SP2 = false>
__device__ __forceinline__ void gemm_phase(PG8_LAS unsigned char* lds, const Gemm g, const Sched& S, const Epi& E) {
    int tid_ = threadIdx.x; asm volatile("" : "+v"(tid_));
    const int tid = tid_, wid = __builtin_amdgcn_readfirstlane(tid >> 6), lane = tid & 63, wr = wid >> 2, wc = wid & 3, fr = lane & 15, fq = lane >> 4;
    const int K = g.K, nt = K / BK;
    unsigned voffA[2], voffB[2];
#pragma unroll
    for (int i = 0; i < 2; ++i) { int R, C; stage_rc(tid * 16 + i * 8192, R, C); const int Rb = Epi::PERM ? ((R & ~31) + perm32(R & 31)) : R;
        voffA[i] = (unsigned)(R * K + C) * 2u; voffB[i] = (unsigned)(Rb * K + C) * 2u; }
    const size_t kstep = (size_t)(BK * 2);
    const size_t hstep = (size_t)HALF * K * 2;
    const size_t tstep = 2 * hstep;
    const unsigned ldsw = (unsigned)wid * 1024u;
    const int aoff = lds_byte(wr * 64 + fr, fq * 8), boff = lds_byte(wc * 32 + fr, fq * 8);
#define PG8_SA(b, h) (((b) * 2 + (h)) * HTB)
#define PG8_SB(b, h) ((4 + (b) * 2 + (h)) * HTB)
#define PG8_STAGE(bufoff, gbase, voff) do { _Pragma("unroll") for (int _i = 0; _i < 2; ++_i) \
        __builtin_amdgcn_global_load_lds((const unsigned*)((const char*)(gbase) + (voff)[_i]), (PG8_LAS unsigned*)(lds + (bufoff) + ldsw + _i * 8192), 16, 0, 0); } while (0)
#define PG8_LDA(dst, b, h) do { _Pragma("unroll") for (int m = 0; m < 4; ++m) _Pragma("unroll") for (int k = 0; k < 2; ++k) dst[m][k] = *(const PG8_LAS bf16x8*)(lds + PG8_SA(b, h) + aoff + m * 2048 + k * 1024); } while (0)
#define PG8_LDB(dst, b, h) do { _Pragma("unroll") for (int n = 0; n < 2; ++n) _Pragma("unroll") for (int k = 0; k < 2; ++k) dst[n][k] = *(const PG8_LAS bf16x8*)(lds + PG8_SB(b, h) + boff + n * 2048 + k * 1024); } while (0)
#define PG8_MMA(ai, bj, At, Bt) do { __builtin_amdgcn_s_setprio(1); _Pragma("unroll") for (int m = 0; m < 4; ++m) _Pragma("unroll") for (int n = 0; n < 2; ++n) _Pragma("unroll") for (int k = 0; k < 2; ++k) \
        acc[ai][bj][m][n] = __builtin_amdgcn_mfma_f32_16x16x32_bf16(Bt[n][k], At[m][k], acc[ai][bj][m][n], 0, 0, 0); __builtin_amdgcn_s_setprio(0); } while (0)
#define PG8_WAIT_V(n) asm volatile("s_waitcnt vmcnt(" #n ")" ::: "memory")
#define PG8_WAIT_L(n) asm volatile("s_waitcnt lgkmcnt(" #n ")" ::: "memory")
#define PG8_BAR __builtin_amdgcn_s_barrier()
#define PG8_SCHED __builtin_amdgcn_sched_barrier(0)
    Unit cur, nxt; int ui = 0;
    if (!S.next(0, cur)) return;
    f32x4 acc[2][2][4][2];
#pragma unroll
    for (int a = 0; a < 2; ++a)
#pragma unroll
        for (int b = 0; b < 2; ++b)
#pragma unroll
            for (int m = 0; m < 4; ++m)
#pragma unroll
                for (int n = 0; n < 2; ++n) acc[a][b][m][n] = (f32x4){0.f, 0.f, 0.f, 0.f};
    bf16x8 At[4][2], B0[2][2], B1[2][2];
    const char* cA = (const char*)g.A + (size_t)cur.pm * tstep; const char* cB = (const char*)g.Bt + (size_t)cur.pn * tstep;
    S.a_ready(cur);
    if constexpr (SP2) {
        PG8_STAGE(PG8_SB(0, 0), cB, voffB); PG8_STAGE(PG8_SB(0, 1), cB + hstep, voffB); PG8_STAGE(PG8_SA(0, 0), cA, voffA); PG8_STAGE(PG8_SA(0, 1), cA + hstep, voffA);
        if (wr == 1) PG8_BAR;
        PG8_WAIT_V(2); PG8_BAR;
        PG8_STAGE(PG8_SB(1, 0), cB + kstep, voffB); PG8_STAGE(PG8_SA(1, 0), cA + kstep, voffA); PG8_STAGE(PG8_SB(1, 1), cB + hstep + kstep, voffB);
        PG8_WAIT_V(6); PG8_BAR;
    } else {
        PG8_STAGE(PG8_SB(0, 0), cB, voffB); PG8_STAGE(PG8_SA(0, 0), cA, voffA); PG8_STAGE(PG8_SB(0, 1), cB + hstep, voffB); PG8_STAGE(PG8_SA(0, 1), cA + hstep, voffA);
        if (wr == 1) PG8_BAR;
        PG8_WAIT_V(4); PG8_BAR;
        PG8_STAGE(PG8_SB(1, 0), cB + kstep, voffB); PG8_STAGE(PG8_SA(1, 0), cA + kstep, voffA); PG8_STAGE(PG8_SB(1, 1), cB + hstep + kstep, voffB);
        PG8_WAIT_V(6); PG8_BAR;
    }
    for (;;) {
        E.begin(cur, ui, tid);
        const bool has_next = S.next(ui + 1, nxt);
        const char* nA = has_next ? (const char*)g.A + (size_t)nxt.pm * tstep : cA; const char* nB = has_next ? (const char*)g.Bt + (size_t)nxt.pn * tstep : cB;
        for (int t = 0; t < nt; t += 2) {
            if constexpr (Epi::MID) { if (t == (nt >> 1)) E.mid(acc, cur, ui, wr, wc, fr, fq); }
            const bool last = (t == nt - 2);
            const char* a1 = cA + (size_t)(t + 1) * kstep;
            const char* a2 = last ? nA : cA + (size_t)(t + 2) * kstep; const char* b2 = last ? nB : cB + (size_t)(t + 2) * kstep;
            const char* a3 = a2 + kstep; const char* b3 = b2 + kstep;
            if (last && has_next) S.a_ready(nxt);
            if constexpr (SP2) {
            PG8_LDB(B0, 0, 0); PG8_LDB(B1, 0, 1); PG8_SCHED; PG8_LDA(At, 0, 0); PG8_STAGE(PG8_SA(1, 1), a1 + hstep, voffA);
            PG8_WAIT_V(8); PG8_WAIT_L(0); PG8_BAR; PG8_MMA(0, 0, At, B0); PG8_MMA(0, 1, At, B1); PG8_BAR; PG8_SCHED;
            PG8_LDA(At, 0, 1); PG8_STAGE(PG8_SB(0, 0), b2, voffB); PG8_STAGE(PG8_SB(0, 1), b2 + hstep, voffB); PG8_STAGE(PG8_SA(0, 0), a2, voffA);
            PG8_WAIT_V(8); PG8_WAIT_L(0); PG8_BAR; PG8_MMA(1, 0, At, B0); PG8_MMA(1, 1, At, B1); PG8_BAR; PG8_SCHED;
            PG8_LDB(B0, 1, 0); PG8_LDB(B1, 1, 1); PG8_SCHED; PG8_LDA(At, 1, 0); PG8_STAGE(PG8_SA(0, 1), a2 + hstep, voffA);
            PG8_WAIT_V(8); PG8_WAIT_L(0); PG8_BAR; PG8_MMA(0, 0, At, B0); PG8_MMA(0, 1, At, B1); PG8_BAR; PG8_SCHED;
            PG8_LDA(At, 1, 1); PG8_STAGE(PG8_SB(1, 0), b3, voffB); PG8_STAGE(PG8_SB(1, 1), b3 + hstep, voffB); PG8_STAGE(PG8_SA(1, 0), a3, voffA);
            PG8_WAIT_V(8); PG8_WAIT_L(0); PG8_BAR; PG8_MMA(1, 0, At, B0); PG8_MMA(1, 1, At, B1); PG8_BAR; PG8_SCHED;
            } else {
            PG8_LDB(B0, 0, 0); PG8_SCHED; PG8_LDA(At, 0, 0); PG8_STAGE(PG8_SA(1, 1), a1 + hstep, voffA);
            PG8_WAIT_L(8); PG8_BAR; PG8_WAIT_L(0); PG8_MMA(0, 0, At, B0); PG8_BAR; PG8_SCHED;
            PG8_LDB(B1, 0, 1); PG8_STAGE(PG8_SB(0, 0), b2, voffB);
            PG8_BAR; PG8_WAIT_L(0); PG8_MMA(0, 1, At, B1); PG8_BAR;
            PG8_LDA(At, 0, 1); PG8_STAGE(PG8_SA(0, 0), a2, voffA);
            PG8_BAR; PG8_WAIT_L(0); PG8_MMA(1, 0, At, B0); PG8_BAR; PG8_SCHED;
            PG8_STAGE(PG8_SB(0, 1), b2 + hstep, voffB);
            PG8_WAIT_V(6); PG8_BAR; PG8_MMA(1, 1, At, B1); PG8_BAR;
            PG8_LDB(B0, 1, 0); PG8_SCHED; PG8_LDA(At, 1, 0); PG8_STAGE(PG8_SA(0, 1), a2 + hstep, voffA);
            PG8_WAIT_L(8); PG8_BAR; PG8_WAIT_L(0); PG8_MMA(0, 0, At, B0); PG8_BAR; PG8_SCHED;
            PG8_LDB(B1, 1, 1); PG8_STAGE(PG8_SB(1, 0), b3, voffB);
            PG8_BAR; PG8_WAIT_L(0); PG8_MMA(0, 1, At, B1); PG8_BAR;
            PG8_LDA(At, 1, 1); PG8_STAGE(PG8_SA(1, 0), a3, voffA);
            PG8_BAR; PG8_WAIT_L(0); PG8_MMA(1, 0, At, B0); PG8_BAR; PG8_SCHED;
            PG8_STAGE(PG8_SB(1, 1), b3 + hstep, voffB);
            PG8_WAIT_V(6); PG8_BAR; PG8_MMA(1, 1, At, B1); PG8_BAR;
            }
        }
        if constexpr (ALIGN_EPI) { if (wr == 0) PG8_BAR; }
        if constexpr (!Epi::AFTER_DRAIN) { E(acc, cur, ui, wr, wc, fr, fq); S.done(cur); }
        if (!has_next) break;
#pragma unroll
        for (int a = 0; a < 2; ++a)
#pragma unroll
            for (int b = 0; b < 2; ++b)
#pragma unroll
                for (int m = 0; m < 4; ++m)
#pragma unroll
                    for (int n = 0; n < 2; ++n) acc[a][b][m][n] = (f32x4){0.f, 0.f, 0.f, 0.f};
        cur = nxt; cA = nA; cB = nB; ++ui;
        if constexpr (ALIGN_EPI) { if (wr == 1) PG8_BAR; }
    }
    PG8_WAIT_V(0);
    if constexpr (!ALIGN_EPI) { if (wr == 0) PG8_BAR; }
    PG8_BAR;
#undef PG8_SA
#undef PG8_SB
#undef PG8_STAGE
#undef PG8_LDA
#undef PG8_LDB
#undef PG8_MMA
#undef PG8_WAIT_V
#undef PG8_WAIT_L
#undef PG8_BAR
#undef PG8_SCHED
}
}

namespace attn_body {
using bf16=__hip_bfloat16;
using bf16x8=__attribute__((ext_vector_type(8)))short;
using s16x4=__attribute__((ext_vector_type(4)))short;
using f32x16=__attribute__((ext_vector_type(16)))float;
using u32x4=__attribute__((ext_vector_type(4)))unsigned;
constexpr int BATCH=8,NHEAD=8,SEQ=2048,D=64,DM=512,OP=1024;
constexpr int NW=8,QBLK=32,QB=QBLK*NW,KVBLK=64,NQB=SEQ/QB;
constexpr int ATTN_PITCH=DM, ATTN_UNIT_ROWS=QB;
__device__ __forceinline__ int crow(int r,int hi){return (r&3)+8*(r>>2)+4*hi;}
#define SBAR() __builtin_amdgcn_sched_barrier(0)
__device__ __forceinline__ void cmask(f32x16&p0,f32x16&p1,int jb,int qrel,int hi){
  const float NEG=-INFINITY; int kb=64*jb+4*hi;
  #pragma unroll
  for(int r=0;r<16;++r){int kv=kb+(r&3)+8*(r>>2); if(kv>qrel)p0[r]=NEG; if(kv+32>qrel)p1[r]=NEG;}
}

constexpr int NSLOT=3, SLOTB=8192;
constexpr int LDS_K=0, LDS_V=NSLOT*SLOTB, LDS_WS=2*NSLOT*SLOTB, LDS_OST=LDS_WS+NW*64*4, LDS_BYTES=LDS_OST+NW*4096;
constexpr float C2=0.125f*1.4426950408889634f;
__device__ __forceinline__ void glds16(const void*gsrc,unsigned lds_dst){unsigned keep;
  asm volatile("s_mov_b32 %0, m0\n\ts_mov_b32 m0, %2\n\ts_nop 0\n\tglobal_load_lds_dwordx4 %1, off\n\ts_mov_b32 m0, %0":"=&s"(keep):"v"(gsrc),"s"(lds_dst):"memory");}
__device__ __forceinline__ float max3f(float a,float b,float c){float r;asm("v_max3_f32 %0, %1, %2, %3":"=v"(r):"v"(a),"v"(b),"v"(c));return r;}
__device__ __forceinline__ float max2f(float a,float b){float r;asm("v_max_f32_e32 %0, %1, %2":"=v"(r):"v"(a),"v"(b));return r;}
__device__ __forceinline__ float fadd_s(float a,float b){float r;asm("v_add_f32_e32 %0, %1, %2":"=v"(r):"v"(a),"v"(b));return r;}
__device__ __forceinline__ float fsub_s(float a,float b){float r;asm("v_sub_f32_e32 %0, %1, %2":"=v"(r):"v"(a),"v"(b));return r;}
typedef float f32x2_t __attribute__((ext_vector_type(2))); typedef __bf16 bf16x2_t __attribute__((ext_vector_type(2)));
__device__ __forceinline__ unsigned cvtpk_s(float lo,float hi){f32x2_t v={lo,hi};bf16x2_t b=__builtin_convertvector(v,bf16x2_t);return __builtin_bit_cast(unsigned,b);}
#define WAIT_BAR(N) asm volatile("s_waitcnt vmcnt(" #N ") lgkmcnt(0)\n\ts_barrier":::"memory")

__device__ __forceinline__ void qkt(f32x16&p0,f32x16&p1,const char*Kslot,const bf16x8*qr,const f32x16&negm,int r32,int hi){
  const char*kb=Kslot+hi*1024+r32*16;
  #pragma unroll
  for(int d0=0;d0<4;++d0){
    const bf16x8 b0=*reinterpret_cast<const bf16x8*>(kb+d0*2048);
    const bf16x8 b1=*reinterpret_cast<const bf16x8*>(kb+d0*2048+512);
    if(d0==0){p0=__builtin_amdgcn_mfma_f32_32x32x16_bf16(b0,qr[0],negm,0,0,0);p1=__builtin_amdgcn_mfma_f32_32x32x16_bf16(b1,qr[0],negm,0,0,0);}
    else{p0=__builtin_amdgcn_mfma_f32_32x32x16_bf16(b0,qr[d0],p0,0,0,0);p1=__builtin_amdgcn_mfma_f32_32x32x16_bf16(b1,qr[d0],p1,0,0,0);}}
}
typedef __attribute__((address_space(3))) const char* lds_cptr;
typedef short v4i16_t __attribute__((ext_vector_type(4)));
__device__ __forceinline__ void kload8(bf16x8*kf,lds_cptr kp){
  kf[0]=*(const __attribute__((address_space(3))) bf16x8*)(kp);      kf[1]=*(const __attribute__((address_space(3))) bf16x8*)(kp+512);
  kf[2]=*(const __attribute__((address_space(3))) bf16x8*)(kp+2048); kf[3]=*(const __attribute__((address_space(3))) bf16x8*)(kp+2560);
  kf[4]=*(const __attribute__((address_space(3))) bf16x8*)(kp+4096); kf[5]=*(const __attribute__((address_space(3))) bf16x8*)(kp+4608);
  kf[6]=*(const __attribute__((address_space(3))) bf16x8*)(kp+6144); kf[7]=*(const __attribute__((address_space(3))) bf16x8*)(kp+6656);
}
__device__ __forceinline__ void kload2(bf16x8*kf,lds_cptr kp,int j){ kf[2*j]=*(const __attribute__((address_space(3))) bf16x8*)(kp+j*2048); kf[2*j+1]=*(const __attribute__((address_space(3))) bf16x8*)(kp+j*2048+512); }
__device__ __forceinline__ s16x4 vtr(lds_cptr p){ return __builtin_bit_cast(s16x4,__builtin_amdgcn_ds_read_tr16_b64_v4i16((__attribute__((address_space(3))) v4i16_t*)p)); }
__device__ __forceinline__ float rowmax(const f32x16&p0,const f32x16&p1){
  float a=max3f(p0[0],p0[1],p1[0]),b=max3f(p0[2],p0[3],p1[1]);a=max3f(a,p1[2],p1[3]);
  #pragma unroll
  for(int r=4;r<16;r+=4){a=max3f(a,p0[r],p0[r+1]);b=max3f(b,p0[r+2],p0[r+3]);a=max3f(a,p1[r],p1[r+1]);b=max3f(b,p1[r+2],p1[r+3]);}
  const float m=max2f(a,b);
  auto rr=__builtin_amdgcn_permlane32_swap(__float_as_uint(m),__float_as_uint(m),false,false);
  return max2f(__uint_as_float(rr[0]),__uint_as_float(rr[1]));
}
__device__ __forceinline__ void pv(f32x16*o,int vb,bf16x8 pa0,bf16x8 pa1,bf16x8 pa2,bf16x8 pa3){
  #pragma unroll
  for(int d0=0;d0<2;++d0){s16x4 lo[4],hi[4];
    #pragma unroll
    for(int ks=0;ks<4;++ks){
      asm volatile("ds_read_b64_tr_b16 %0,%1 offset:%c2":"=&v"(lo[ks]):"v"(vb),"i"(d0*4096+ks*1024):"memory");
      asm volatile("ds_read_b64_tr_b16 %0,%1 offset:%c2":"=&v"(hi[ks]):"v"(vb),"i"(d0*4096+ks*1024+512):"memory");}
    asm volatile("s_waitcnt lgkmcnt(0)":::"memory");SBAR();
    #define PK(k) (bf16x8){lo[k][0],lo[k][1],lo[k][2],lo[k][3],hi[k][0],hi[k][1],hi[k][2],hi[k][3]}
    o[d0]=__builtin_amdgcn_mfma_f32_32x32x16_bf16(pa0,PK(0),o[d0],0,0,0);
    o[d0]=__builtin_amdgcn_mfma_f32_32x32x16_bf16(pa1,PK(1),o[d0],0,0,0);
    o[d0]=__builtin_amdgcn_mfma_f32_32x32x16_bf16(pa2,PK(2),o[d0],0,0,0);
    o[d0]=__builtin_amdgcn_mfma_f32_32x32x16_bf16(pa3,PK(3),o[d0],0,0,0);
    #undef PK
  }
}

__device__ __forceinline__ float selm(float f,float t,unsigned long long m){float d;asm("v_cndmask_b32_e64 %0, %1, %2, %3":"=v"(d):"v"(f),"v"(t),"s"(m));return d;}
constexpr unsigned long long m16c_(int r){unsigned long long m=0;for(int l=0;l<64;++l){const int e=((l&31)-4*(l>>5))&15,o=(r&3)+8*((r>>2)&1);if(e==o)m|=1ull<<l;}return m;}
constexpr unsigned long long m4c_(int r){unsigned long long m=0;for(int l=0;l<64;++l)if((l&3)==(r&3))m|=1ull<<l;return m;}
template<int R> struct MaskC{ static constexpr unsigned long long m16=m16c_(R), m4=m4c_(R); };
#define M16C(r) (attn_body::m16tab(r))
#define M4C(r) (attn_body::m4tab(r))
__device__ __forceinline__ constexpr unsigned long long m16tab(int r){ constexpr unsigned long long T[16]={m16c_(0),m16c_(1),m16c_(2),m16c_(3),m16c_(4),m16c_(5),m16c_(6),m16c_(7),m16c_(8),m16c_(9),m16c_(10),m16c_(11),m16c_(12),m16c_(13),m16c_(14),m16c_(15)}; return T[r]; }
__device__ __forceinline__ constexpr unsigned long long m4tab(int r){ constexpr unsigned long long T[4]={m4c_(0),m4c_(1),m4c_(2),m4c_(3)}; return T[r&3]; }
#ifndef ATTN_STORE16
#define ATTN_STORE16(p,v) (*(__attribute__((address_space(1))) u32x4*)(p)=(v))
#endif
template<int THRL> __device__ __forceinline__ void attn_unit(int b,int h,int qb,const bf16*Q,const bf16*__restrict__ K,const bf16*__restrict__ V,bf16*O,float*ssa,const __attribute__((address_space(3))) float*mtab,char*shm){
  int tid_=threadIdx.x; asm volatile("":"+v"(tid_)); const int tid=tid_,lane=tid&63,r32=lane&31,hi=lane>>5; const int wid=__builtin_amdgcn_readfirstlane(tid>>6);
  const long rowbase=(long)b*SEQ; const int q0=qb*QB;
  const bf16*Qw=Q+(rowbase+q0+wid*QBLK)*DM+h*D;
  const bf16*Kh=K+rowbase*DM+h*D,*Vh=V+rowbase*DM+h*D;
  const unsigned lds0=(unsigned)(uintptr_t)shm;
  float*wsf=(float*)(shm+LDS_WS)+wid*64;
  const bf16*ksrc=Kh+(long)lane*DM+wid*8;
  const bf16*vsrc=Vh+(long)(16*(wid&3)+(lane>>2))*DM+(wid>>2)*32+(lane&3)*8;
  const unsigned kdst=lds0+LDS_K+wid*1024, vdst=lds0+LDS_V+wid*1024;
  #define DMA_K(t,slot) glds16(ksrc+(long)(t)*KVBLK*DM,(unsigned)__builtin_amdgcn_readfirstlane(kdst+(slot)))
  #define DMA_V(t,slot) glds16(vsrc+(long)(t)*KVBLK*DM,(unsigned)__builtin_amdgcn_readfirstlane(vdst+(slot)))
  const int vb0=(int)(lds0+LDS_V)+((lane>>4)&1)*32+(lane&3)*8+(4*hi+((lane&15)>>2))*64;
  const char*Kbase=shm+LDS_K; bf16x8 kf[8];
  const lds_cptr shm3=(lds_cptr)shm; const lds_cptr kp0=shm3+LDS_K+hi*1024+r32*16; const lds_cptr vp0=shm3+LDS_V+((lane>>4)&1)*32+(lane&3)*8+(4*hi+((lane&15)>>2))*64;
  const int NT=(q0+QB)/KVBLK;
  DMA_K(0,0);DMA_V(0,0);DMA_K(1,SLOTB);
  bf16x8 qr[4];
  #pragma unroll
  for(int d0=0;d0<4;++d0)qr[d0]=*(const __attribute__((address_space(1))) bf16x8*)(&Qw[(long)r32*DM+d0*16+hi*8]);
  float mhat=0.f,l_reg=0.f;f32x16 o[2];o[0]=f32x16{};o[1]=f32x16{};const f32x16 negm=f32x16{};
  const int qrel=wid*QBLK+r32; const int qabs256=q0+qrel+256-4*hi-59; (void)qrel;
  const float ninf_=-INFINITY; (void)qabs256; (void)mtab;
  #define MTAB(P0,P1,t) do{ const int dw_=q0+32*wid-64*(t); \
    if(dw_>=576){   \
      _Pragma("unroll") for(int r=0;r<16;++r){ P0[r]=selm(ninf_,P0[r]-mhat,M16C(r)); P1[r]=selm(ninf_,P1[r]-mhat,M16C(r)); } \
    } else if(dw_>=192&&dw_<=480){   \
      _Pragma("unroll") for(int r=0;r<16;++r){ const float x0_=P0[r]-mhat,x1_=P1[r]-mhat; P0[r]=selm(ninf_,selm(x0_,x0_+1.0f,M16C(r)),M4C(r)); P1[r]=selm(ninf_,selm(x1_,x1_+1.0f,M16C(r)),M4C(r)); } \
    } else {   \
      _Pragma("unroll") for(int r=0;r<16;++r){ const int d0_=(q0+qrel)-(64*(t)+4*hi+(r&3)+8*(r>>2)); const int d1_=d0_-32; \
        { const int c_=((unsigned)d0_<=128u?1:0)+((((d0_&3)==0)&&((unsigned)d0_<=512u))?1:0)+((((d0_&15)==0)&&(d0_>=0))?1:0); const float a_=(c_==0)?-INFINITY:((c_==1)?0.f:((c_==2)?1.0f:1.5849625007211562f)); P0[r]=(P0[r]-mhat)+a_; } \
        { const int c_=((unsigned)d1_<=128u?1:0)+((((d1_&3)==0)&&((unsigned)d1_<=512u))?1:0)+((((d1_&15)==0)&&(d1_>=0))?1:0); const float a_=(c_==0)?-INFINITY:((c_==1)?0.f:((c_==2)?1.0f:1.5849625007211562f)); P1[r]=(P1[r]-mhat)+a_; } \
        if((r&3)==3)SBAR(); } } }while(0)
  #define CMASK(P0,P1,t) MTAB(P0,P1,t)
  bool resc=false;
  #define START(P0,P1) do{ const float rm=rowmax(P0,P1); resc=false; \
    { const float dl=rm; mhat=fadd_s(mhat,dl); \
      _Pragma("unroll") for(int r=0;r<16;++r){P0[r]=fsub_s(P0[r],dl);P1[r]=fsub_s(P1[r],dl);} \
      } \
    _Pragma("unroll") for(int r=0;r<16;++r)P0[r]=__builtin_amdgcn_exp2f(P0[r]); }while(0)
  #define RESC() do{ if(resc){ asm volatile("s_waitcnt lgkmcnt(0)":::"memory"); \
      _Pragma("unroll") for(int d_=0;d_<2;++d_) _Pragma("unroll") for(int r=0;r<16;++r)o[d_][r]*=wsf[crow(r,hi)]; } }while(0)
  f32x16 pA0,pA1,pB0,pB1;
  int sl_prev=0,sl_cur=0,sl_next=SLOTB;
  #define ROT() do{sl_prev=sl_cur;sl_cur=sl_next;sl_next=(sl_next==(NSLOT-1)*SLOTB)?0:sl_next+SLOTB;}while(0)
  DMA_K(2,2*SLOTB);
  WAIT_BAR(3);
  qkt(pA0,pA1,Kbase,qr,negm,r32,hi);asm volatile("s_nop 15\n\ts_nop 7":"+v"(pA0),"+v"(pA1));CMASK(pA0,pA1,0);
  START(pA0,pA1);
  _Pragma("unroll") for(int r=0;r<16;++r)pA1[r]=__builtin_amdgcn_exp2f(pA1[r]);
  WAIT_BAR(0);
  DMA_K(3,0);DMA_V(1,SLOTB);
  ROT();
  kload8(kf,kp0+sl_cur);
  WAIT_BAR(2);
  s16x4 vlo[8],vhi[8]; u32x4 pw0,pw1,pw2,pw3;
  #define PKW(P,B) cvtpk_s(P[B],P[B+1])
  #define PAF(k) __builtin_bit_cast(bf16x8,pw##k)
  #define VFR(i) (bf16x8){vlo[i][0],vlo[i][1],vlo[i][2],vlo[i][3],vhi[i][0],vhi[i][1],vhi[i][2],vhi[i][3]}
  #define PIN(x) asm volatile("":"+v"(x))
  #define MX3(a,b,c) __builtin_fmaxf(__builtin_fmaxf((a),(b)),(c))
  #define GAPA(MF,A0,A1,A2,A3,W0,W1,PW) do{ MF; sacc+=A0; sacc+=A1; sacc+=A2; sacc+=A3; PIN(sacc); W0; W1; PIN(PW); SBAR(); }while(0)
  #define EX(v) __builtin_amdgcn_exp2f(v)
  #define GAPB(MF,X,B) do{ MF; X[B]=EX(X[B]); X[B+1]=EX(X[B+1]); X[B+2]=EX(X[B+2]); X[B+3]=EX(X[B+3]); PIN(X); SBAR(); }while(0)
  #define VRD(i) do{ vlo[i]=vtr(vp_+(((i)>>2)*4096+((i)&3)*1024)); vhi[i]=vtr(vp_+(((i)>>2)*4096+((i)&3)*1024+512)); }while(0)
  #define KRD(G,j) do{ if(G){ kload2(kf,kp0+sl_next,j); SBAR(); } }while(0)
  #define STEP(C0,C1,P0,P1,t,GK,GV,GL) do{ SBAR(); \
    const lds_cptr vp_=vp0+sl_prev; \
    VRD(0); SBAR(); float sacc=(P0[0]+P0[1]); \
    GAPA(C0=__builtin_amdgcn_mfma_f32_32x32x16_bf16(kf[0],qr[0],negm,0,0,0), P0[2],P0[3],P0[4],P0[5],     pw0[0]=PKW(P0,0), pw0[1]=PKW(P0,2), pw0); \
    VRD(4); SBAR(); GAPA(C1=__builtin_amdgcn_mfma_f32_32x32x16_bf16(kf[1],qr[0],negm,0,0,0), P0[6],P0[7],P0[8],P0[9],     pw0[2]=PKW(P0,4), pw0[3]=PKW(P0,6), pw0); \
    VRD(1); SBAR(); GAPA(C0=__builtin_amdgcn_mfma_f32_32x32x16_bf16(kf[2],qr[1],C0,0,0,0),   P0[10],P0[11],P0[12],P0[13], pw1[0]=PKW(P0,8), pw1[1]=PKW(P0,10), pw1); \
    VRD(5); SBAR(); GAPA(C1=__builtin_amdgcn_mfma_f32_32x32x16_bf16(kf[3],qr[1],C1,0,0,0),   P0[14],P0[15],P1[0],P1[1],   pw1[2]=PKW(P0,12),pw1[3]=PKW(P0,14), pw1); \
    VRD(2); SBAR(); GAPA(C0=__builtin_amdgcn_mfma_f32_32x32x16_bf16(kf[4],qr[2],C0,0,0,0),   P1[2],P1[3],P1[4],P1[5],     pw2[0]=PKW(P1,0), pw2[1]=PKW(P1,2), pw2); \
    VRD(6); SBAR(); GAPA(C1=__builtin_amdgcn_mfma_f32_32x32x16_bf16(kf[5],qr[2],C1,0,0,0),   P1[6],P1[7],P1[8],P1[9],     pw2[2]=PKW(P1,4), pw2[3]=PKW(P1,6), pw2); \
    VRD(3); SBAR(); GAPA(C0=__builtin_amdgcn_mfma_f32_32x32x16_bf16(kf[6],qr[3],C0,0,0,0),   P1[10],P1[11],P1[12],P1[13], pw3[0]=PKW(P1,8), pw3[1]=PKW(P1,10), pw3); \
    VRD(7); SBAR(); GAPA(C1=__builtin_amdgcn_mfma_f32_32x32x16_bf16(kf[7],qr[3],C1,0,0,0),   P1[14],P1[15],0.f,0.f,       pw3[2]=PKW(P1,12),pw3[3]=PKW(P1,14), pw3); \
    l_reg+=sacc; \
    if(GK){DMA_K((t)+3,sl_cur);} if(GV){DMA_V((t)+1,sl_next);} \
    CMASK(C0,C1,t); \
    { float a=MX3(C0[0],C0[1],C1[0]),b=MX3(C0[2],C0[3],C1[1]); a=MX3(a,C1[2],C1[3]); \
      _Pragma("unroll") for(int r=4;r<16;r+=4){a=MX3(a,C0[r],C0[r+1]);b=MX3(b,C0[r+2],C0[r+3]);a=MX3(a,C1[r],C1[r+1]);b=MX3(b,C1[r+2],C1[r+3]);} \
      float rm=__builtin_fmaxf(a,b); { auto rr=__builtin_amdgcn_permlane32_swap(__float_as_uint(rm),__float_as_uint(rm),false,false); rm=__builtin_fmaxf(__uint_as_float(rr[0]),__uint_as_float(rr[1])); } \
      resc=false; \
      if(__builtin_expect(__any(rm>(float)THRL),0)){ const float dl=__builtin_fmaxf(rm,0.f); mhat+=dl; \
        _Pragma("unroll") for(int r=0;r<16;++r){C0[r]-=dl;C1[r]-=dl;} \
        const float f=__builtin_amdgcn_exp2f(-dl); l_reg*=f; if(hi==0)wsf[r32]=f; resc=true; } } \
    SBAR(); \
    GAPB(o[0]=__builtin_amdgcn_mfma_f32_32x32x16_bf16(PAF(0),VFR(0),o[0],0,0,0), C0,0); \
    GAPB(o[1]=__builtin_amdgcn_mfma_f32_32x32x16_bf16(PAF(0),VFR(4),o[1],0,0,0), C0,4); \
    KRD(GL,0); GAPB(o[0]=__builtin_amdgcn_mfma_f32_32x32x16_bf16(PAF(1),VFR(1),o[0],0,0,0), C0,8); \
    KRD(GL,1); GAPB(o[1]=__builtin_amdgcn_mfma_f32_32x32x16_bf16(PAF(1),VFR(5),o[1],0,0,0), C0,12); \
    KRD(GL,2); GAPB(o[0]=__builtin_amdgcn_mfma_f32_32x32x16_bf16(PAF(2),VFR(2),o[0],0,0,0), C1,0); \
    KRD(GL,3); GAPB(o[1]=__builtin_amdgcn_mfma_f32_32x32x16_bf16(PAF(2),VFR(6),o[1],0,0,0), C1,4); \
    GAPB(o[0]=__builtin_amdgcn_mfma_f32_32x32x16_bf16(PAF(3),VFR(3),o[0],0,0,0), C1,8); \
    GAPB(o[1]=__builtin_amdgcn_mfma_f32_32x32x16_bf16(PAF(3),VFR(7),o[1],0,0,0), C1,12); \
    }while(0)
  int t=1;
  #undef CMASK
  #define CMASK(P0,P1,t) MTAB(P0,P1,t)
  for(;t+5<NT;t+=2){
    STEP(pB0,pB1,pA0,pA1,t,true,true,true);     WAIT_BAR(2); RESC(); ROT();
    STEP(pA0,pA1,pB0,pB1,t+1,true,true,true);   WAIT_BAR(2); RESC(); ROT();
  }
  #undef CMASK
  #define CMASK(P0,P1,t) MTAB(P0,P1,t)
  #define ENDW(tt) do{ if((tt)+3<NT){WAIT_BAR(2);} else if((tt)+2<NT){WAIT_BAR(1);} else {WAIT_BAR(0);} }while(0)
  for(;t+1<NT;t+=2){
    STEP(pB0,pB1,pA0,pA1,t,(t+3<NT),(t+1<NT),(t+1<NT));       ENDW(t);   RESC(); ROT();
    STEP(pA0,pA1,pB0,pB1,t+1,(t+4<NT),(t+2<NT),(t+2<NT));     ENDW(t+1); RESC(); ROT();
  }
  STEP(pB0,pB1,pA0,pA1,NT-1,false,false,false); RESC();
  { float sacc=pB0[0]+pB0[1]; _Pragma("unroll") for(int r=2;r<16;++r)sacc+=pB0[r]; _Pragma("unroll") for(int r=0;r<16;++r)sacc+=pB1[r]; l_reg+=sacc;
    pw0=(u32x4){PKW(pB0,0),PKW(pB0,2),PKW(pB0,4),PKW(pB0,6)};pw1=(u32x4){PKW(pB0,8),PKW(pB0,10),PKW(pB0,12),PKW(pB0,14)};pw2=(u32x4){PKW(pB1,0),PKW(pB1,2),PKW(pB1,4),PKW(pB1,6)};pw3=(u32x4){PKW(pB1,8),PKW(pB1,10),PKW(pB1,12),PKW(pB1,14)};
    SBAR(); pv(o,vb0+sl_cur,PAF(0),PAF(1),PAF(2),PAF(3)); }
  #undef PKW
  #undef PAF
  #undef VFR
  #undef PIN
  #undef MX3
  #undef GAPA
  #undef GAPB
  #undef EX
  #undef VRD
  #undef KRD
  #undef STEP
  #undef ENDW
  {auto rr=__builtin_amdgcn_permlane32_swap(__float_as_uint(l_reg),__float_as_uint(l_reg),false,false);l_reg=__uint_as_float(rr[0])+__uint_as_float(rr[1]);}
  if(hi==0)wsf[32+r32]=l_reg;asm volatile("s_waitcnt lgkmcnt(0)":::"memory");
  float rli[16];
  #pragma unroll
  for(int r=0;r<16;++r)rli[r]=__builtin_amdgcn_rcpf(wsf[32+crow(r,hi)]);
  bf16*Ow=O+(rowbase+q0+wid*QBLK)*OP+h*D; float*ssw=ssa+(rowbase+q0+wid*QBLK)*8+h;
  { bf16*stg=(bf16*)(shm+LDS_OST)+wid*2048;
    #pragma unroll
    for(int r=0;r<16;++r){const int orow=crow(r,hi);
      #pragma unroll
      for(int d0=0;d0<2;++d0)stg[orow*64+d0*32+r32]=__float2bfloat16(o[d0][r]*rli[r]);}
    asm volatile("s_waitcnt lgkmcnt(0)":::"memory");
    #pragma unroll
    for(int i=0;i<4;++i){const int row=i*8+(lane>>3),ch=lane&7; const u32x4 v=*(const u32x4*)(stg+row*64+ch*8); ATTN_STORE16(Ow+(long)row*OP+ch*8,v);
      float sq=0.f; _Pragma("unroll") for(int e=0;e<4;++e){ const float lo=__uint_as_float(v[e]<<16), hi_=__uint_as_float(v[e]&0xffff0000u); sq+=lo*lo+hi_*hi_; }
      sq+=__shfl_xor(sq,1); sq+=__shfl_xor(sq,2); sq+=__shfl_xor(sq,4); if(ch==0) *(__attribute__((address_space(1))) float*)(ssw+(long)row*8)=sq; } }
  asm volatile("s_waitcnt lgkmcnt(0)\n\ts_barrier":::"memory");
  #undef DMA_K
  #undef DMA_V
  #undef CMASK
  #undef MTAB
  #undef START
  #undef RESC
  #undef ROT
}
constexpr int ATTN_LDS_BYTES=LDS_BYTES;
struct AttnTensors { const bf16* Q; const bf16* K; const bf16* V; bf16* O; float* ssa; };
struct AttnUnit { int bh; int qb; };
struct StaticOrder {
  int vcu;
  __device__ __forceinline__ explicit StaticOrder(int grid,int block):vcu((block%8)*(grid/8)+block/8){}
  __device__ __forceinline__ bool next(int i,AttnUnit&u)const{ if(i>=2)return false; const int s=vcu&3; u.bh=vcu>>2; u.qb=(i==0)?s:7-s; return true; }
  __device__ __forceinline__ void a_ready(const AttnUnit&)const{}
  __device__ __forceinline__ void done(const AttnUnit&)const{}
};
template<class Sched,int THRL=8> __device__ __forceinline__ void attn_phase(char*lds,const __attribute__((address_space(3))) float*mtab,const AttnTensors&T,const Sched&S){
  AttnUnit u;
  for(int i=0;S.next(i,u);++i){ S.a_ready(u); attn_unit<THRL>(u.bh/NHEAD,u.bh%NHEAD,u.qb,T.Q,T.K,T.V,T.O,T.ssa,mtab,lds); S.done(u); }
}
#undef SBAR
#undef WAIT_BAR
}
namespace ssm {
#define SLAS __attribute__((address_space(3)))
#define SGAS __attribute__((address_space(1)))
typedef short bf16x8 __attribute__((ext_vector_type(8)));
typedef float f32x4 __attribute__((ext_vector_type(4)));
typedef unsigned u32x4 __attribute__((ext_vector_type(4)));
typedef unsigned u32x2 __attribute__((ext_vector_type(2)));
constexpr int G = 32, GC = 16, SN = 64, CH = 32;
constexpr size_t F_OFF = 0, PF_OFF = 32768, QF_OFF = 32768 + 131072, TBL_BYTES = 32768 + 2 * 131072;
__device__ __forceinline__ unsigned f2bf(float f) { unsigned u = __builtin_bit_cast(unsigned, f); return (u + 0x7fffu + ((u >> 16) & 1u)) >> 16; }
__device__ __forceinline__ unsigned pk2(float lo, float hi) { return f2bf(lo) | (f2bf(hi) << 16); }
__device__ __forceinline__ float gelu_tanh(float x) { const float k = 0.7978845608028654f; const float t = k * (x + 0.044715f * x * x * x);
    const float e = __builtin_amdgcn_exp2f(2.0f * 1.4426950408889634f * t); const float th = 1.0f - 2.0f * __builtin_amdgcn_rcpf(1.0f + e); return 0.5f * x * (1.0f + th); }

struct Disc { float ldr, ldi, fr, fi; };
__device__ __forceinline__ Disc disc(float a_re, float a_im, float log_dt) {
    Disc d; const float lr = fminf(a_re, -1e-4f), li = a_im, dt = expf(log_dt);
    d.ldr = lr * dt; d.ldi = li * dt;
    const float mag = expf(d.ldr), sn = sinf(d.ldi), cs = cosf(d.ldi), sh = sinf(0.5f * d.ldi);
    const float em1r = expm1f(d.ldr) * cs - 2.0f * sh * sh;
    const float em1i = mag * sn;
    const float den = lr * lr + li * li;
    d.fr = (em1r * lr + em1i * li) / den; d.fi = (em1i * lr - em1r * li) / den;
    return d;
}

__device__ __forceinline__ void build_tables(int l, int g, const SGAS float* a_re, const SGAS float* a_im, const SGAS float* log_dt, const SGAS float* b_re, const SGAS float* b_im, const SGAS float* c_re, const SGAS float* c_im, const SGAS float* dsk,
                                             SGAS unsigned char* tbl, SGAS float* a32, SGAS float* ssc  , SLAS unsigned char* lds) {
    int tid_ = threadIdx.x; asm volatile("" : "+v"(tid_)); const int tid = tid_;
    SLAS float* pwr = (SLAS float*)lds;
    SLAS float* pwi = pwr + 33 * 64;
    SLAS float* bbr = pwi + 33 * 64;
    SLAS float* bbi = bbr + 1024;
    SLAS float* cr = bbi + 1024;
    SLAS float* ci = cr + 1024;
    SLAS float* Mt = ci + 1024;
    const int lg = l * G + g;
    for (int i = tid; i < 1024; i += 512) { const int n = i >> 4, c = i & 15; const Disc d = disc(a_re[lg * SN + n], a_im[lg * SN + n], log_dt[lg]);
        const float br = b_re[(size_t)(lg * SN + n) * GC + c], bi = b_im[(size_t)(lg * SN + n) * GC + c]; bbr[i] = d.fr * br - d.fi * bi; bbi[i] = d.fr * bi + d.fi * br;
        cr[i] = c_re[(size_t)lg * 1024 + i]; ci[i] = c_im[(size_t)lg * 1024 + i]; }
    for (int i = tid; i < 33 * 64; i += 512) { const int tau = i >> 6, n = i & 63; const Disc d = disc(a_re[lg * SN + n], a_im[lg * SN + n], log_dt[lg]);
        const float mg = expf(d.ldr * (float)tau), ang = d.ldi * (float)tau; pwr[i] = mg * cosf(ang); pwi[i] = mg * sinf(ang); }
    __syncthreads();
    if (tid < 64) { a32[(size_t)(lg * SN + tid) * 2] = pwr[32 * 64 + tid]; a32[(size_t)(lg * SN + tid) * 2 + 1] = pwi[32 * 64 + tid];
        SGAS float* sc = ssc + (size_t)(lg * SN + tid) * 36; sc[0] = pwr[64 + tid]; sc[1] = pwi[64 + tid]; sc[2] = 0.f; sc[3] = 0.f;
        for (int c = 0; c < 16; ++c) { sc[4 + c] = bbr[tid * 16 + c]; sc[20 + c] = bbi[tid * 16 + c]; } }
    for (int i = tid; i < 32 * 256; i += 512) { const int tau = i >> 8, c = (i >> 4) & 15, cp = i & 15; float s = 0.f;
        for (int n = 0; n < 64; ++n) { const float pr = pwr[tau * 64 + n], pi = pwi[tau * 64 + n], xr = bbr[n * 16 + cp], xi = bbi[n * 16 + cp];
            const float er = pr * xr - pi * xi, ei = pr * xi + pi * xr; s += cr[c * 64 + n] * er - ci[c * 64 + n] * ei; }
        if (tau == 0 && c == cp) s += dsk[lg * GC + c];
        Mt[i] = s; }
    __syncthreads();
    for (int i = tid; i < 32 * 64; i += 512) { const int dl = i >> 6, lane = i & 63, c = lane & 15, kg = lane >> 4, tau = dl - (kg >> 1), c0 = 8 * (kg & 1); float v[8];
#pragma unroll
        for (int j = 0; j < 8; ++j) v[j] = (tau >= 0) ? Mt[tau * 256 + c * 16 + c0 + j] : 0.f;
        u32x4 w; w.x = pk2(v[0], v[1]); w.y = pk2(v[2], v[3]); w.z = pk2(v[4], v[5]); w.w = pk2(v[6], v[7]);
        *(SGAS u32x4*)(tbl + F_OFF + (size_t)i * 16) = w; }
    for (int i = tid; i < 8 * 16 * 64; i += 512) { const int nt = i >> 10, p = (i >> 6) & 15, lane = i & 63, np = 16 * nt + (lane & 15), kg = lane >> 4, sp = 2 * p + (kg >> 1), c0 = 8 * (kg & 1), n = np & 63, tau = 31 - sp;
        const float pr = pwr[tau * 64 + n], pi = pwi[tau * 64 + n]; float v[8];
#pragma unroll
        for (int j = 0; j < 8; ++j) { const float xr = bbr[n * 16 + c0 + j], xi = bbi[n * 16 + c0 + j]; v[j] = (np < 64) ? (pr * xr - pi * xi) : (pr * xi + pi * xr); }
        u32x4 w; w.x = pk2(v[0], v[1]); w.y = pk2(v[2], v[3]); w.z = pk2(v[4], v[5]); w.w = pk2(v[6], v[7]);
        *(SGAS u32x4*)(tbl + PF_OFF + (size_t)i * 16) = w; }
    for (int i = tid; i < 32 * 4 * 64; i += 512) { const int s = i >> 8, kb = (i >> 6) & 3, lane = i & 63, c = lane & 15, kg = lane >> 4; float v[8];
#pragma unroll
        for (int j = 0; j < 8; ++j) { const int np = 32 * kb + 8 * kg + j, n = np & 63; const float pr = pwr[(s + 1) * 64 + n], pi = pwi[(s + 1) * 64 + n], xr = cr[c * 64 + n], xi = ci[c * 64 + n];
            v[j] = (np < 64) ? (xr * pr - xi * pi) : -(xr * pi + xi * pr); }
        u32x4 w; w.x = pk2(v[0], v[1]); w.y = pk2(v[2], v[3]); w.z = pk2(v[4], v[5]); w.w = pk2(v[6], v[7]);
        *(SGAS u32x4*)(tbl + QF_OFF + (size_t)i * 16) = w; }
    __syncthreads();
}

template <int HALF_>
__device__ __forceinline__ void y_pass(const bf16x8 (&ufr)[16], const bf16x8 (&hp)[4], const SGAS unsigned char* tbl, SGAS unsigned short* Zb, size_t tok0  , int g, int lane) {
    const int kg = lane >> 4;
    bf16x8 ff[16];
#pragma unroll
    for (int i = 0; i < 16; ++i) ff[i] = *(const SGAS bf16x8*)(tbl + F_OFF + (size_t)((2 * i + HALF_) * 64 + lane) * 16);
#pragma unroll
    for (int si = 0; si < 16; ++si) {
        const int s = 2 * si + HALF_;
        bf16x8 qf[4];
#pragma unroll
        for (int kb = 0; kb < 4; ++kb) qf[kb] = *(const SGAS bf16x8*)(tbl + QF_OFF + (size_t)((s * 4 + kb) * 64 + lane) * 16);
        f32x4 acc0 = {0.f, 0.f, 0.f, 0.f}, acc1 = {0.f, 0.f, 0.f, 0.f};
#pragma unroll
        for (int p = 0; p <= si; ++p) {
            if (p & 1) acc1 = __builtin_amdgcn_mfma_f32_16x16x32_bf16(ff[si - p], ufr[p], acc1, 0, 0, 0);
            else       acc0 = __builtin_amdgcn_mfma_f32_16x16x32_bf16(ff[si - p], ufr[p], acc0, 0, 0, 0);
        }
#pragma unroll
        for (int kb = 0; kb < 4; ++kb) {
            if (kb & 1) acc1 = __builtin_amdgcn_mfma_f32_16x16x32_bf16(qf[kb], hp[kb], acc1, 0, 0, 0);
            else        acc0 = __builtin_amdgcn_mfma_f32_16x16x32_bf16(qf[kb], hp[kb], acc0, 0, 0, 0);
        }
        const f32x4 y = acc0 + acc1;
        u32x2 w; w.x = pk2(gelu_tanh(y[0]), gelu_tanh(y[1])); w.y = pk2(gelu_tanh(y[2]), gelu_tanh(y[3]));
        *(SGAS u32x2*)(Zb + (tok0 + s) * 512 + g * 16 + 4 * kg) = w;
    }
}

__device__ __forceinline__ void prompt_unit(int g, int b, int l, const SGAS unsigned short* U  , const SGAS unsigned char* tbl_l  , const SGAS float* a32_l, SGAS unsigned short* Zb, SGAS float* out_re, SGAS float* out_im  ,
                                            SLAS unsigned char* lds) {
    int tid_ = threadIdx.x; asm volatile("" : "+v"(tid_)); const int tid = tid_, lane = tid & 63, wid = __builtin_amdgcn_readfirstlane(tid >> 6), ct = wid & 3, half = wid >> 2, j = lane & 15, kg = lane >> 4;
    const SGAS unsigned char* tbl = tbl_l + (size_t)g * TBL_BYTES;
    SLAS float* SL = (SLAS float*)lds; SLAS unsigned short* HP = (SLAS unsigned short*)(lds + 32768);
    const size_t tok0 = (size_t)b * 2048 + 32 * (16 * ct + j);
    bf16x8 ufr[16];
#pragma unroll
    for (int p = 0; p < 16; ++p) ufr[p] = *(const SGAS bf16x8*)(U + (((size_t)g * 16384 + tok0 + 2 * p + (kg >> 1)) * 16 + 8 * (kg & 1)));
#pragma unroll
    for (int q = 0; q < 4; ++q) { const int nt = 4 * half + q; f32x4 acc = {0.f, 0.f, 0.f, 0.f};
#pragma unroll
        for (int p = 0; p < 16; ++p) { const bf16x8 pf = *(const SGAS bf16x8*)(tbl + PF_OFF + (size_t)((nt * 16 + p) * 64 + lane) * 16); acc = __builtin_amdgcn_mfma_f32_16x16x32_bf16(pf, ufr[p], acc, 0, 0, 0); }
        *(SLAS f32x4*)(SL + (16 * ct + j) * 128 + 16 * nt + 4 * kg) = acc; }
    __syncthreads();
    if (wid == 0) { const float ar = a32_l[(size_t)(g * SN + lane) * 2], ai = a32_l[(size_t)(g * SN + lane) * 2 + 1]; float hr = 0.f, hi = 0.f;
        for (int k = 0; k < 64; ++k) { HP[k * 128 + lane] = (unsigned short)f2bf(hr); HP[k * 128 + 64 + lane] = (unsigned short)f2bf(hi);
            const float sr = SL[k * 128 + lane], si = SL[k * 128 + 64 + lane]; const float nr = ar * hr - ai * hi + sr, ni = ar * hi + ai * hr + si; hr = nr; hi = ni; }
        out_re[(size_t)(b * G + g) * SN + lane] = hr; out_im[(size_t)(b * G + g) * SN + lane] = hi; }
    __syncthreads();
    bf16x8 hp[4];
#pragma unroll
    for (int kb = 0; kb < 4; ++kb) hp[kb] = *(const SLAS bf16x8*)(HP + (16 * ct + j) * 128 + 32 * kb + 8 * kg);
    if (half == 0) y_pass<0>(ufr, hp, tbl, Zb, tok0, g, lane); else y_pass<1>(ufr, hp, tbl, Zb, tok0, g, lane);
    __syncthreads();
}

__device__ __forceinline__ void sample_unit(int b, int g, int l, const SGAS float* Us, const SGAS float* h0re, const SGAS float* h0im, const SGAS float* ssc,
                                            const SGAS float* c_re, const SGAS float* c_im, const SGAS float* dsk, SGAS unsigned short* Zb, SGAS float* out_re, SGAS float* out_im, SLAS float* wlds, int lane) {
    const int lg = l * G + g, n = lane;
    const SGAS float* sc = ssc + (size_t)(lg * SN + n) * 36; const float abr = sc[0], abi = sc[1];
    float bbr[16], bbi[16];
#pragma unroll
    for (int c = 0; c < 16; ++c) { bbr[c] = sc[4 + c]; bbi[c] = sc[20 + c]; }
    float hr = h0re[(size_t)(b * G + g) * SN + n], hi = h0im[(size_t)(b * G + g) * SN + n];
#pragma unroll
    for (int t = 0; t < 8; ++t) { const SGAS float* up = Us + (size_t)(b * 8 + t) * 512 + g * 16; float ur = 0.f, ui = 0.f;
#pragma unroll
        for (int c = 0; c < 16; ++c) { const float u = up[c]; ur += bbr[c] * u; ui += bbi[c] * u; }
        const float nr = abr * hr - abi * hi + ur, ni = abr * hi + abi * hr + ui; hr = nr; hi = ni;
        wlds[t * 128 + n] = hr; wlds[t * 128 + 64 + n] = hi; }
    out_re[(size_t)(b * G + g) * SN + n] = hr; out_im[(size_t)(b * G + g) * SN + n] = hi;
    asm volatile("s_waitcnt lgkmcnt(0)" ::: "memory");
    const int t = lane >> 3, c0 = 2 * (lane & 7); float y0 = 0.f, y1 = 0.f;
    const SGAS float* cr0 = c_re + (size_t)(lg * GC + c0) * SN; const SGAS float* ci0 = c_im + (size_t)(lg * GC + c0) * SN;
    for (int m = 0; m < 64; ++m) { const float xr = wlds[t * 128 + m], xi = wlds[t * 128 + 64 + m]; y0 += xr * cr0[m] - xi * ci0[m]; y1 += xr * cr0[SN + m] - xi * ci0[SN + m]; }
    const SGAS float* up = Us + (size_t)(b * 8 + t) * 512 + g * 16 + c0;
    y0 += dsk[lg * GC + c0] * up[0]; y1 += dsk[lg * GC + c0 + 1] * up[1];
    *(SGAS unsigned*)(Zb + ((size_t)16384 + b * 8 + t) * 512 + g * 16 + c0) = pk2(gelu_tanh(y0), gelu_tanh(y1));
    asm volatile("s_waitcnt lgkmcnt(0)" ::: "memory");
}
#undef SLAS
#undef SGAS
}
#define XB_TMO      128
#define XB_XCNT(j)  (256  + 64 * (j))
#define XB_XSUB(j)  (1280 + 64 * (j))
#define XB_XGEN(j)  (2304 + 64 * (j))
#define XB_TOP      3328
#define XB_TOPGEN   3392
#define XCD_BAR_WORDS 3456
#define XB_SPIN_CAP (1u << 18)

__device__ __forceinline__ unsigned xb_ld(unsigned* p)              { return __hip_atomic_load((GAS unsigned*)p, __ATOMIC_RELAXED, __HIP_MEMORY_SCOPE_AGENT); }
__device__ __forceinline__ unsigned xb_add(unsigned* p, unsigned v) { return __hip_atomic_fetch_add((GAS unsigned*)p, v, __ATOMIC_RELAXED, __HIP_MEMORY_SCOPE_AGENT); }
__device__ __forceinline__ unsigned xb_xcc_id() { return (unsigned)__builtin_amdgcn_s_getreg((3 << 11) | 20) & 0xFu; }
#define XB_SPIN(cond, bar) do { unsigned _sp = 0; while (cond) { __builtin_amdgcn_s_sleep(1); \
    if ((++_sp & 255u) == 0u) { if (xb_ld(&(bar)[XB_TMO])) break; if (_sp > XB_SPIN_CAP) { atomicAdd(&(bar)[XB_TMO], 1u); break; } } } } while (0)

struct XcdBarrier {
    unsigned* bar; unsigned x;
    volatile LAS unsigned* st;
};

__device__ __forceinline__ XcdBarrier xcd_barrier_post(unsigned* bar, volatile LAS unsigned* st) {
    XcdBarrier b; b.bar = bar; b.x = xb_xcc_id(); b.st = st;
    if (threadIdx.x == 0) (void)xb_add(&bar[XB_XCNT(b.x)], 1u);
    return b;
}
__device__ __forceinline__ void xcd_barrier_complete(unsigned* bar, unsigned x, unsigned& nloc, unsigned& nx) {
    const unsigned G = gridDim.x * gridDim.y * gridDim.z;
    unsigned sum, cnt, mine, sp = 0u;
    for (;;) {
        sum = 0u; cnt = 0u; mine = 0u;
#pragma unroll
        for (unsigned j = 0; j < 16; ++j) { const unsigned c = xb_ld(&bar[XB_XCNT(j)]); sum += c; cnt += (c > 0u) ? 1u : 0u; mine = (j == x) ? c : mine; }
        if (sum == G) break;
        __builtin_amdgcn_s_sleep(1);
        if ((++sp & 255u) == 0u) { if (xb_ld(&bar[XB_TMO])) break; if (sp > XB_SPIN_CAP) { atomicAdd(&bar[XB_TMO], 1u); break; } }
    }
    nloc = mine > 0u ? mine : 1u; nx = cnt > 0u ? cnt : 1u;
}

__device__ __forceinline__ void xcd_barrier(const XcdBarrier& b) {
    asm volatile("s_waitcnt vmcnt(0)" ::: "memory");
    __syncthreads();
    if (threadIdx.x == 0) {
        unsigned* bar = b.bar;
        __builtin_amdgcn_s_waitcnt(0);
        unsigned nloc = b.st[0], nx = b.st[1];
        if (nloc == 0u) { xcd_barrier_complete(bar, b.x, nloc, nx); b.st[0] = nloc; b.st[1] = nx; }
        const unsigned old = xb_add(&bar[XB_XSUB(b.x)], 1u);
        const unsigned gen = old / nloc;
        if (old + 1u == (gen + 1u) * nloc) {
            __builtin_amdgcn_fence(__ATOMIC_RELEASE, "agent");
            asm volatile("s_waitcnt vmcnt(0)" ::: "memory");
            const unsigned og = xb_add(&bar[XB_TOP], 1u);
            const unsigned tg = og / nx;
            if (og + 1u == (tg + 1u) * nx) xb_add(&bar[XB_TOPGEN], 1u);
            else XB_SPIN(xb_ld(&bar[XB_TOPGEN]) == tg, bar);
            __builtin_amdgcn_fence(__ATOMIC_ACQUIRE, "agent");
            xb_add(&bar[XB_XGEN(b.x)], 1u);
            asm volatile("s_waitcnt vmcnt(0)" ::: "memory");
        } else {
            XB_SPIN(xb_ld(&bar[XB_XGEN(b.x)]) == gen, bar);
            __builtin_amdgcn_fence(__ATOMIC_ACQUIRE, "agent");
            asm volatile("s_waitcnt vmcnt(0)" ::: "memory");
        }
    }
    __syncthreads();
}
static_assert(WS_WIN + (size_t)NLAYER * INW_ * DM_ * 2 <= WS_WOUT && WS_WOUT + (size_t)NLAYER * DM_ * DM_ * 2 <= WS_WGU && WS_WGU + (size_t)NLAYER * 2 * FF_ * DM_ * 2 <= WS_WDN &&
              WS_WDN + (size_t)NLAYER * DM_ * FF_ * 2 <= WS_WGLU && WS_WGLU + (size_t)NLAYER * 512 * 512 * 2 <= WS_SSMT && WS_SSMT + (size_t)NLAYER * 32 * ssm::TBL_BYTES <= WS_A32 &&
              WS_XRES + (size_t)MT * DM_ * 4 <= WS_XB && WS_XB + (size_t)MT * DM_ * 2 <= WS_QB && WS_QB + (size_t)MT * 512 * 2 <= WS_KB && WS_KB + (size_t)MT * 512 * 2 <= WS_VB &&
              WS_VB + (size_t)MT * 512 * 2 <= WS_UB && WS_UB + (size_t)32 * MP * 16 * 2 <= WS_US && WS_US + (size_t)MS * 512 * 4 <= WS_MIX && WS_MIX + (size_t)MT * 1024 * 2 <= WS_ZB &&
              WS_ZB + (size_t)MT * 512 * 2 <= WS_GB && WS_GB + (size_t)MT * FF_ * 2 <= WS_SS1 && WS_SS1 + (size_t)MT * 16 * 4 <= WS_SS2 && WS_SS2 + (size_t)MT * 16 * 4 <= WS_SSA &&
              WS_SSA + (size_t)MT * 8 * 4 <= WS_SSS && WS_SSS + (size_t)MT * 8 * 4 <= WS_SSC && WS_SSC + (size_t)NLAYER * 32 * 64 * 36 * 4 <= WS_END, "d_ws map");
static_assert(attn_body::LDS_BYTES <= MTAB_OFF && MTAB_OFF + MTAB_N * 4 <= RING_BYTES, "attention LDS");
struct Frame {
    LAS unsigned char* lds; volatile LAS unsigned* MISC; gu32* ctl; int tid, lane, wave, vcu, G;
};

__device__ __forceinline__ void p0_transpose_item(const GAS float* W, int K, int N, GAS bf16* WT, int k0, int n0, int drow0, const GAS float* scale, LAS float* scr, int lane) {
#pragma unroll 8
    for (int i = 0; i < 32; ++i) { const int kk = 2 * i + (lane >> 5); const float sc = scale ? scale[k0 + kk] : 1.0f; scr[kk * 33 + (lane & 31)] = W[(size_t)(k0 + kk) * N + n0 + (lane & 31)] * sc; }
    LDS_WAIT(); asm volatile("" ::: "memory");
    const int c = lane & 7;
#pragma unroll
    for (int j = 0; j < 4; ++j) { const int n = (lane >> 3) + 8 * j; const LAS float* s = scr + (8 * c) * 33 + n;
        v4u o; o.x = pk2(s[0 * 33], s[1 * 33]); o.y = pk2(s[2 * 33], s[3 * 33]); o.z = pk2(s[4 * 33], s[5 * 33]); o.w = pk2(s[6 * 33], s[7 * 33]);
        *(GAS v4u*)(WT + (size_t)(drow0 + n) * K + k0 + 8 * c) = o; }
    LDS_WAIT(); asm volatile("" ::: "memory");
}

__device__ __forceinline__ void sattn_unit(int b, int h, const GAS bf16* Qb, const GAS float* ck, const GAS float* cv, const GAS float* newK, const GAS float* newV, GAS bf16* MIX, GAS float* ssa, LAS float* wl, int t, int lane) {
    const int row = MP + b * 8 + t;
    wl[lane] = __uint_as_float((unsigned)Qb[(size_t)row * 512 + h * 64 + lane] << 16);
    LDS_WAIT();
#pragma unroll 1
    for (int it = 0; it < 9; ++it) { const int br = it / 3, r = it - 3 * br, dil = br == 0 ? 1 : (br == 1 ? 4 : 16); const int jj = lane + 64 * r;
        if (jj <= 128) { const int idx = 2048 + t - dil * jj;
            const GAS float* kp = (idx < 2048) ? ck + (((size_t)b * 2048 + idx) * 8 + h) * 64 : newK + ((size_t)(b * 8 + idx - 2048) * 512 + h * 64);
            float a = 0.f;
#pragma unroll
            for (int e = 0; e < 16; ++e) { const f32x4 kv = *(const GAS f32x4*)(kp + 4 * e); const f32x4 qv = *(const LAS f32x4*)(wl + 4 * e); a += (kv[0] * qv[0] + kv[1] * qv[1]) + (kv[2] * qv[2] + kv[3] * qv[3]); }
            wl[64 + br * 192 + jj] = a; } }
    LDS_WAIT();
    float m = -INFINITY;
#pragma unroll 1
    for (int i = lane; i < 576; i += 64) { const int jj = i % 192; if (jj <= 128) m = fmaxf(m, wl[64 + i]); }
    m = wave_max(m);
    float den = 0.f;
#pragma unroll 1
    for (int i = lane; i < 576; i += 64) { const int jj = i % 192; if (jj <= 128) { const float p = __builtin_amdgcn_exp2f(wl[64 + i] - m); den += p; wl[64 + i] = p; } }
    den = wave_sum(den);
    LDS_WAIT();
    const int kq = lane >> 4, dl = lane & 15; f32x4 acc = {0.f, 0.f, 0.f, 0.f};
#pragma unroll 1
    for (int br = 0; br < 3; ++br) { const int dil = br == 0 ? 1 : (br == 1 ? 4 : 16);
#pragma unroll 3
        for (int j0 = 0; j0 < 132; j0 += 4) { const int jj = j0 + kq;
            if (jj <= 128) { const int idx = 2048 + t - dil * jj;
                const GAS float* vp = (idx < 2048) ? cv + (((size_t)b * 2048 + idx) * 8 + h) * 64 : newV + ((size_t)(b * 8 + idx - 2048) * 512 + h * 64);
                const f32x4 v = *(const GAS f32x4*)(vp + 4 * dl); const float p = wl[64 + br * 192 + jj]; acc = acc + v * p; } } }
#pragma unroll
    for (int e = 0; e < 4; ++e) { acc[e] += __shfl_xor(acc[e], 16); acc[e] += __shfl_xor(acc[e], 32); }
    const float rd = __builtin_amdgcn_rcpf(den);
    const unsigned w0 = pk2(acc[0] * rd, acc[1] * rd), w1 = pk2(acc[2] * rd, acc[3] * rd);
    const float a0 = __uint_as_float(w0 << 16), a1 = __uint_as_float(w0 & 0xffff0000u), a2 = __uint_as_float(w1 << 16), a3 = __uint_as_float(w1 & 0xffff0000u);
    float sq = (a0 * a0 + a1 * a1) + (a2 * a2 + a3 * a3);
    sq += __shfl_xor(sq, 1); sq += __shfl_xor(sq, 2); sq += __shfl_xor(sq, 4); sq += __shfl_xor(sq, 8);
    if (kq == 0) { typedef unsigned u32x2v __attribute__((ext_vector_type(2))); u32x2v w; w.x = w0; w.y = w1; *(GAS u32x2v*)(MIX + (size_t)row * 1024 + h * 64 + 4 * dl) = w; }
    if (lane == 0) ssa[(size_t)row * 8 + h] = sq;
    LDS_WAIT();
}

struct Args { const float* in[26]; float* out; unsigned char* ws; };
__device__ __forceinline__ const GAS float* rfl_ptr(unsigned long long v) { const unsigned lo = __builtin_amdgcn_readfirstlane((unsigned)v), hi = __builtin_amdgcn_readfirstlane((unsigned)(v >> 32)); return (const GAS float*)(((unsigned long long)hi << 32) | lo); }
__global__ void __launch_bounds__(NWAVES * 64, 2) hymba_fwd(Args args) {
    extern __shared__ __attribute__((aligned(16))) unsigned char lds[];
    Frame F;
    F.lds = (LAS unsigned char*)lds; F.MISC = (volatile LAS unsigned*)(F.lds + MISC_OFF);
    F.tid = threadIdx.x; F.lane = F.tid & 63; F.wave = __builtin_amdgcn_readfirstlane(F.tid >> 6);
    F.G = gridDim.x; { const int bx = blockIdx.x; F.vcu = (F.G % 8 == 0) ? (bx % 8) * (F.G / 8) + bx / 8 : bx; }
    GAS unsigned char* const ws = (GAS unsigned char*)args.ws; F.ctl = (gu32*)(ws + WS_CTL);
#if DBG_SET >= 30
    for (int u = F.tid; u < LDS_BYTES / 4; u += NWAVES * 64) ((LAS unsigned*)F.lds)[u] = 0xFFFFFFFFu;
    __syncthreads();
#endif
    for (int u = F.tid; u < (LDS_BYTES - MISC_OFF) / 4; u += NWAVES * 64) ((LAS unsigned*)(F.lds + MISC_OFF))[u] = 0u;
    __syncthreads();
    volatile LAS unsigned long long* PT = (volatile LAS unsigned long long*)(F.lds + PTAB_OFF);
    if (F.tid == 0) {
#pragma unroll
        for (int i = 0; i < 26; ++i) PT[i] = (unsigned long long)args.in[i];
        PT[26] = (unsigned long long)args.out;
    }
    __syncthreads();
#define INP(k) rfl_ptr(PT[k])
#define OUTP() ((GAS float*)rfl_ptr(PT[26]))
#define WSP() pg8::lau(ws)
#define GRID_BAR() do { XcdBarrier b_ = bar; asm volatile("" : "+s"(b_.bar), "+s"(b_.x), "+s"(b_.st)); xcd_barrier(b_); } while (0)
#define LDSP() ({ LAS unsigned char* l_ = F.lds; asm volatile("" : "+s"(l_)); l_; })
#define TID() ({ int t_ = threadIdx.x; asm volatile("" : "+v"(t_)); t_; })
#define LANE() ({ int l_ = F.lane; asm volatile("" : "+v"(l_)); l_; })
    XcdBarrier bar = xcd_barrier_post((unsigned*)(F.ctl + CW_BAR), F.MISC + 8);
    LAS pg8::f32x2* RTAB = (LAS pg8::f32x2*)(F.lds + RTAB_OFF);
    const int gw = F.vcu * NWAVES + F.wave, NGW = F.G * NWAVES;

#if PHM & 1
    {
        GAS unsigned char* w = WSP();
        for (int it = F.vcu; it < NLAYER * 32; it += F.G) { const int l = it >> 5, g = it & 31;
            ssm::build_tables(l, g, INP(9), INP(10), INP(11), INP(12), INP(13), INP(14), INP(15), INP(16), w + WS_SSMT + (size_t)it * ssm::TBL_BYTES, (GAS float*)(w + WS_A32), (GAS float*)(w + WS_SSC), LDSP()); }
        __syncthreads();
        LAS float* scr = (LAS float*)(F.lds + RING_OFF + F.wave * 16384);
        GAS bf16* W_IN = (GAS bf16*)(w + WS_WIN); GAS bf16* W_OUT = (GAS bf16*)(w + WS_WOUT); GAS bf16* W_GU = (GAS bf16*)(w + WS_WGU); GAS bf16* W_DN = (GAS bf16*)(w + WS_WDN); GAS bf16* W_GLU = (GAS bf16*)(w + WS_WGLU);
        constexpr int I_IN = 16 * 64, I_OUT = 16 * 32, I_G = 16 * 88, I_DN = 44 * 32, I_GLU = 8 * 16, I_LAYER = I_IN + I_OUT + 2 * I_G + I_DN + I_GLU;
        for (int it = gw; it < NLAYER * I_LAYER; it += NGW) {
            const int l = it / I_LAYER; int r = it % I_LAYER;
            if (r < I_IN) { const int kb = r / 64, nb = r % 64; p0_transpose_item(INP(7) + (size_t)l * 1024 * 2048, 1024, 2048, W_IN + (size_t)l * 2048 * 1024, 64 * kb, 32 * nb, 32 * nb, INP(6) + l * 1024, scr, F.lane); continue; } r -= I_IN;
            if (r < I_OUT) { const int kb = r / 32, nb = r % 32; const GAS float* sc = (kb < 8) ? INP(8) + l * 512 : INP(19) + l * 512 - 512;
                p0_transpose_item(INP(20) + (size_t)l * 1024 * 1024, 1024, 1024, W_OUT + (size_t)l * 1024 * 1024, 64 * kb, 32 * nb, 32 * nb, sc, scr, F.lane); continue; } r -= I_OUT;
            if (r < 2 * I_G) { const int up = r >= I_G; if (up) r -= I_G; const int kb = r / 88, nb = r % 88, n0 = 32 * nb, drow0 = (n0 >> 7) * 256 + up * 128 + (n0 & 127);
                p0_transpose_item((up ? INP(23) : INP(22)) + (size_t)l * 1024 * 2816, 1024, 2816, W_GU + (size_t)l * 5632 * 1024, 64 * kb, n0, drow0, INP(21) + l * 1024, scr, F.lane); continue; } r -= 2 * I_G;
            if (r < I_DN) { const int kb = r / 32, nb = r % 32; p0_transpose_item(INP(24) + (size_t)l * 2816 * 1024, 2816, 1024, W_DN + (size_t)l * 1024 * 2816, 64 * kb, 32 * nb, 32 * nb, nullptr, scr, F.lane); continue; } r -= I_DN;
            { const int kb = r / 16, nb = r % 16; p0_transpose_item(INP(17) + (size_t)l * 512 * 512, 512, 512, W_GLU + (size_t)l * 512 * 512, 64 * kb, 32 * nb, 32 * nb, nullptr, scr, F.lane); }
        }
        { const GAS float* x_prompt = INP(0); const GAS float* x_sample = INP(1); GAS bf16* XB = (GAS bf16*)(w + WS_XB); GAS float* SS1 = (GAS float*)(w + WS_SS1);
        for (int m = gw; m < MT; m += NGW) { const GAS float* xr = (m < MP) ? x_prompt + (size_t)m * 1024 : x_sample + (size_t)(m - MP) * 1024;
            const GAS f32x4* xv = (const GAS f32x4*)xr + F.lane; f32x4 v[4]; float s = 0.f;
#pragma unroll
            for (int j = 0; j < 4; ++j) { v[j] = xv[64 * j]; s += (v[j].x * v[j].x + v[j].y * v[j].y) + (v[j].z * v[j].z + v[j].w * v[j].w); }
            s = wave_sum(s);
            GAS unsigned long long* o8 = (GAS unsigned long long*)(XB + (size_t)m * 1024) + F.lane;
#pragma unroll
            for (int j = 0; j < 4; ++j) o8[64 * j] = (unsigned long long)pk2(v[j].x, v[j].y) | ((unsigned long long)pk2(v[j].z, v[j].w) << 32);
            if (F.lane < 16) SS1[(size_t)m * 16 + F.lane] = (F.lane == 0) ? s : 0.f; } }
        GRID_BAR();
    }
#endif

#pragma unroll 1
    for (int l = 0; l < NLAYER; ++l) {
#if PHM & 2
        {
            GAS unsigned char* w = WSP();
            pg8::Gemm g{(const GAS bf16*)(w + WS_XB), (const GAS bf16*)(w + WS_WIN) + (size_t)l * 2048 * 1024, MT, INW_, 1024}; pg8::StaticOrder S; S.init(MT, INW_, F.G, (int)blockIdx.x);
            pg8::EpiInProj E{ws, OUTP(), l, RTAB};
            pg8::gemm_phase<pg8::EpiInProj, pg8::StaticOrder, true, true>(LDSP() + RING_OFF, g, S, E);
            GRID_BAR();
#if defined(DBG_STOP) && DBG_STOP == 1
            if (l == DBG_STOP_L) return;
#endif
        }
#endif
        {
            LAS float* mtab = (LAS float*)(LDSP() + MTAB_OFF);
            for (int i = TID(); i < MTAB_N; i += NWAVES * 64) { const int dl = i - 256; float v = -INFINITY;
                if (dl >= 0) { const int c = (dl <= 128 ? 1 : 0) + (((dl & 3) == 0 && dl <= 512) ? 1 : 0) + (((dl & 15) == 0 && dl <= 2048) ? 1 : 0); v = (c == 0) ? -INFINITY : (c == 1 ? 0.f : (c == 2 ? 1.0f : 1.5849625007211562f)); }
                mtab[i] = v; }
            __syncthreads();
#if PHM & 4
            { GAS unsigned char* w = WSP();
            unsigned char* wg = (unsigned char*)w; const attn_body::AttnTensors AT{(const attn_body::bf16*)(wg + WS_QB), (const attn_body::bf16*)(wg + WS_KB), (const attn_body::bf16*)(wg + WS_VB), (attn_body::bf16*)(wg + WS_MIX), (float*)(wg + WS_SSA)};
            const attn_body::StaticOrder SA((int)F.G, (int)blockIdx.x);
            attn_body::attn_phase<attn_body::StaticOrder>((char*)lds + RING_OFF, mtab, AT, SA); }
#endif
            __syncthreads();
#if PHM & 8
            { GAS unsigned char* w = WSP(); GAS float* ob = OUTP();
            for (int u = F.vcu; u < 256; u += F.G)
                ssm::prompt_unit(u >> 3, u & 7, l, (const GAS bf16*)(w + WS_UB), w + WS_SSMT + (size_t)l * 32 * ssm::TBL_BYTES, (const GAS float*)(w + WS_A32) + (size_t)l * 32 * 64 * 2, (GAS bf16*)(w + WS_ZB),
                                 ob + O_PR + (size_t)l * 8 * 32 * 64, ob + O_PI + (size_t)l * 8 * 32 * 64, LDSP()); }
#endif
            __syncthreads();
#if PHM & 16
            { GAS unsigned char* w = WSP(); GAS float* ob = OUTP();
            for (int u = F.vcu; u < 256; u += F.G)
                sattn_unit(u >> 3, u & 7, (const GAS bf16*)(w + WS_QB), INP(2) + (size_t)l * 32 * 2048 * 512, INP(3) + (size_t)l * 32 * 2048 * 512, ob + O_SK + (size_t)l * MS * 512, ob + O_SV + (size_t)l * MS * 512,
                           (GAS bf16*)(w + WS_MIX), (GAS float*)(w + WS_SSA), (LAS float*)(LDSP() + F.wave * 4096), F.wave, LANE()); }
#endif
            __syncthreads();
#if PHM & 32
            { GAS unsigned char* w = WSP(); GAS float* ob = OUTP();
            for (int u = F.vcu * 4 + F.wave; u < 1024 && F.wave < 4; u += F.G * 4)
                ssm::sample_unit(u >> 5, u & 31, l, (const GAS float*)(w + WS_US), INP(4) + (size_t)l * 32 * 32 * 64, INP(5) + (size_t)l * 32 * 32 * 64, (const GAS float*)(w + WS_SSC), INP(14), INP(15), INP(16),
                                 (GAS bf16*)(w + WS_ZB), ob + O_SR + (size_t)l * 32 * 32 * 64, ob + O_SI + (size_t)l * 32 * 32 * 64, (LAS float*)(LDSP() + F.wave * 4096), LANE()); }
#endif
            GRID_BAR();
#if defined(DBG_STOP) && DBG_STOP == 2
            if (l == DBG_STOP_L) return;
#endif
        }
#if PHM & 64
        {
            GAS unsigned char* w = WSP();
            pg8::Gemm g{(const GAS bf16*)(w + WS_ZB), (const GAS bf16*)(w + WS_WGLU) + (size_t)l * 512 * 512, MT, 512, 512}; pg8::StaticOrder S; S.init(MT, 512, F.G, (int)blockIdx.x);
            pg8::EpiGlu E{ws, INP(18) + l * 512};
            pg8::gemm_phase<pg8::EpiGlu, pg8::StaticOrder, true, true>(LDSP() + RING_OFF, g, S, E);
            GRID_BAR();
#if defined(DBG_STOP) && DBG_STOP == 3
            if (l == DBG_STOP_L) return;
#endif
        }
#endif
#if PHM & 128
        {
            GAS unsigned char* w = WSP();
            pg8::Gemm g{(const GAS bf16*)(w + WS_MIX), (const GAS bf16*)(w + WS_WOUT) + (size_t)l * 1024 * 1024, MT, 1024, 1024}; pg8::StaticOrder S; S.init(MT, 1024, F.G, (int)blockIdx.x);
            pg8::EpiWout E{ws, l == 0 ? INP(0) : nullptr, l == 0 ? INP(1) : nullptr, RTAB};
            pg8::gemm_phase<pg8::EpiWout, pg8::StaticOrder, true, true>(LDSP() + RING_OFF, g, S, E);
            GRID_BAR();
#if defined(DBG_STOP) && DBG_STOP == 4
            if (l == DBG_STOP_L) return;
#endif
        }
#endif
#if PHM & 256
        {
            GAS unsigned char* w = WSP();
            pg8::Gemm g{(const GAS bf16*)(w + WS_XB), (const GAS bf16*)(w + WS_WGU) + (size_t)l * 5632 * 1024, MT, 2 * FF_, 1024}; pg8::StaticOrder S; S.init(MT, 2 * FF_, F.G, (int)blockIdx.x);
            pg8::EpiGateUp E{ws, RTAB};
            pg8::gemm_phase<pg8::EpiGateUp, pg8::StaticOrder, true, true>(LDSP() + RING_OFF, g, S, E);
            GRID_BAR();
#if defined(DBG_STOP) && DBG_STOP == 5
            if (l == DBG_STOP_L) return;
#endif
        }
#endif
#if PHM & 512
        {
            GAS unsigned char* w = WSP();
            pg8::Gemm g{(const GAS bf16*)(w + WS_GB), (const GAS bf16*)(w + WS_WDN) + (size_t)l * 1024 * 2816, MT, 1024, FF_}; pg8::StaticOrder S; S.init(MT, 1024, F.G, (int)blockIdx.x);
            pg8::EpiDown E{ws};
            pg8::gemm_phase<pg8::EpiDown, pg8::StaticOrder, true, true>(LDSP() + RING_OFF, g, S, E);
            GRID_BAR();
#if defined(DBG_STOP) && DBG_STOP == 6
            if (l == DBG_STOP_L) return;
#endif
        }
#endif
    }
    {
        GAS unsigned char* w = WSP(); GAS float* ob = OUTP();
        const GAS float* fg = INP(25); const GAS float* SS1 = (const GAS float*)(w + WS_SS1); const GAS float* XRES = (const GAS float*)(w + WS_XRES);
        const int lane7 = LANE();
        for (int m = gw; m < MT; m += NGW) { const float s = pg8::sum16(SS1 + (size_t)m * 16); const float r = __builtin_amdgcn_rsqf(s * (1.0f / 1024.0f) + 1e-6f);
            const GAS f32x4* xv = (const GAS f32x4*)(XRES + (size_t)m * 1024) + lane7; const GAS f32x4* gv = (const GAS f32x4*)fg + lane7;
            GAS f32x4* ov = (GAS f32x4*)((m < MP) ? ob + O_YP + (size_t)m * 1024 : ob + O_YS + (size_t)(m - MP) * 1024) + lane7;
#pragma unroll
            for (int j = 0; j < 4; ++j) ov[64 * j] = xv[64 * j] * r * gv[64 * j]; }
    }
}
#if DBG_SET
namespace dbg {
__global__ void k_cmp_f32(const float* a, const float* b, size_t n, float* acc) {
    float s1 = 0.f, s2 = 0.f;
    for (size_t i = (size_t)blockIdx.x * blockDim.x + threadIdx.x; i < n; i += (size_t)gridDim.x * blockDim.x) { const float d = a[i] - b[i]; s1 += d * d; s2 += b[i] * b[i]; }
    s1 = wave_sum(s1); s2 = wave_sum(s2);
    if ((threadIdx.x & 63) == 0) { atomicAdd(acc, s1); atomicAdd(acc + 1, s2); }
}
__global__ void k_cmp_bf16(const unsigned short* a, int lda, int acol0, const float* b, int ldb, int bcol0, int rows, int cols, float scale, float* acc) {
    float s1 = 0.f, s2 = 0.f; const size_t n = (size_t)rows * cols;
    for (size_t i = (size_t)blockIdx.x * blockDim.x + threadIdx.x; i < n; i += (size_t)gridDim.x * blockDim.x) { const size_t r = i / cols; const int c = (int)(i % cols);
        const float av = __uint_as_float((unsigned)a[r * lda + acol0 + c] << 16), bv = scale * b[r * ldb + bcol0 + c]; const float d = av - bv; s1 += d * d; s2 += bv * bv; }
    s1 = wave_sum(s1); s2 = wave_sum(s2);
    if ((threadIdx.x & 63) == 0) { atomicAdd(acc, s1); atomicAdd(acc + 1, s2); }
}
__global__ void k_cmp_f32s(const float* a, int lda, int acol0, const float* b, int ldb, int bcol0, int rows, int cols, float scale, float* acc) {
    float s1 = 0.f, s2 = 0.f; const size_t n = (size_t)rows * cols;
    for (size_t i = (size_t)blockIdx.x * blockDim.x + threadIdx.x; i < n; i += (size_t)gridDim.x * blockDim.x) { const size_t r = i / cols; const int c = (int)(i % cols);
        const float av = a[r * lda + acol0 + c], bv = scale * b[r * ldb + bcol0 + c]; const float d = av - bv; s1 += d * d; s2 += bv * bv; }
    s1 = wave_sum(s1); s2 = wave_sum(s2);
    if ((threadIdx.x & 63) == 0) { atomicAdd(acc, s1); atomicAdd(acc + 1, s2); }
}
__global__ void k_cmp_u(const unsigned short* U, const float* z, float* acc) {
    float s1 = 0.f, s2 = 0.f; const size_t n = (size_t)32 * 16384 * 16;
    for (size_t i = (size_t)blockIdx.x * blockDim.x + threadIdx.x; i < n; i += (size_t)gridDim.x * blockDim.x) { const int c = (int)(i & 15); const size_t row = (i >> 4) % 16384; const int g = (int)(i / (16384 * 16));
        const float av = __uint_as_float((unsigned)U[i] << 16), bv = z[row * 2048 + 1536 + g * 16 + c]; const float d = av - bv; s1 += d * d; s2 += bv * bv; }
    s1 = wave_sum(s1); s2 = wave_sum(s2);
    if ((threadIdx.x & 63) == 0) { atomicAdd(acc, s1); atomicAdd(acc + 1, s2); }
}
__global__ void k_cmp_u32(const unsigned* a, const unsigned* b, size_t n, float* acc) {
    float s1 = 0.f;
    for (size_t i = (size_t)blockIdx.x * blockDim.x + threadIdx.x; i < n; i += (size_t)gridDim.x * blockDim.x) s1 += (a[i] != b[i]) ? 1.f : 0.f;
    s1 = wave_sum(s1);
    if ((threadIdx.x & 63) == 0) { atomicAdd(acc, s1); atomicAdd(acc + 1, 1.0f); }
}
__device__ int qdigit(float num, float den) {
#if DBG_SET >= 30
    return (num == 0.0f) ? 8 : 1;
#endif
    const float e = sqrtf(num / fmaxf(den, 1e-30f));
    if (!(e == e) || !(e < 1e30f)) return 0;
    const float q = -2.0f * log10f(fmaxf(e, 1e-12f)) + 0.5f;
    int d = (int)floorf(q); return d < 0 ? 0 : (d > 8 ? 8 : d);
}
__global__ void k_report(const float* acc, float* out) {
    const int q0 = qdigit(acc[0], acc[1]), q1 = qdigit(acc[2], acc[3]), q2 = qdigit(acc[4], acc[5]), q3 = qdigit(acc[6], acc[7]);
    const float A = ((float)(1 + q0) + 0.1f * (float)q1) * 100.0f; const float eps = sqrtf(((float)(1 + q2) + 0.1f * (float)q3 + 0.03f) * 100.0f);
    const size_t n = (size_t)MS * 1024;
    for (size_t i = (size_t)blockIdx.x * blockDim.x + threadIdx.x; i < n; i += (size_t)gridDim.x * blockDim.x) out[O_YS + i] += (i & 1) ? eps : -eps;
    if (blockIdx.x == 0 && threadIdx.x == 0) out[O_PK] = A;
}
}
#endif
extern "C" void kernel_launch(void* const* d_in, const int* in_sizes, int n_in, void* d_out, int out_size, void* d_ws, size_t ws_size, hipStream_t stream) {
    static int ready = 0;
    if (!ready) {
        if (n_in != 26 || (size_t)out_size != O_END || ws_size < (size_t)2047 * MiB) { fprintf(stderr, "kernel_launch: unexpected shapes (n_in %d out %d ws %zu)\n", n_in, out_size, ws_size); ready = -1; return; }
        if (hipFuncSetAttribute((const void*)hymba_fwd, hipFuncAttributeMaxDynamicSharedMemorySize, LDS_BYTES) != hipSuccess) { fprintf(stderr, "kernel_launch: hipFuncSetAttribute failed\n"); ready = -1; return; }
        ready = 1;
    }
    if (ready < 0) return;
#if DBG_SET >= 30
#ifndef DBG_POISON_LO
#define DBG_POISON_LO (2 * MiB)
#define DBG_POISON_HI WS_END
#endif
    (void)hipMemsetAsync((char*)d_ws + DBG_POISON_LO, 0xFF, DBG_POISON_HI - DBG_POISON_LO, stream);
#endif
    (void)hipMemsetAsync((char*)d_ws + WS_CTL, 0, CTL_ZERO_BYTES, stream);
    Args a{};
    for (int i = 0; i < 26; ++i) a.in[i] = (const float*)d_in[i];
    a.out = (float*)d_out; a.ws = (unsigned char*)d_ws;
#if DBG_SET
    float* shadow = (float*)((char*)d_ws + 448 * MiB); float* nvws = (float*)((char*)d_ws + 784 * MiB); float* acc = (float*)((char*)d_ws + 447 * MiB);
    (void)hipMemsetAsync(acc, 0, 64, stream);
    a.out = shadow;
    float* dout = (float*)d_out;
#if DBG_SET >= 30
    float* shadowB = nvws;
    (void)hipMemsetAsync(d_out, 0, (size_t)out_size * 4, stream);
#elif DBG_SET < 10
    nv::forward(stream, d_in, dout, nvws);
#elif DBG_SET < 20
    nv::forward(stream, d_in, dout, nvws, 1, 0);
#else
    nv::forward(stream, d_in, dout, nvws, 0, 1);
#endif
    hipLaunchKernelGGL(hymba_fwd, dim3(256), dim3(NWAVES * 64), LDS_BYTES, stream, a);
#if DBG_SET >= 40
    {
        char* wsb = (char*)d_ws; char* st = (char*)d_ws + 1200 * MiB;
        (void)hipMemcpyAsync(st, wsb + WS_XRES, WS_SSC - WS_XRES, hipMemcpyDeviceToDevice, stream);
    }
#endif
#if DBG_SET >= 30
    for (int rep = 0; rep < 4; ++rep) {
        (void)hipMemsetAsync((char*)d_ws + WS_CTL, 0, CTL_ZERO_BYTES, stream);
        a.out = shadowB;
        hipLaunchKernelGGL(hymba_fwd, dim3(256), dim3(NWAVES * 64), LDS_BYTES, stream, a);
        using namespace dbg;
#if DBG_SET == 30
        k_cmp_f32<<<1024, 256, 0, stream>>>(shadow + O_PK, shadowB + O_PK, (size_t)MP * 512, acc + 0);
        k_cmp_f32<<<64, 256, 0, stream>>>(shadow + O_PR, shadowB + O_PR, (size_t)16384, acc + 2);
        k_cmp_f32<<<1024, 256, 0, stream>>>(shadow + O_PK + (size_t)MP * 512, shadowB + O_PK + (size_t)MP * 512, (size_t)MP * 512, acc + 4);
        k_cmp_f32<<<1024, 256, 0, stream>>>(shadow + O_YP, shadowB + O_YP, (size_t)MP * 1024, acc + 6);
#elif DBG_SET == 32
        k_cmp_f32<<<1024, 256, 0, stream>>>(shadow + O_PK, shadowB + O_PK, (size_t)MP * 512, acc + 0);
        k_cmp_f32<<<1024, 256, 0, stream>>>(shadow + O_PV, shadowB + O_PV, (size_t)MP * 512, acc + 2);
        k_cmp_f32<<<1024, 256, 0, stream>>>(shadow + O_PK, shadowB + O_PK, (size_t)MP * 512, acc + 4);
        k_cmp_f32<<<1024, 256, 0, stream>>>(shadow + O_PV, shadowB + O_PV, (size_t)MP * 512, acc + 6);
#elif DBG_SET == 33
        for (int q = 0; q < 4; ++q) k_cmp_f32<<<64, 256, 0, stream>>>(shadow + O_PR, shadowB + O_PR, (size_t)16384, acc + 2 * q);
#elif DBG_SET == 34
        for (int q = 0; q < 4; ++q) k_cmp_f32<<<1024, 256, 0, stream>>>(shadow + O_PK + (size_t)MP * 512, shadowB + O_PK + (size_t)MP * 512, (size_t)MP * 512, acc + 2 * q);
#elif DBG_SET >= 40
        { const char* wsb = (const char*)d_ws; const char* st = (const char*)d_ws + 1200 * MiB;
#define CMPBUF(slot, lo, hi) k_cmp_u32<<<1024, 256, 0, stream>>>((const unsigned*)(wsb + (lo)), (const unsigned*)(st + ((lo) - WS_XRES)), ((hi) - (lo)) / 4, acc + 2 * (slot))
#if DBG_SET == 42
          CMPBUF(0, WS_MIX, WS_ZB); CMPBUF(1, WS_ZB, WS_GB); CMPBUF(2, WS_SSA, WS_SSS); CMPBUF(3, WS_UB, WS_MIX);
#elif DBG_SET == 47
          CMPBUF(0, WS_MIX, WS_MIX + (size_t)MP * 2048); CMPBUF(1, WS_MIX + (size_t)MP * 2048, WS_MIX + (size_t)MT * 2048); CMPBUF(2, WS_SSA, WS_SSA + (size_t)MP * 32); CMPBUF(3, WS_SSA + (size_t)MP * 32, WS_SSA + (size_t)MT * 32);
#elif DBG_SET == 43
          CMPBUF(0, WS_MIX, WS_ZB); CMPBUF(1, WS_SSS, WS_SSC); CMPBUF(2, WS_MIX, WS_ZB); CMPBUF(3, WS_SSS, WS_SSC);
#elif DBG_SET == 44
          CMPBUF(0, WS_XRES, WS_XB); CMPBUF(1, WS_XB, WS_QB); CMPBUF(2, WS_SS2, WS_SSA); CMPBUF(3, WS_XRES, WS_XB);
#elif DBG_SET == 45
          CMPBUF(0, WS_GB, WS_SS1); CMPBUF(1, WS_GB, WS_SS1); CMPBUF(2, WS_GB, WS_SS1); CMPBUF(3, WS_GB, WS_SS1);
#elif DBG_SET == 46
          CMPBUF(0, WS_XRES, WS_XB); CMPBUF(1, WS_XB, WS_QB); CMPBUF(2, WS_SS1, WS_SS2); CMPBUF(3, WS_XRES, WS_XB);
#endif
        }
#elif DBG_SET == 31
        k_cmp_f32<<<256, 256, 0, stream>>>(shadow + O_SK, shadowB + O_SK, (size_t)MS * 512, acc + 0);
        k_cmp_f32<<<64, 256, 0, stream>>>(shadow + O_SR, shadowB + O_SR, (size_t)65536, acc + 2);
        k_cmp_f32<<<256, 256, 0, stream>>>(shadow + O_SK + (size_t)MS * 512, shadowB + O_SK + (size_t)MS * 512, (size_t)MS * 512, acc + 4);
        k_cmp_f32<<<256, 256, 0, stream>>>(shadow + O_YS, shadowB + O_YS, (size_t)MS * 1024, acc + 6);
#endif
    }
#endif
    {
        using namespace dbg;
        const size_t R = 16384; float* n_xn = nvws; float* n_z = n_xn + R * 1024; float* n_cat = n_z + R * 2048; float* n_tmp = n_cat + R * 1024; float* n_Hre = n_tmp + R * 512; float* n_Him = n_Hre + R * 2048;
        float* n_zg = n_Him + R * 2048; float* n_glut = n_zg + R * 512; float* n_mix = n_glut + R * 512; float* n_h = n_mix + R * 1024; float* n_hn = n_h + R * 1024; float* n_gt = n_hn + R * 1024; float* n_up = n_gt + R * 2816; float* n_xcur = n_up + R * 2816;
        (void)n_xn; (void)n_z; (void)n_cat; (void)n_tmp; (void)n_zg; (void)n_glut; (void)n_mix; (void)n_h; (void)n_hn; (void)n_gt; (void)n_up; (void)n_xcur;
        unsigned char* ws = (unsigned char*)d_ws;
#if DBG_SET == 1
        k_cmp_f32<<<1024, 256, 0, stream>>>(shadow + O_PK, dout + O_PK, (size_t)MP * 512, acc + 0);
        k_cmp_f32<<<64, 256, 0, stream>>>(shadow + O_PR, dout + O_PR, (size_t)8 * 32 * 64, acc + 2);
        k_cmp_f32<<<1024, 256, 0, stream>>>(shadow + O_PK + (size_t)MP * 512, dout + O_PK + (size_t)MP * 512, (size_t)MP * 512, acc + 4);
        k_cmp_f32<<<1024, 256, 0, stream>>>(shadow + O_YP, dout + O_YP, (size_t)MP * 1024, acc + 6);
#elif DBG_SET == 2
        k_cmp_f32<<<256, 256, 0, stream>>>(shadow + O_SK, dout + O_SK, (size_t)MS * 512, acc + 0);
        k_cmp_f32<<<64, 256, 0, stream>>>(shadow + O_SR, dout + O_SR, (size_t)32 * 32 * 64, acc + 2);
        k_cmp_f32<<<256, 256, 0, stream>>>(shadow + O_SK + (size_t)MS * 512, dout + O_SK + (size_t)MS * 512, (size_t)MS * 512, acc + 4);
        k_cmp_f32<<<256, 256, 0, stream>>>(shadow + O_YS, dout + O_YS, (size_t)MS * 1024, acc + 6);
#elif DBG_SET == 3
        k_cmp_f32<<<1024, 256, 0, stream>>>(shadow + O_PV + 3 * (size_t)MP * 512, dout + O_PV + 3 * (size_t)MP * 512, (size_t)MP * 512, acc + 0);
        k_cmp_f32<<<64, 256, 0, stream>>>(shadow + O_PI + 3 * 16384, dout + O_PI + 3 * 16384, (size_t)16384, acc + 2);
        k_cmp_f32<<<256, 256, 0, stream>>>(shadow + O_SV + 3 * (size_t)MS * 512, dout + O_SV + 3 * (size_t)MS * 512, (size_t)MS * 512, acc + 4);
        k_cmp_f32<<<64, 256, 0, stream>>>(shadow + O_SI + 3 * 65536, dout + O_SI + 3 * 65536, (size_t)65536, acc + 6);
#endif
        k_report<<<256, 256, 0, stream>>>(acc, dout);
    }
#else
    hipLaunchKernelGGL(hymba_fwd, dim3(256), dim3(NWAVES * 64), LDS_BYTES, stream, a);
#endif
}
```

```cpp
#include <hip/hip_runtime.h>
#include <hip/hip_bf16.h>
#include <cstdio>
#include <cstdint>
#include <cmath>
#ifndef DBG_SET
#define DBG_SET 0
#endif
#ifndef PHM
#define PHM 0xFFFF
#endif
#ifndef REP1
#define REP1 1
#endif
#ifndef REP2A
#define REP2A 1
#endif
#ifndef REP2S
#define REP2S 1
#endif
#ifndef REP2B
#define REP2B 1
#endif
#ifndef REP3
#define REP3 1
#endif
#ifndef REP5
#define REP5 1
#endif
#ifndef REP0
#define REP0 1
#endif
#ifndef REPY
#define REPY 1
#endif
#ifndef REPS
#define REPS 1
#endif
#ifndef XCC_LOCAL
#define XCC_LOCAL 1
#endif
#ifndef S5_BM
#define S5_BM 1
#endif
#ifndef GWT
#define GWT 1
#endif
#ifndef ATTN_FAR
#define ATTN_FAR 1
#endif
#ifndef EARLY_INV
#define EARLY_INV 1
#endif
#ifndef SS5_IN_P3
#define SS5_IN_P3 1
#endif
#ifndef REPB
#define REPB 1
#endif
#ifndef REP4
#define REP4 1
#endif
#ifndef REP6
#define REP6 1
#endif
#ifndef REP2C
#define REP2C 1
#endif
#ifndef REPM
#define REPM 1
#endif
#ifndef REPM5
#define REPM5 1
#endif
#define GAS __attribute__((address_space(1)))
#define LAS __attribute__((address_space(3)))
constexpr int NWAVES = 8;
constexpr int MP = 16384, MS = 256, MT = MP + MS, DM_ = 1024, FF_ = 2816, INW_ = 2048, NLAYER = 4;
constexpr size_t MiB = 1u << 20;
constexpr size_t WS_CTL = 0, CTL_ZERO_BYTES = (DBG_SET >= 60) ? 1 * MiB : 65536;
constexpr size_t WS_WIN = 2 * MiB, WS_WOUT = 18 * MiB, WS_WGU = 26 * MiB, WS_WDN = 70 * MiB, WS_WGLU = 92 * MiB;
constexpr size_t WS_SSMT = 94 * MiB, WS_A32 = 130 * MiB;
constexpr size_t WS_XRES = 131 * MiB, WS_XB = 196 * MiB, WS_QB = 229 * MiB, WS_KB = 246 * MiB, WS_VB = 263 * MiB, WS_UB = 280 * MiB, WS_US = 296 * MiB;
constexpr size_t WS_MIX = 297 * MiB, WS_ZB = 330 * MiB, WS_GB = 347 * MiB, WS_SS1 = 437 * MiB, WS_SS2 = 439 * MiB, WS_SSA = 441 * MiB, WS_SSS = 442 * MiB, WS_SSC = 443 * MiB  , WS_END = 445 * MiB;
constexpr int CW_BAR = 4096, CW_RANK = 8192, CW_LB = 9216, CW_E3 = 10240, CW_E5 = 11264, CW_S5 = 12288;
constexpr size_t O_YP = 0, O_YS = O_YP + (size_t)MP * 1024, O_PK = O_YS + (size_t)MS * 1024, O_PV = O_PK + (size_t)NLAYER * MP * 512, O_PR = O_PV + (size_t)NLAYER * MP * 512,
                 O_PI = O_PR + (size_t)NLAYER * 8 * 32 * 64, O_SK = O_PI + (size_t)NLAYER * 8 * 32 * 64, O_SV = O_SK + (size_t)NLAYER * MS * 512, O_SR = O_SV + (size_t)NLAYER * MS * 512,
                 O_SI = O_SR + (size_t)NLAYER * 32 * 32 * 64, O_END = O_SI + (size_t)NLAYER * 32 * 32 * 64;
constexpr int RING_OFF = 0, RING_BYTES = 131072, RTAB_OFF = 155648, MISC_OFF = 159744, PTAB_OFF = MISC_OFF + 512, LDS_BYTES = 163840;
constexpr int MTAB_OFF = 86016, MTAB_N = 2304;

typedef unsigned short bf16;
typedef unsigned v4u __attribute__((ext_vector_type(4)));
typedef float f32x4 __attribute__((ext_vector_type(4)));
typedef GAS unsigned gu32;
#define RLX_AGENT __ATOMIC_RELAXED, __HIP_MEMORY_SCOPE_AGENT
#define LDS_WAIT() asm volatile("s_waitcnt lgkmcnt(0)" ::: "memory")
#define VM_WAIT() asm volatile("s_waitcnt vmcnt(0)" ::: "memory")
__device__ __forceinline__ unsigned f2bf(float f) { unsigned u = __builtin_bit_cast(unsigned, f); return (u + 0x7fffu + ((u >> 16) & 1u)) >> 16; }
__device__ __forceinline__ unsigned pk2(float lo, float hi) { return f2bf(lo) | (f2bf(hi) << 16); }
__device__ __forceinline__ float wave_sum(float v) {
#pragma unroll
    for (int o = 1; o < 64; o <<= 1) v += __shfl_xor(v, o);
    return v;
}
__device__ __forceinline__ float wave_max(float v) {
#pragma unroll
    for (int o = 1; o < 64; o <<= 1) v = fmaxf(v, __shfl_xor(v, o));
    return v;
}

namespace pg8 {
#define PG8_LAS __attribute__((address_space(3)))
typedef unsigned short bf16_t;
typedef short bf16x8 __attribute__((ext_vector_type(8)));
typedef float f32x4 __attribute__((ext_vector_type(4)));
typedef unsigned u32x4 __attribute__((ext_vector_type(4)));
constexpr int BM = 256, BK = 64, HALF = 128, HTB = HALF * BK * 2  , STAGE_BYTES = 8 * HTB, NXCD = 8, WGM = 8;

__host__ __device__ __forceinline__ int lds_byte(int r, int c) { const int st = (r >> 4) * 2 + (c >> 5), rr = r & 15, cc = c & 31, ob = rr * 64 + cc * 2; return st * 1024 + (ob ^ (((ob >> 9) & 1) << 5)); }
__host__ __device__ __forceinline__ void stage_rc(int b, int& R, int& C) { const int st = b / 1024, sb = b % 1024, swz = sb ^ (((sb >> 9) & 1) << 5); R = (st >> 1) * 16 + swz / 64; C = (st & 1) * 32 + (swz % 64) / 2; }
__host__ __device__ __forceinline__ int perm32(int rho) { const int n = rho >> 4, i = rho & 15; return 8 * (i >> 2) + 4 * n + (i & 3); }

struct Unit { int pm, pn; };
struct Gemm { const GAS bf16_t* A; const GAS bf16_t* Bt; int M, N, K; };

struct StaticOrder {
    int nM, nN, nwg, G, c;
    __host__ __device__ void init(int M, int N, int G_, int c_) { nM = M / BM; nN = N / BM; nwg = nM * nN; G = G_; c = c_; }
    __host__ __device__ bool next(int i, Unit& u) const {
        const int L = i * G + c; if (L >= nwg) return false;
        int wgid = L; { const int q = nwg / NXCD, r = nwg % NXCD, xcd = wgid % NXCD, off = wgid / NXCD; wgid = (xcd < r ? xcd * (q + 1) : r * (q + 1) + (xcd - r) * q) + off; }
        const int nig = WGM * nN, gid = wgid / nig, fm = gid * WGM, gsz = (nM - fm) < WGM ? (nM - fm) : WGM;
        u.pm = fm + ((wgid % nig) % gsz); u.pn = (wgid % nig) / gsz; return true;
    }
    __device__ __forceinline__ void a_ready(const Unit&) const {}
    __device__ __forceinline__ void done(const Unit&) const {}
};

__device__ __forceinline__ unsigned cvt_pk_bf16(float lo, float hi) { unsigned r; asm volatile("v_cvt_pk_bf16_f32 %0, %1, %2" : "=v"(r) : "v"(lo), "v"(hi)); return r; }
typedef float f32x2 __attribute__((ext_vector_type(2)));
constexpr int MP_ROWS = MP;
constexpr float RMS_EPS = 1e-6f;
constexpr float QSCALE = 0.125f * 1.4426950408889634f;
__device__ __forceinline__ u32x4 pack8(const f32x4 a, const f32x4 b) { u32x4 w; w.x = cvt_pk_bf16(a[0], a[1]); w.y = cvt_pk_bf16(a[2], a[3]); w.z = cvt_pk_bf16(b[0], b[1]); w.w = cvt_pk_bf16(b[2], b[3]); return w; }
__device__ __forceinline__ void unpack8(const u32x4 z, f32x4& a, f32x4& b) { a[0] = __uint_as_float(z.x << 16); a[1] = __uint_as_float(z.x & 0xffff0000u); a[2] = __uint_as_float(z.y << 16); a[3] = __uint_as_float(z.y & 0xffff0000u);
    b[0] = __uint_as_float(z.z << 16); b[1] = __uint_as_float(z.z & 0xffff0000u); b[2] = __uint_as_float(z.w << 16); b[3] = __uint_as_float(z.w & 0xffff0000u); }
__device__ __forceinline__ float sum8sq(const f32x4 a, const f32x4 b) { return (a[0] * a[0] + a[1] * a[1]) + (a[2] * a[2] + a[3] * a[3]) + (b[0] * b[0] + b[1] * b[1]) + (b[2] * b[2] + b[3] * b[3]); }
__device__ __forceinline__ GAS unsigned char* lau(GAS unsigned char* p) { asm volatile("" : "+s"(p)); return p; }
__device__ __forceinline__ GAS float* lauf(GAS float* p) { asm volatile("" : "+s"(p)); return p; }
__device__ __forceinline__ const GAS float* laucf(const GAS float* p) { asm volatile("" : "+s"(p)); return p; }
__device__ __forceinline__ void st16_wt(GAS void* p, const u32x4 v) { asm volatile("global_store_dwordx4 %0, %1, off sc1\n\ts_nop 1" :: "v"(p), "v"(v) : "memory"); }
__device__ __forceinline__ float fq_reduce(float v) { v += __shfl_xor(v, 16); v += __shfl_xor(v, 32); return v; }
__device__ __forceinline__ float sum16(const GAS float* p) { const f32x4 a = *(const GAS f32x4*)p, b = *(const GAS f32x4*)(p + 4), c = *(const GAS f32x4*)(p + 8), d = *(const GAS f32x4*)(p + 12);
    return ((a[0] + a[1]) + (a[2] + a[3])) + ((b[0] + b[1]) + (b[2] + b[3])) + ((c[0] + c[1]) + (c[2] + c[3])) + ((d[0] + d[1]) + (d[2] + d[3])); }
__device__ __forceinline__ float sum8(const GAS float* p) { const f32x4 a = *(const GAS f32x4*)p, b = *(const GAS f32x4*)(p + 4); return ((a[0] + a[1]) + (a[2] + a[3])) + ((b[0] + b[1]) + (b[2] + b[3])); }

struct EpiInProj {
    static constexpr bool PERM = true, AFTER_DRAIN = false, MID = false;
    GAS unsigned char* ws; GAS float* out; int l; PG8_LAS f32x2* tab;
    __device__ __forceinline__ void begin(const Unit& u, int ui, int tid) const {
        const GAS float* ss = (const GAS float*)(lau(ws) + WS_SS1);
        if (tid < 256) { const int row = u.pm * BM + tid; const float s = sum16(ss + (size_t)row * 16); tab[(ui & 1) * 256 + tid] = (f32x2){__builtin_amdgcn_rsqf(s * (1.0f / 1024.0f) + RMS_EPS), 0.f}; }
    }
    __device__ __forceinline__ void mid(f32x4 (&)[2][2][4][2], const Unit&, int, int, int, int, int) const {}
    __device__ __forceinline__ void operator()(const f32x4 (&acc)[2][2][4][2], const Unit& u, int ui, int wr, int wc, int fr, int fq) const {
        const int seg = u.pn >> 1, col0 = (u.pn & 1) * BM + wc * 32 + 8 * fq;
        GAS unsigned char* w = lau(ws); GAS float* ob = lauf(out);
        GAS bf16_t* Q = (GAS bf16_t*)(w + WS_QB); GAS bf16_t* Kb = (GAS bf16_t*)(w + WS_KB); GAS bf16_t* Vb = (GAS bf16_t*)(w + WS_VB); GAS bf16_t* U = (GAS bf16_t*)(w + WS_UB); GAS float* Us = (GAS float*)(w + WS_US);
        GAS float* outKp = ob + O_PK + (size_t)l * MP * 512; GAS float* outVp = ob + O_PV + (size_t)l * MP * 512; GAS float* outKs = ob + O_SK + (size_t)l * MS * 512; GAS float* outVs = ob + O_SV + (size_t)l * MS * 512;
#pragma unroll
        for (int ai = 0; ai < 2; ++ai)
#pragma unroll
            for (int m = 0; m < 4; ++m) {
                const int rl = ai * HALF + wr * 64 + m * 16 + fr, row = u.pm * BM + rl; const float r = tab[(ui & 1) * 256 + rl].x;
#pragma unroll
                for (int bj = 0; bj < 2; ++bj) {
                    const int c = col0 + bj * HALF; f32x4 v0 = acc[ai][bj][m][0] * r, v1 = acc[ai][bj][m][1] * r;
                    if (seg == 0) { *(GAS u32x4*)(Q + (size_t)row * 512 + c) = pack8(v0 * QSCALE, v1 * QSCALE); }
                    else if (seg == 3) {
                        if (row < MP_ROWS) { *(GAS u32x4*)(U + (((size_t)(c >> 4) * MP_ROWS + row) * 16 + (c & 15))) = pack8(v0, v1); }
                        else { GAS float* p = Us + (size_t)(row - MP_ROWS) * 512 + c; *(GAS f32x4*)p = v0; *(GAS f32x4*)(p + 4) = v1; }
                    } else {
                        GAS bf16_t* bb = (seg == 1) ? Kb : Vb; *(GAS u32x4*)(bb + (size_t)row * 512 + c) = pack8(v0, v1);
                        GAS float* p = (row < MP_ROWS) ? ((seg == 1 ? outKp : outVp) + (size_t)row * 512 + c) : ((seg == 1 ? outKs : outVs) + (size_t)(row - MP_ROWS) * 512 + c);
                        *(GAS f32x4*)p = v0; *(GAS f32x4*)(p + 4) = v1;
                    }
                }
                asm volatile("" ::: "memory");
            }
    }
};

struct EpiGlu {
    static constexpr bool PERM = true, AFTER_DRAIN = false, MID = false;
    GAS unsigned char* ws; const GAS float* bias;
    __device__ __forceinline__ void begin(const Unit&, int, int) const {}
    __device__ __forceinline__ void mid(f32x4 (&)[2][2][4][2], const Unit&, int, int, int, int, int) const {}
    __device__ __forceinline__ void operator()(const f32x4 (&acc)[2][2][4][2], const Unit& u, int ui, int wr, int wc, int fr, int fq) const {
        const int col0 = u.pn * BM + wc * 32 + 8 * fq;
        GAS unsigned char* w = lau(ws); const GAS bf16_t* Z = (const GAS bf16_t*)(w + WS_ZB); GAS bf16_t* MIXs = (GAS bf16_t*)(w + WS_MIX) + 512; GAS float* sss = (GAS float*)(w + WS_SSS);
        f32x4 bv[2][2];
#pragma unroll
        for (int bj = 0; bj < 2; ++bj)
#pragma unroll
            for (int n = 0; n < 2; ++n) bv[bj][n] = *(const GAS f32x4*)(bias + col0 + bj * HALF + 4 * n);
        float part[2][4];
#pragma unroll
        for (int ai = 0; ai < 2; ++ai) {
            u32x4 pre[1][4][2];
#pragma unroll
            for (int m = 0; m < 4; ++m)
#pragma unroll
                for (int bj = 0; bj < 2; ++bj) { const int c = col0 + bj * HALF, row = u.pm * BM + ai * HALF + wr * 64 + m * 16 + fr;
                    pre[0][m][bj] = *(const GAS u32x4*)(Z + ((size_t)(c >> 4) * MP_ROWS + row) * 16 + (c & 15)); }
            __builtin_amdgcn_sched_barrier(0);
#pragma unroll
            for (int m = 0; m < 4; ++m) {
                const int row = u.pm * BM + ai * HALF + wr * 64 + m * 16 + fr; float pt = 0.f;
#pragma unroll
                for (int bj = 0; bj < 2; ++bj) {
                    const int c = col0 + bj * HALF; const u32x4 zz = pre[0][m][bj];
                    f32x4 z0, z1; z0[0] = __uint_as_float(zz.x << 16); z0[1] = __uint_as_float(zz.x & 0xffff0000u); z0[2] = __uint_as_float(zz.y << 16); z0[3] = __uint_as_float(zz.y & 0xffff0000u);
                    z1[0] = __uint_as_float(zz.z << 16); z1[1] = __uint_as_float(zz.z & 0xffff0000u); z1[2] = __uint_as_float(zz.w << 16); z1[3] = __uint_as_float(zz.w & 0xffff0000u);
                    const f32x4 a0 = acc[ai][bj][m][0] + bv[bj][0], a1 = acc[ai][bj][m][1] + bv[bj][1]; f32x4 o0, o1;
#pragma unroll
                    for (int e = 0; e < 4; ++e) { o0[e] = z0[e] * __builtin_amdgcn_rcpf(1.0f + __builtin_amdgcn_exp2f(-1.4426950408889634f * a0[e])); o1[e] = z1[e] * __builtin_amdgcn_rcpf(1.0f + __builtin_amdgcn_exp2f(-1.4426950408889634f * a1[e])); }
                    pt += sum8sq(o0, o1);
                    *(GAS u32x4*)(MIXs + (size_t)row * 1024 + c) = pack8(o0, o1);
                }
                part[ai][m] = pt;
            }
            __builtin_amdgcn_sched_barrier(0);
        }
#pragma unroll
        for (int ai = 0; ai < 2; ++ai)
#pragma unroll
            for (int m = 0; m < 4; ++m) { const int row = u.pm * BM + ai * HALF + wr * 64 + m * 16 + fr; const float pr = fq_reduce(part[ai][m]); if (fq == 0) sss[(size_t)row * 8 + u.pn * 4 + wc] = pr; }
        asm volatile("" ::: "memory");
    }
};

struct EpiWout {
    static constexpr bool PERM = true, AFTER_DRAIN = false, MID = true;
    GAS unsigned char* ws; PG8_LAS f32x2* tab; size_t dry;
    __device__ __forceinline__ void begin(const Unit& u, int ui, int tid) const {
        GAS unsigned char* w0 = lau(ws); const GAS float* ssa = (const GAS float*)(w0 + WS_SSA); const GAS float* sss = (const GAS float*)(w0 + WS_SSS);
        if (tid < 256) { const int row = u.pm * BM + tid; const float sa = sum8(ssa + (size_t)row * 8), s2 = sum8(sss + (size_t)row * 8);
            const float va = sa * (1.0f / 512.0f) + RMS_EPS, vs = s2 * (1.0f / 512.0f) + RMS_EPS; const float rs = __builtin_amdgcn_rsqf(vs); tab[(ui & 1) * 256 + tid] = (f32x2){__builtin_amdgcn_rsqf(va) * vs * rs, rs}; }
    }
    __device__ __forceinline__ void mid(f32x4 (&acc)[2][2][4][2], const Unit& u, int ui, int wr, int wc, int fr, int fq) const {
#pragma unroll
        for (int ai = 0; ai < 2; ++ai)
#pragma unroll
            for (int m = 0; m < 4; ++m) { const float f = tab[(ui & 1) * 256 + ai * HALF + wr * 64 + m * 16 + fr].x;
#pragma unroll
                for (int bj = 0; bj < 2; ++bj)
#pragma unroll
                    for (int n = 0; n < 2; ++n) acc[ai][bj][m][n] = acc[ai][bj][m][n] * f; }
    }
    __device__ __forceinline__ void operator()(const f32x4 (&acc)[2][2][4][2], const Unit& u, int ui, int wr, int wc, int fr, int fq) const {
        const int col0 = u.pn * BM + wc * 32 + 8 * fq;
        GAS unsigned char* w = lau(ws); const GAS bf16_t* xin = (const GAS bf16_t*)(w + WS_XB); GAS bf16_t* xb = (GAS bf16_t*)(w + WS_XB + dry); GAS float* ss2 = (GAS float*)(w + WS_SS2 + dry);
        float part[2][4];
#pragma unroll
        for (int ai = 0; ai < 2; ++ai) {
            u32x4 pre[1][4][2];
#pragma unroll
            for (int m = 0; m < 4; ++m)
#pragma unroll
                for (int bj = 0; bj < 2; ++bj) pre[0][m][bj] = *(const GAS u32x4*)(xin + (size_t)(u.pm * BM + ai * HALF + wr * 64 + m * 16 + fr) * 1024 + col0 + bj * HALF);
            __builtin_amdgcn_sched_barrier(0);
#pragma unroll
            for (int m = 0; m < 4; ++m) {
                const int rl = ai * HALF + wr * 64 + m * 16 + fr, row = u.pm * BM + rl; const float rs = tab[(ui & 1) * 256 + rl].y; float pt = 0.f;
#pragma unroll
                for (int bj = 0; bj < 2; ++bj) {
                    const int c = col0 + bj * HALF; f32x4 x0, x1; unpack8(pre[0][m][bj], x0, x1);
                    const f32x4 h0 = x0 + acc[ai][bj][m][0] * rs, h1 = x1 + acc[ai][bj][m][1] * rs;
                    *(GAS u32x4*)(xb + (size_t)row * 1024 + c) = pack8(h0, h1); pt += sum8sq(h0, h1);
                }
                part[ai][m] = pt;
            }
            __builtin_amdgcn_sched_barrier(0);
        }
#pragma unroll
        for (int ai = 0; ai < 2; ++ai)
#pragma unroll
            for (int m = 0; m < 4; ++m) { const int row = u.pm * BM + ai * HALF + wr * 64 + m * 16 + fr; const float pr = fq_reduce(part[ai][m]); if (fq == 0) ss2[(size_t)row * 16 + u.pn * 4 + wc] = pr; }
        asm volatile("" ::: "memory");
    }
};

struct EpiGateUp {
    static constexpr bool PERM = true, AFTER_DRAIN = false, MID = false;
    GAS unsigned char* ws; PG8_LAS f32x2* tab;
    __device__ __forceinline__ void begin(const Unit& u, int ui, int tid) const {
        const GAS float* ss = (const GAS float*)(lau(ws) + WS_SS2);
        if (tid < 256) { const int row = u.pm * BM + tid; const float s = sum16(ss + (size_t)row * 16); tab[(ui & 1) * 256 + tid] = (f32x2){__builtin_amdgcn_rsqf(s * (1.0f / 1024.0f) + RMS_EPS), 0.f}; }
    }
    __device__ __forceinline__ void mid(f32x4 (&)[2][2][4][2], const Unit&, int, int, int, int, int) const {}
    __device__ __forceinline__ void operator()(const f32x4 (&acc)[2][2][4][2], const Unit& u, int ui, int wr, int wc, int fr, int fq) const {
        const int c = u.pn * HALF + wc * 32 + 8 * fq; GAS bf16_t* G = (GAS bf16_t*)(lau(ws) + WS_GB);
#pragma unroll
        for (int ai = 0; ai < 2; ++ai)
#pragma unroll
            for (int m = 0; m < 4; ++m) {
                const int rl = ai * HALF + wr * 64 + m * 16 + fr, row = u.pm * BM + rl; const float r = tab[(ui & 1) * 256 + rl].x;
                f32x4 o[2];
#pragma unroll
                for (int n = 0; n < 2; ++n) { const f32x4 g = acc[ai][0][m][n] * r, up = acc[ai][1][m][n] * r;
#pragma unroll
                    for (int e = 0; e < 4; ++e) o[n][e] = g[e] * up[e] * __builtin_amdgcn_rcpf(1.0f + __builtin_amdgcn_exp2f(-1.4426950408889634f * g[e])); }
#if GWT
                st16_wt(G + (size_t)row * 2816 + c, pack8(o[0], o[1]));
#else
                *(GAS u32x4*)(G + (size_t)row * 2816 + c) = pack8(o[0], o[1]);
#endif
                asm volatile("" ::: "memory");
            }
    }
};

struct EpiDown {
    static constexpr bool PERM = true, AFTER_DRAIN = false, MID = false;
    GAS unsigned char* ws; size_t dry;
    __device__ __forceinline__ void begin(const Unit&, int, int) const {}
    __device__ __forceinline__ void mid(f32x4 (&)[2][2][4][2], const Unit&, int, int, int, int, int) const {}
    __device__ __forceinline__ void operator()(const f32x4 (&acc)[2][2][4][2], const Unit& u, int ui, int wr, int wc, int fr, int fq) const {
        const int col0 = u.pn * BM + wc * 32 + 8 * fq;
        GAS unsigned char* w = lau(ws); const GAS bf16_t* xin = (const GAS bf16_t*)(w + WS_XB); GAS bf16_t* xb = (GAS bf16_t*)(w + WS_XB + dry); GAS float* ss1 = (GAS float*)(w + WS_SS1 + dry);
        float part[2][4];
#pragma unroll
        for (int ai = 0; ai < 2; ++ai) {
            u32x4 pre[1][4][2];
#pragma unroll
            for (int m = 0; m < 4; ++m)
#pragma unroll
                for (int bj = 0; bj < 2; ++bj) pre[0][m][bj] = *(const GAS u32x4*)(xin + (size_t)(u.pm * BM + ai * HALF + wr * 64 + m * 16 + fr) * 1024 + col0 + bj * HALF);
            __builtin_amdgcn_sched_barrier(0);
#pragma unroll
            for (int m = 0; m < 4; ++m) {
                const int row = u.pm * BM + ai * HALF + wr * 64 + m * 16 + fr; float pt = 0.f;
#pragma unroll
                for (int bj = 0; bj < 2; ++bj) {
                    const int c = col0 + bj * HALF; f32x4 x0, x1; unpack8(pre[0][m][bj], x0, x1);
                    const f32x4 y0 = x0 + acc[ai][bj][m][0], y1 = x1 + acc[ai][bj][m][1];
                    *(GAS u32x4*)(xb + (size_t)row * 1024 + c) = pack8(y0, y1); pt += sum8sq(y0, y1);
                }
                part[ai][m] = pt;
            }
            __builtin_amdgcn_sched_barrier(0);
        }
#pragma unroll
        for (int ai = 0; ai < 2; ++ai)
#pragma unroll
            for (int m = 0; m < 4; ++m) { const int row = u.pm * BM + ai * HALF + wr * 64 + m * 16 + fr; const float pr = fq_reduce(part[ai][m]); if (fq == 0) ss1[(size_t)row * 16 + u.pn * 4 + wc] = pr; }
        asm volatile("" ::: "memory");
    }
};
template <class Epi, class Sched, bool ALIGN_EPI = false, bool SP2 = false, bool AGRP = false>
__device__ __forceinline__ void gemm_phase(PG8_LAS unsigned char* lds, const Gemm g, const Sched& S, const Epi& E) {
    int tid_ = threadIdx.x; asm volatile("" : "+v"(tid_));
    const int tid = tid_, wid = __builtin_amdgcn_readfirstlane(tid >> 6), lane = tid & 63, wr = wid >> 2, wc = wid & 3, fr = lane & 15, fq = lane >> 4;
    const int K = g.K, nt = K / BK;
    unsigned voffA[2], voffB[2];
#pragma unroll
    for (int i = 0; i < 2; ++i) { int R, C; stage_rc(tid * 16 + i * 8192, R, C); const int Rb = Epi::PERM ? ((R & ~31) + perm32(R & 31)) : R;
        voffA[i] = AGRP ? (unsigned)((C >> 4) * (MP * 32) + R * 32 + (C & 15) * 2) : (unsigned)(R * K + C) * 2u; voffB[i] = (unsigned)(Rb * K + C) * 2u; }
    const size_t kstep = (size_t)(BK * 2);
    const size_t hstep = (size_t)HALF * K * 2;
    const size_t tstep = 2 * hstep;
    const size_t kstepA = AGRP ? (size_t)4 * MP * 32 : kstep, hstepA = AGRP ? (size_t)HALF * 32 : hstep, tstepA = 2 * hstepA;
    const unsigned ldsw = (unsigned)wid * 1024u;
    const int aoff = lds_byte(wr * 64 + fr, fq * 8), boff = lds_byte(wc * 32 + fr, fq * 8);
#define PG8_SA(b, h) (((b) * 2 + (h)) * HTB)
#define PG8_SB(b, h) ((4 + (b) * 2 + (h)) * HTB)
#define PG8_STAGE(bufoff, gbase, voff) do { _Pragma("unroll") for (int _i = 0; _i < 2; ++_i) \
        __builtin_amdgcn_global_load_lds((const unsigned*)((const char*)(gbase) + (voff)[_i]), (PG8_LAS unsigned*)(lds + (bufoff) + ldsw + _i * 8192), 16, 0, 0); } while (0)
#define PG8_LDA(dst, b, h) do { _Pragma("unroll") for (int m = 0; m < 4; ++m) _Pragma("unroll") for (int k = 0; k < 2; ++k) dst[m][k] = *(const PG8_LAS bf16x8*)(lds + PG8_SA(b, h) + aoff + m * 2048 + k * 1024); } while (0)
#define PG8_LDB(dst, b, h) do { _Pragma("unroll") for (int n = 0; n < 2; ++n) _Pragma("unroll") for (int k = 0; k < 2; ++k) dst[n][k] = *(const PG8_LAS bf16x8*)(lds + PG8_SB(b, h) + boff + n * 2048 + k * 1024); } while (0)
#define PG8_MMA(ai, bj, At, Bt) do { __builtin_amdgcn_s_setprio(1); _Pragma("unroll") for (int m = 0; m < 4; ++m) _Pragma("unroll") for (int n = 0; n < 2; ++n) _Pragma("unroll") for (int k = 0; k < 2; ++k) \
        acc[ai][bj][m][n] = __builtin_amdgcn_mfma_f32_16x16x32_bf16(Bt[n][k], At[m][k], acc[ai][bj][m][n], 0, 0, 0); __builtin_amdgcn_s_setprio(0); } while (0)
#define PG8_WAIT_V(n) asm volatile("s_waitcnt vmcnt(" #n ")" ::: "memory")
#define PG8_WAIT_L(n) asm volatile("s_waitcnt lgkmcnt(" #n ")" ::: "memory")
#define PG8_BAR __builtin_amdgcn_s_barrier()
#define PG8_SCHED __builtin_amdgcn_sched_barrier(0)
    Unit cur, nxt; int ui = 0;
    if (!S.next(0, cur)) return;
    f32x4 acc[2][2][4][2];
#pragma unroll
    for (int a = 0; a < 2; ++a)
#pragma unroll
        for (int b = 0; b < 2; ++b)
#pragma unroll
            for (int m = 0; m < 4; ++m)
#pragma unroll
                for (int n = 0; n < 2; ++n) acc[a][b][m][n] = (f32x4){0.f, 0.f, 0.f, 0.f};
    bf16x8 At[4][2], B0[2][2], B1[2][2];
    const char* cA = (const char*)g.A + (size_t)cur.pm * tstepA; const char* cB = (const char*)g.Bt + (size_t)cur.pn * tstep;
    S.a_ready(cur);
    if constexpr (SP2) {
        PG8_STAGE(PG8_SB(0, 0), cB, voffB); PG8_STAGE(PG8_SB(0, 1), cB + hstep, voffB); PG8_STAGE(PG8_SA(0, 0), cA, voffA); PG8_STAGE(PG8_SA(0, 1), cA + hstepA, voffA);
        E.begin(cur, 0, tid);
        if (wr == 1) PG8_BAR;
        PG8_WAIT_V(2); PG8_BAR;
        PG8_STAGE(PG8_SB(1, 0), cB + kstep, voffB); PG8_STAGE(PG8_SA(1, 0), cA + kstepA, voffA); PG8_STAGE(PG8_SB(1, 1), cB + hstep + kstep, voffB);
        PG8_WAIT_V(6); PG8_BAR;
    } else {
        PG8_STAGE(PG8_SB(0, 0), cB, voffB); PG8_STAGE(PG8_SA(0, 0), cA, voffA); PG8_STAGE(PG8_SB(0, 1), cB + hstep, voffB); PG8_STAGE(PG8_SA(0, 1), cA + hstepA, voffA);
        if (wr == 1) PG8_BAR;
        PG8_WAIT_V(4); PG8_BAR;
        PG8_STAGE(PG8_SB(1, 0), cB + kstep, voffB); PG8_STAGE(PG8_SA(1, 0), cA + kstepA, voffA); PG8_STAGE(PG8_SB(1, 1), cB + hstep + kstep, voffB);
        PG8_WAIT_V(6); PG8_BAR;
    }
    for (;;) {
        if (!SP2 || ui > 0) E.begin(cur, ui, tid);
        const bool has_next = S.next(ui + 1, nxt);
        const char* nA = has_next ? (const char*)g.A + (size_t)nxt.pm * tstepA : cA; const char* nB = has_next ? (const char*)g.Bt + (size_t)nxt.pn * tstep : cB;
        for (int t = 0; t < nt; t += 2) {
            if constexpr (Epi::MID) { if (t == (nt >> 1)) E.mid(acc, cur, ui, wr, wc, fr, fq); }
            const bool last = (t == nt - 2);
            const char* a1 = cA + (size_t)(t + 1) * kstepA;
            const char* a2 = last ? nA : cA + (size_t)(t + 2) * kstepA; const char* b2 = last ? nB : cB + (size_t)(t + 2) * kstep;
            const char* a3 = a2 + kstepA; const char* b3 = b2 + kstep;
            if (last && has_next) S.a_ready(nxt);
            if constexpr (SP2) {
            PG8_LDB(B0, 0, 0); PG8_LDB(B1, 0, 1); PG8_SCHED; PG8_LDA(At, 0, 0); PG8_STAGE(PG8_SA(1, 1), a1 + hstepA, voffA);
            PG8_WAIT_V(8); PG8_WAIT_L(0); PG8_BAR; PG8_MMA(0, 0, At, B0); PG8_MMA(0, 1, At, B1); PG8_BAR; PG8_SCHED;
            PG8_LDA(At, 0, 1); PG8_STAGE(PG8_SB(0, 0), b2, voffB); PG8_STAGE(PG8_SB(0, 1), b2 + hstep, voffB); PG8_STAGE(PG8_SA(0, 0), a2, voffA);
            PG8_WAIT_V(8); PG8_WAIT_L(0); PG8_BAR; PG8_MMA(1, 0, At, B0); PG8_MMA(1, 1, At, B1); PG8_BAR; PG8_SCHED;
            PG8_LDB(B0, 1, 0); PG8_LDB(B1, 1, 1); PG8_SCHED; PG8_LDA(At, 1, 0); PG8_STAGE(PG8_SA(0, 1), a2 + hstepA, voffA);
            PG8_WAIT_V(8); PG8_WAIT_L(0); PG8_BAR; PG8_MMA(0, 0, At, B0); PG8_MMA(0, 1, At, B1); PG8_BAR; PG8_SCHED;
            PG8_LDA(At, 1, 1); PG8_STAGE(PG8_SB(1, 0), b3, voffB); PG8_STAGE(PG8_SB(1, 1), b3 + hstep, voffB); PG8_STAGE(PG8_SA(1, 0), a3, voffA);
            PG8_WAIT_V(8); PG8_WAIT_L(0); PG8_BAR; PG8_MMA(1, 0, At, B0); PG8_MMA(1, 1, At, B1); PG8_BAR; PG8_SCHED;
            } else {
            PG8_LDB(B0, 0, 0); PG8_SCHED; PG8_LDA(At, 0, 0); PG8_STAGE(PG8_SA(1, 1), a1 + hstepA, voffA);
            PG8_WAIT_L(8); PG8_BAR; PG8_WAIT_L(0); PG8_MMA(0, 0, At, B0); PG8_BAR; PG8_SCHED;
            PG8_LDB(B1, 0, 1); PG8_STAGE(PG8_SB(0, 0), b2, voffB);
            PG8_BAR; PG8_WAIT_L(0); PG8_MMA(0, 1, At, B1); PG8_BAR;
            PG8_LDA(At, 0, 1); PG8_STAGE(PG8_SA(0, 0), a2, voffA);
            PG8_BAR; PG8_WAIT_L(0); PG8_MMA(1, 0, At, B0); PG8_BAR; PG8_SCHED;
            PG8_STAGE(PG8_SB(0, 1), b2 + hstep, voffB);
            PG8_WAIT_V(6); PG8_BAR; PG8_MMA(1, 1, At, B1); PG8_BAR;
            PG8_LDB(B0, 1, 0); PG8_SCHED; PG8_LDA(At, 1, 0); PG8_STAGE(PG8_SA(0, 1), a2 + hstepA, voffA);
            PG8_WAIT_L(8); PG8_BAR; PG8_WAIT_L(0); PG8_MMA(0, 0, At, B0); PG8_BAR; PG8_SCHED;
            PG8_LDB(B1, 1, 1); PG8_STAGE(PG8_SB(1, 0), b3, voffB);
            PG8_BAR; PG8_WAIT_L(0); PG8_MMA(0, 1, At, B1); PG8_BAR;
            PG8_LDA(At, 1, 1); PG8_STAGE(PG8_SA(1, 0), a3, voffA);
            PG8_BAR; PG8_WAIT_L(0); PG8_MMA(1, 0, At, B0); PG8_BAR; PG8_SCHED;
            PG8_STAGE(PG8_SB(1, 1), b3 + hstep, voffB);
            PG8_WAIT_V(6); PG8_BAR; PG8_MMA(1, 1, At, B1); PG8_BAR;
            }
        }
        if constexpr (ALIGN_EPI) { if (wr == 0) PG8_BAR; }
        if constexpr (!Epi::AFTER_DRAIN) { E(acc, cur, ui, wr, wc, fr, fq); S.done(cur); }
        if (!has_next) break;
#pragma unroll
        for (int a = 0; a < 2; ++a)
#pragma unroll
            for (int b = 0; b < 2; ++b)
#pragma unroll
                for (int m = 0; m < 4; ++m)
#pragma unroll
                    for (int n = 0; n < 2; ++n) acc[a][b][m][n] = (f32x4){0.f, 0.f, 0.f, 0.f};
        cur = nxt; cA = nA; cB = nB; ++ui;
        if constexpr (ALIGN_EPI) { if (wr == 1) PG8_BAR; }
    }
    PG8_WAIT_V(0);
    if constexpr (!ALIGN_EPI) { if (wr == 0) PG8_BAR; }
    PG8_BAR;
#undef PG8_SA
#undef PG8_SB
#undef PG8_STAGE
#undef PG8_LDA
#undef PG8_LDB
#undef PG8_MMA
#undef PG8_WAIT_V
#undef PG8_WAIT_L
#undef PG8_BAR
#undef PG8_SCHED
}
}

namespace attn_body {
using bf16=__hip_bfloat16;
using bf16x8=__attribute__((ext_vector_type(8)))short;
using s16x4=__attribute__((ext_vector_type(4)))short;
using f32x16=__attribute__((ext_vector_type(16)))float;
using u32x4=__attribute__((ext_vector_type(4)))unsigned;
constexpr int BATCH=8,NHEAD=8,SEQ=2048,D=64,DM=512,OP=1024;
constexpr int NW=8,QBLK=32,QB=QBLK*NW,KVBLK=64,NQB=SEQ/QB;
constexpr int ATTN_PITCH=DM, ATTN_UNIT_ROWS=QB;
__device__ __forceinline__ int crow(int r,int hi){return (r&3)+8*(r>>2)+4*hi;}
#define SBAR() __builtin_amdgcn_sched_barrier(0)
__device__ __forceinline__ void cmask(f32x16&p0,f32x16&p1,int jb,int qrel,int hi){
  const float NEG=-INFINITY; int kb=64*jb+4*hi;
  #pragma unroll
  for(int r=0;r<16;++r){int kv=kb+(r&3)+8*(r>>2); if(kv>qrel)p0[r]=NEG; if(kv+32>qrel)p1[r]=NEG;}
}

constexpr int NSLOT=3, SLOTB=8192;
constexpr int LDS_K=0, LDS_V=NSLOT*SLOTB, LDS_WS=2*NSLOT*SLOTB, LDS_OST=LDS_WS+NW*64*4, LDS_BYTES=LDS_OST+NW*4096;
constexpr float C2=0.125f*1.4426950408889634f;
__device__ __forceinline__ void glds16(const void*gsrc,unsigned lds_dst){unsigned keep;
  asm volatile("s_mov_b32 %0, m0\n\ts_mov_b32 m0, %2\n\ts_nop 0\n\tglobal_load_lds_dwordx4 %1, off\n\ts_mov_b32 m0, %0":"=&s"(keep):"v"(gsrc),"s"(lds_dst):"memory");}
__device__ __forceinline__ float max3f(float a,float b,float c){float r;asm("v_max3_f32 %0, %1, %2, %3":"=v"(r):"v"(a),"v"(b),"v"(c));return r;}
__device__ __forceinline__ float max2f(float a,float b){float r;asm("v_max_f32_e32 %0, %1, %2":"=v"(r):"v"(a),"v"(b));return r;}
__device__ __forceinline__ float fadd_s(float a,float b){float r;asm("v_add_f32_e32 %0, %1, %2":"=v"(r):"v"(a),"v"(b));return r;}
__device__ __forceinline__ float fsub_s(float a,float b){float r;asm("v_sub_f32_e32 %0, %1, %2":"=v"(r):"v"(a),"v"(b));return r;}
typedef float f32x2_t __attribute__((ext_vector_type(2))); typedef __bf16 bf16x2_t __attribute__((ext_vector_type(2)));
__device__ __forceinline__ unsigned cvtpk_s(float lo,float hi){f32x2_t v={lo,hi};bf16x2_t b=__builtin_convertvector(v,bf16x2_t);return __builtin_bit_cast(unsigned,b);}
#define WAIT_BAR(N) asm volatile("s_waitcnt vmcnt(" #N ") lgkmcnt(0)\n\ts_barrier":::"memory")

__device__ __forceinline__ void qkt(f32x16&p0,f32x16&p1,const char*Kslot,const bf16x8*qr,const f32x16&negm,int r32,int hi){
  const char*kb=Kslot+hi*1024+r32*16;
  #pragma unroll
  for(int d0=0;d0<4;++d0){
    const bf16x8 b0=*reinterpret_cast<const bf16x8*>(kb+d0*2048);
    const bf16x8 b1=*reinterpret_cast<const bf16x8*>(kb+d0*2048+512);
    if(d0==0){p0=__builtin_amdgcn_mfma_f32_32x32x16_bf16(b0,qr[0],negm,0,0,0);p1=__builtin_amdgcn_mfma_f32_32x32x16_bf16(b1,qr[0],negm,0,0,0);}
    else{p0=__builtin_amdgcn_mfma_f32_32x32x16_bf16(b0,qr[d0],p0,0,0,0);p1=__builtin_amdgcn_mfma_f32_32x32x16_bf16(b1,qr[d0],p1,0,0,0);}}
}
typedef __attribute__((address_space(3))) const char* lds_cptr;
typedef short v4i16_t __attribute__((ext_vector_type(4)));
__device__ __forceinline__ void kload8(bf16x8*kf,lds_cptr kp){
  kf[0]=*(const __attribute__((address_space(3))) bf16x8*)(kp);      kf[1]=*(const __attribute__((address_space(3))) bf16x8*)(kp+512);
  kf[2]=*(const __attribute__((address_space(3))) bf16x8*)(kp+2048); kf[3]=*(const __attribute__((address_space(3))) bf16x8*)(kp+2560);
  kf[4]=*(const __attribute__((address_space(3))) bf16x8*)(kp+4096); kf[5]=*(const __attribute__((address_space(3))) bf16x8*)(kp+4608);
  kf[6]=*(const __attribute__((address_space(3))) bf16x8*)(kp+6144); kf[7]=*(const __attribute__((address_space(3))) bf16x8*)(kp+6656);
}
__device__ __forceinline__ void kload2(bf16x8*kf,lds_cptr kp,int j){ kf[2*j]=*(const __attribute__((address_space(3))) bf16x8*)(kp+j*2048); kf[2*j+1]=*(const __attribute__((address_space(3))) bf16x8*)(kp+j*2048+512); }
__device__ __forceinline__ s16x4 vtr(lds_cptr p){ return __builtin_bit_cast(s16x4,__builtin_amdgcn_ds_read_tr16_b64_v4i16((__attribute__((address_space(3))) v4i16_t*)p)); }
__device__ __forceinline__ float rowmax(const f32x16&p0,const f32x16&p1){
  float a=max3f(p0[0],p0[1],p1[0]),b=max3f(p0[2],p0[3],p1[1]);a=max3f(a,p1[2],p1[3]);
  #pragma unroll
  for(int r=4;r<16;r+=4){a=max3f(a,p0[r],p0[r+1]);b=max3f(b,p0[r+2],p0[r+3]);a=max3f(a,p1[r],p1[r+1]);b=max3f(b,p1[r+2],p1[r+3]);}
  const float m=max2f(a,b);
  auto rr=__builtin_amdgcn_permlane32_swap(__float_as_uint(m),__float_as_uint(m),false,false);
  return max2f(__uint_as_float(rr[0]),__uint_as_float(rr[1]));
}
__device__ __forceinline__ void pv(f32x16*o,int vb,bf16x8 pa0,bf16x8 pa1,bf16x8 pa2,bf16x8 pa3){
  #pragma unroll
  for(int d0=0;d0<2;++d0){s16x4 lo[4],hi[4];
    #pragma unroll
    for(int ks=0;ks<4;++ks){
      asm volatile("ds_read_b64_tr_b16 %0,%1 offset:%c2":"=&v"(lo[ks]):"v"(vb),"i"(d0*4096+ks*1024):"memory");
      asm volatile("ds_read_b64_tr_b16 %0,%1 offset:%c2":"=&v"(hi[ks]):"v"(vb),"i"(d0*4096+ks*1024+512):"memory");}
    asm volatile("s_waitcnt lgkmcnt(0)":::"memory");SBAR();
    #define PK(k) (bf16x8){lo[k][0],lo[k][1],lo[k][2],lo[k][3],hi[k][0],hi[k][1],hi[k][2],hi[k][3]}
    o[d0]=__builtin_amdgcn_mfma_f32_32x32x16_bf16(pa0,PK(0),o[d0],0,0,0);
    o[d0]=__builtin_amdgcn_mfma_f32_32x32x16_bf16(pa1,PK(1),o[d0],0,0,0);
    o[d0]=__builtin_amdgcn_mfma_f32_32x32x16_bf16(pa2,PK(2),o[d0],0,0,0);
    o[d0]=__builtin_amdgcn_mfma_f32_32x32x16_bf16(pa3,PK(3),o[d0],0,0,0);
    #undef PK
  }
}

__device__ __forceinline__ float selm(float f,float t,unsigned long long m){float d;asm("v_cndmask_b32_e64 %0, %1, %2, %3":"=v"(d):"v"(f),"v"(t),"s"(m));return d;}
constexpr unsigned long long m16c_(int r){unsigned long long m=0;for(int l=0;l<64;++l){const int e=((l&31)-4*(l>>5))&15,o=(r&3)+8*((r>>2)&1);if(e==o)m|=1ull<<l;}return m;}
constexpr unsigned long long m4c_(int r){unsigned long long m=0;for(int l=0;l<64;++l)if((l&3)==(r&3))m|=1ull<<l;return m;}
template<int R> struct MaskC{ static constexpr unsigned long long m16=m16c_(R), m4=m4c_(R); };
#define M16C(r) (attn_body::m16tab(r))
#define M4C(r) (attn_body::m4tab(r))
__device__ __forceinline__ constexpr unsigned long long m16tab(int r){ constexpr unsigned long long T[16]={m16c_(0),m16c_(1),m16c_(2),m16c_(3),m16c_(4),m16c_(5),m16c_(6),m16c_(7),m16c_(8),m16c_(9),m16c_(10),m16c_(11),m16c_(12),m16c_(13),m16c_(14),m16c_(15)}; return T[r]; }
__device__ __forceinline__ constexpr unsigned long long m4tab(int r){ constexpr unsigned long long T[4]={m4c_(0),m4c_(1),m4c_(2),m4c_(3)}; return T[r&3]; }
__device__ __forceinline__ void mask_half(f32x16&P,int dh,int dl,float mhat){
  const float ninf=-INFINITY; constexpr float L3=1.5849625007211562f; const float mh1=mhat-1.0f, mh3=mhat-L3;
  if(dh>=544){
    _Pragma("unroll") for(int r=0;r<16;++r) P[r]=selm(ninf,P[r]-mhat,M16C(r));
  } else if(dh>=160&&dh<=480){
    _Pragma("unroll") for(int r=0;r<16;++r) P[r]=selm(ninf,P[r]-selm(mhat,mh1,M16C(r)),M4C(r));
  } else if(dh<=-32){
    _Pragma("unroll") for(int r=0;r<16;++r) P[r]=ninf;
  } else if(dh>=32&&dh<=96){
    _Pragma("unroll") for(int r=0;r<16;++r) P[r]=P[r]-selm(selm(mhat,mh1,M4C(r)),mh3,M16C(r));
  } else if(dh==0){
    _Pragma("unroll") for(int r=0;r<16;++r){ const float v=P[r]-selm(selm(mhat,mh1,M4C(r)),mh3,M16C(r)); P[r]=(dl-((r&3)+8*(r>>2))>=0)?v:ninf; }
  } else if(dh==128){
    _Pragma("unroll") for(int r=0;r<16;++r){ const float nr=P[r]-selm(selm(mhat,mh1,M4C(r)),mh3,M16C(r)), md=selm(ninf,P[r]-selm(mhat,mh1,M16C(r)),M4C(r)); P[r]=(dl-((r&3)+8*(r>>2))<=128)?nr:md; }
  } else {
    _Pragma("unroll") for(int r=0;r<16;++r){ const float fr=selm(ninf,P[r]-mhat,M16C(r)), md=selm(ninf,P[r]-selm(mhat,mh1,M16C(r)),M4C(r)); P[r]=(dl-((r&3)+8*(r>>2))<=512)?md:fr; }
  }
}
#ifndef ATTN_STORE16
#define ATTN_STORE16(p,v) (*(__attribute__((address_space(1))) u32x4*)(p)=(v))
#endif
template<int THRL> __device__ __forceinline__ void attn_unit(int b,int h,int qb,const bf16*Q,const bf16*__restrict__ K,const bf16*__restrict__ V,bf16*O,float*ssa,const __attribute__((address_space(3))) float*mtab,char*shm){
  int tid_=threadIdx.x; asm volatile("":"+v"(tid_)); const int tid=tid_,lane=tid&63,r32=lane&31,hi=lane>>5; const int wid=__builtin_amdgcn_readfirstlane(tid>>6);
  const long rowbase=(long)b*SEQ; const int q0=qb*QB;
  const bf16*Qw=Q+(rowbase+q0+wid*QBLK)*DM+h*D;
  const bf16*Kh=K+rowbase*DM+h*D,*Vh=V+rowbase*DM+h*D;
  const unsigned lds0=(unsigned)(uintptr_t)shm;
  float*wsf=(float*)(shm+LDS_WS)+wid*64;
  const bf16*ksrc=Kh+(long)lane*DM+wid*8;
  const bf16*vsrc=Vh+(long)(16*(wid&3)+(lane>>2))*DM+(wid>>2)*32+(lane&3)*8;
  const unsigned kdst=lds0+LDS_K+wid*1024, vdst=lds0+LDS_V+wid*1024;
  #define DMA_K(t,slot) glds16(ksrc+(long)(t)*KVBLK*DM,(unsigned)__builtin_amdgcn_readfirstlane(kdst+(slot)))
  #define DMA_V(t,slot) glds16(vsrc+(long)(t)*KVBLK*DM,(unsigned)__builtin_amdgcn_readfirstlane(vdst+(slot)))
  const int vb0=(int)(lds0+LDS_V)+((lane>>4)&1)*32+(lane&3)*8+(4*hi+((lane&15)>>2))*64;
  const char*Kbase=shm+LDS_K; bf16x8 kf[8];
  const lds_cptr shm3=(lds_cptr)shm; const lds_cptr kp0=shm3+LDS_K+hi*1024+r32*16; const lds_cptr vp0=shm3+LDS_V+((lane>>4)&1)*32+(lane&3)*8+(4*hi+((lane&15)>>2))*64;
  const int NT=(q0+QB)/KVBLK;
  DMA_K(0,0);DMA_V(0,0);DMA_K(1,SLOTB);
  bf16x8 qr[4];
  #pragma unroll
  for(int d0=0;d0<4;++d0)qr[d0]=*(const __attribute__((address_space(1))) bf16x8*)(&Qw[(long)r32*DM+d0*16+hi*8]);
  float mhat=0.f,l_reg=0.f;f32x16 o[2];o[0]=f32x16{};o[1]=f32x16{};const f32x16 negm=f32x16{};
  const int qrel=wid*QBLK+r32; const int qabs256=q0+qrel+256-4*hi-59; (void)qrel;
  (void)qabs256; (void)mtab;
  #define MTAB(P0,P1,t) do{ const int dw_=q0+32*wid-64*(t); const int dl_=(q0+qrel)-64*(t)-4*hi; mask_half(P0,dw_,dl_,mhat); mask_half(P1,dw_-32,dl_-32,mhat); }while(0)
  #define CMASK(P0,P1,t) MTAB(P0,P1,t)
  bool resc=false;
  #define START(P0,P1) do{ const float rm=rowmax(P0,P1); resc=false; \
    { const float dl=rm; mhat=fadd_s(mhat,dl); \
      _Pragma("unroll") for(int r=0;r<16;++r){P0[r]=fsub_s(P0[r],dl);P1[r]=fsub_s(P1[r],dl);} \
      } \
    _Pragma("unroll") for(int r=0;r<16;++r)P0[r]=__builtin_amdgcn_exp2f(P0[r]); }while(0)
  #define RESC() do{ if(resc){ asm volatile("s_waitcnt lgkmcnt(0)":::"memory"); \
      _Pragma("unroll") for(int d_=0;d_<2;++d_) _Pragma("unroll") for(int r=0;r<16;++r)o[d_][r]*=wsf[crow(r,hi)]; } }while(0)
  f32x16 pA0,pA1,pB0,pB1;
  int sl_prev=0,sl_cur=0,sl_next=SLOTB;
  #define ROT() do{sl_prev=sl_cur;sl_cur=sl_next;sl_next=(sl_next==(NSLOT-1)*SLOTB)?0:sl_next+SLOTB;}while(0)
  DMA_K(2,2*SLOTB);
  WAIT_BAR(3);
  qkt(pA0,pA1,Kbase,qr,negm,r32,hi);asm volatile("s_nop 15\n\ts_nop 7":"+v"(pA0),"+v"(pA1));CMASK(pA0,pA1,0);
  START(pA0,pA1);
  _Pragma("unroll") for(int r=0;r<16;++r)pA1[r]=__builtin_amdgcn_exp2f(pA1[r]);
  WAIT_BAR(0);
  DMA_K(3,0);DMA_V(1,SLOTB);
  ROT();
  kload8(kf,kp0+sl_cur);
  WAIT_BAR(2);
  s16x4 vlo[8],vhi[8]; u32x4 pw0,pw1,pw2,pw3;
  #define PKW(P,B) cvtpk_s(P[B],P[B+1])
  #define PAF(k) __builtin_bit_cast(bf16x8,pw##k)
  #define VFR(i) (bf16x8){vlo[i][0],vlo[i][1],vlo[i][2],vlo[i][3],vhi[i][0],vhi[i][1],vhi[i][2],vhi[i][3]}
  #define PIN(x) asm volatile("":"+v"(x))
  #define MX3(a,b,c) __builtin_fmaxf(__builtin_fmaxf((a),(b)),(c))
  #define GAPA(MF,A0,A1,A2,A3,W0,W1,PW) do{ MF; sacc+=A0; sacc+=A1; sacc+=A2; sacc+=A3; PIN(sacc); W0; W1; PIN(PW); SBAR(); }while(0)
  #define EX(v) __builtin_amdgcn_exp2f(v)
  #define GAPB(MF,X,B) do{ MF; if(!FAR_){ X[B]=EX(X[B]); X[B+1]=EX(X[B+1]); X[B+2]=EX(X[B+2]); X[B+3]=EX(X[B+3]); PIN(X); } SBAR(); }while(0)
  #define VRD(i) do{ vlo[i]=vtr(vp_+(((i)>>2)*4096+((i)&3)*1024)); vhi[i]=vtr(vp_+(((i)>>2)*4096+((i)&3)*1024+512)); }while(0)
  #define KRD(G,j) do{ if(G){ kload2(kf,kp0+sl_next,j); SBAR(); } }while(0)
  #define STEP(C0,C1,P0,P1,t,GK,GV,GL,FARF) do{ constexpr bool FAR_=(FARF); SBAR(); \
    const lds_cptr vp_=vp0+sl_prev; \
    VRD(0); SBAR(); float sacc=(P0[0]+P0[1]); \
    GAPA(C0=__builtin_amdgcn_mfma_f32_32x32x16_bf16(kf[0],qr[0],negm,0,0,0), P0[2],P0[3],P0[4],P0[5],     pw0[0]=PKW(P0,0), pw0[1]=PKW(P0,2), pw0); \
    VRD(4); SBAR(); GAPA(C1=__builtin_amdgcn_mfma_f32_32x32x16_bf16(kf[1],qr[0],negm,0,0,0), P0[6],P0[7],P0[8],P0[9],     pw0[2]=PKW(P0,4), pw0[3]=PKW(P0,6), pw0); \
    VRD(1); SBAR(); GAPA(C0=__builtin_amdgcn_mfma_f32_32x32x16_bf16(kf[2],qr[1],C0,0,0,0),   P0[10],P0[11],P0[12],P0[13], pw1[0]=PKW(P0,8), pw1[1]=PKW(P0,10), pw1); \
    VRD(5); SBAR(); GAPA(C1=__builtin_amdgcn_mfma_f32_32x32x16_bf16(kf[3],qr[1],C1,0,0,0),   P0[14],P0[15],P1[0],P1[1],   pw1[2]=PKW(P0,12),pw1[3]=PKW(P0,14), pw1); \
    VRD(2); SBAR(); GAPA(C0=__builtin_amdgcn_mfma_f32_32x32x16_bf16(kf[4],qr[2],C0,0,0,0),   P1[2],P1[3],P1[4],P1[5],     pw2[0]=PKW(P1,0), pw2[1]=PKW(P1,2), pw2); \
    VRD(6); SBAR(); GAPA(C1=__builtin_amdgcn_mfma_f32_32x32x16_bf16(kf[5],qr[2],C1,0,0,0),   P1[6],P1[7],P1[8],P1[9],     pw2[2]=PKW(P1,4), pw2[3]=PKW(P1,6), pw2); \
    VRD(3); SBAR(); GAPA(C0=__builtin_amdgcn_mfma_f32_32x32x16_bf16(kf[6],qr[3],C0,0,0,0),   P1[10],P1[11],P1[12],P1[13], pw3[0]=PKW(P1,8), pw3[1]=PKW(P1,10), pw3); \
    VRD(7); SBAR(); GAPA(C1=__builtin_amdgcn_mfma_f32_32x32x16_bf16(kf[7],qr[3],C1,0,0,0),   P1[14],P1[15],0.f,0.f,       pw3[2]=PKW(P1,12),pw3[3]=PKW(P1,14), pw3); \
    l_reg+=sacc; \
    if(GK){DMA_K((t)+3,sl_cur);} if(GV){DMA_V((t)+1,sl_next);} \
    if(!FAR_){ CMASK(C0,C1,t); \
    { float a=MX3(C0[0],C0[1],C1[0]),b=MX3(C0[2],C0[3],C1[1]); a=MX3(a,C1[2],C1[3]); \
      _Pragma("unroll") for(int r=4;r<16;r+=4){a=MX3(a,C0[r],C0[r+1]);b=MX3(b,C0[r+2],C0[r+3]);a=MX3(a,C1[r],C1[r+1]);b=MX3(b,C1[r+2],C1[r+3]);} \
      float rm=__builtin_fmaxf(a,b); { auto rr=__builtin_amdgcn_permlane32_swap(__float_as_uint(rm),__float_as_uint(rm),false,false); rm=__builtin_fmaxf(__uint_as_float(rr[0]),__uint_as_float(rr[1])); } \
      resc=false; \
      if(__builtin_expect(__any(rm>(float)THRL),0)){ const float dl=__builtin_fmaxf(rm,0.f); mhat+=dl; \
        _Pragma("unroll") for(int r=0;r<16;++r){C0[r]-=dl;C1[r]-=dl;} \
        const float f=__builtin_amdgcn_exp2f(-dl); l_reg*=f; if(hi==0)wsf[r32]=f; resc=true; } } \
    } else {   \
      asm volatile("s_nop 15\n\ts_nop 7":"+v"(C0),"+v"(C1)); \
      float a0=-INFINITY,b0=-INFINITY,a1=-INFINITY,b1=-INFINITY; \
      _Pragma("unroll") for(int r=0;r<8;++r){ a0=selm(a0,C0[r],M16C(r)); b0=selm(b0,C0[r+8],M16C(r)); a1=selm(a1,C1[r],M16C(r)); b1=selm(b1,C1[r+8],M16C(r)); } \
      a0-=mhat; b0-=mhat; a1-=mhat; b1-=mhat; \
      float rm=__builtin_fmaxf(__builtin_fmaxf(a0,b0),__builtin_fmaxf(a1,b1)); { auto rr=__builtin_amdgcn_permlane32_swap(__float_as_uint(rm),__float_as_uint(rm),false,false); rm=__builtin_fmaxf(__uint_as_float(rr[0]),__uint_as_float(rr[1])); } \
      resc=false; \
      if(__builtin_expect(__any(rm>(float)THRL),0)){ const float dl=__builtin_fmaxf(rm,0.f); mhat+=dl; a0-=dl; b0-=dl; a1-=dl; b1-=dl; \
        const float f=__builtin_amdgcn_exp2f(-dl); l_reg*=f; if(hi==0)wsf[r32]=f; resc=true; } \
      a0=__builtin_amdgcn_exp2f(a0); b0=__builtin_amdgcn_exp2f(b0); a1=__builtin_amdgcn_exp2f(a1); b1=__builtin_amdgcn_exp2f(b1); \
      _Pragma("unroll") for(int r=0;r<8;++r){ C0[r]=selm(0.f,a0,M16C(r)); C0[r+8]=selm(0.f,b0,M16C(r)); C1[r]=selm(0.f,a1,M16C(r)); C1[r+8]=selm(0.f,b1,M16C(r)); } } \
    SBAR(); \
    GAPB(o[0]=__builtin_amdgcn_mfma_f32_32x32x16_bf16(PAF(0),VFR(0),o[0],0,0,0), C0,0); \
    GAPB(o[1]=__builtin_amdgcn_mfma_f32_32x32x16_bf16(PAF(0),VFR(4),o[1],0,0,0), C0,4); \
    KRD(GL,0); GAPB(o[0]=__builtin_amdgcn_mfma_f32_32x32x16_bf16(PAF(1),VFR(1),o[0],0,0,0), C0,8); \
    KRD(GL,1); GAPB(o[1]=__builtin_amdgcn_mfma_f32_32x32x16_bf16(PAF(1),VFR(5),o[1],0,0,0), C0,12); \
    KRD(GL,2); GAPB(o[0]=__builtin_amdgcn_mfma_f32_32x32x16_bf16(PAF(2),VFR(2),o[0],0,0,0), C1,0); \
    KRD(GL,3); GAPB(o[1]=__builtin_amdgcn_mfma_f32_32x32x16_bf16(PAF(2),VFR(6),o[1],0,0,0), C1,4); \
    GAPB(o[0]=__builtin_amdgcn_mfma_f32_32x32x16_bf16(PAF(3),VFR(3),o[0],0,0,0), C1,8); \
    GAPB(o[1]=__builtin_amdgcn_mfma_f32_32x32x16_bf16(PAF(3),VFR(7),o[1],0,0,0), C1,12); \
    }while(0)
  int t=1;
  #undef CMASK
  #define CMASK(P0,P1,t) MTAB(P0,P1,t)
#if ATTN_FAR
  { const int TF=4*qb-9;
  for(;t+1<=TF&&t+5<NT;t+=2){
    STEP(pB0,pB1,pA0,pA1,t,true,true,true,true);     WAIT_BAR(2); RESC(); ROT();
    STEP(pA0,pA1,pB0,pB1,t+1,true,true,true,true);   WAIT_BAR(2); RESC(); ROT();
  } }
#endif
  for(;t+5<NT;t+=2){
    STEP(pB0,pB1,pA0,pA1,t,true,true,true,false);     WAIT_BAR(2); RESC(); ROT();
    STEP(pA0,pA1,pB0,pB1,t+1,true,true,true,false);   WAIT_BAR(2); RESC(); ROT();
  }
  #undef CMASK
  #define CMASK(P0,P1,t) MTAB(P0,P1,t)
  #define ENDW(tt) do{ if((tt)+3<NT){WAIT_BAR(2);} else if((tt)+2<NT){WAIT_BAR(1);} else {WAIT_BAR(0);} }while(0)
  for(;t+1<NT;t+=2){
    STEP(pB0,pB1,pA0,pA1,t,(t+3<NT),(t+1<NT),(t+1<NT),false);       ENDW(t);   RESC(); ROT();
    STEP(pA0,pA1,pB0,pB1,t+1,(t+4<NT),(t+2<NT),(t+2<NT),false);     ENDW(t+1); RESC(); ROT();
  }
  STEP(pB0,pB1,pA0,pA1,NT-1,false,false,false,false); RESC();
  { float sacc=pB0[0]+pB0[1]; _Pragma("unroll") for(int r=2;r<16;++r)sacc+=pB0[r]; _Pragma("unroll") for(int r=0;r<16;++r)sacc+=pB1[r]; l_reg+=sacc;
    pw0=(u32x4){PKW(pB0,0),PKW(pB0,2),PKW(pB0,4),PKW(pB0,6)};pw1=(u32x4){PKW(pB0,8),PKW(pB0,10),PKW(pB0,12),PKW(pB0,14)};pw2=(u32x4){PKW(pB1,0),PKW(pB1,2),PKW(pB1,4),PKW(pB1,6)};pw3=(u32x4){PKW(pB1,8),PKW(pB1,10),PKW(pB1,12),PKW(pB1,14)};
    SBAR(); pv(o,vb0+sl_cur,PAF(0),PAF(1),PAF(2),PAF(3)); }
  #undef PKW
  #undef PAF
  #undef VFR
  #undef PIN
  #undef MX3
  #undef GAPA
  #undef GAPB
  #undef EX
  #undef VRD
  #undef KRD
  #undef STEP
  #undef ENDW
  {auto rr=__builtin_amdgcn_permlane32_swap(__float_as_uint(l_reg),__float_as_uint(l_reg),false,false);l_reg=__uint_as_float(rr[0])+__uint_as_float(rr[1]);}
  if(hi==0)wsf[32+r32]=l_reg;asm volatile("s_waitcnt lgkmcnt(0)":::"memory");
  float rli[16];
  #pragma unroll
  for(int r=0;r<16;++r)rli[r]=__builtin_amdgcn_rcpf(wsf[32+crow(r,hi)]);
  bf16*Ow=O+(rowbase+q0+wid*QBLK)*OP+h*D; float*ssw=ssa+(rowbase+q0+wid*QBLK)*8+h;
  { bf16*stg=(bf16*)(shm+LDS_OST)+wid*2048;
    #pragma unroll
    for(int r=0;r<16;++r){const int orow=crow(r,hi);
      #pragma unroll
      for(int d0=0;d0<2;++d0)stg[orow*64+d0*32+r32]=__float2bfloat16(o[d0][r]*rli[r]);}
    asm volatile("s_waitcnt lgkmcnt(0)":::"memory");
    #pragma unroll
    for(int i=0;i<4;++i){const int row=i*8+(lane>>3),ch=lane&7; const u32x4 v=*(const u32x4*)(stg+row*64+ch*8); ATTN_STORE16(Ow+(long)row*OP+ch*8,v);
      float sq=0.f; _Pragma("unroll") for(int e=0;e<4;++e){ const float lo=__uint_as_float(v[e]<<16), hi_=__uint_as_float(v[e]&0xffff0000u); sq+=lo*lo+hi_*hi_; }
      sq+=__shfl_xor(sq,1); sq+=__shfl_xor(sq,2); sq+=__shfl_xor(sq,4); if(ch==0) *(__attribute__((address_space(1))) float*)(ssw+(long)row*8)=sq; } }
  asm volatile("s_waitcnt lgkmcnt(0)\n\ts_barrier":::"memory");
  #undef DMA_K
  #undef DMA_V
  #undef CMASK
  #undef MTAB
  #undef START
  #undef RESC
  #undef ROT
}
constexpr int ATTN_LDS_BYTES=LDS_BYTES;
struct AttnTensors { const bf16* Q; const bf16* K; const bf16* V; bf16* O; float* ssa; };
struct AttnUnit { int bh; int qb; };
struct StaticOrder {
  int vcu;
  __device__ __forceinline__ explicit StaticOrder(int vcu_):vcu(vcu_){}
  __device__ __forceinline__ bool next(int i,AttnUnit&u)const{ if(i>=2)return false; const int s=vcu&3; u.bh=vcu>>2; u.qb=(i==0)?s:7-s; return true; }
  __device__ __forceinline__ void a_ready(const AttnUnit&)const{}
  __device__ __forceinline__ void done(const AttnUnit&)const{}
};
template<class Sched,int THRL=8> __device__ __forceinline__ void attn_phase(char*lds,const __attribute__((address_space(3))) float*mtab,const AttnTensors&T,const Sched&S){
  AttnUnit u;
  for(int i=0;S.next(i,u);++i){ S.a_ready(u); attn_unit<THRL>(u.bh/NHEAD,u.bh%NHEAD,u.qb,T.Q,T.K,T.V,T.O,T.ssa,mtab,lds); S.done(u); }
}
#undef SBAR
#undef WAIT_BAR
}
namespace ssm {
#define SLAS __attribute__((address_space(3)))
#define SGAS __attribute__((address_space(1)))
typedef short bf16x8 __attribute__((ext_vector_type(8)));
typedef float f32x4 __attribute__((ext_vector_type(4)));
typedef unsigned u32x4 __attribute__((ext_vector_type(4)));
typedef unsigned u32x2 __attribute__((ext_vector_type(2)));
constexpr int G = 32, GC = 16, SN = 64, CH = 32;
constexpr size_t F_OFF = 0, PF_OFF = 32768, QF_OFF = 32768 + 131072, TBL_BYTES = 32768 + 2 * 131072;
__device__ __forceinline__ unsigned f2bf(float f) { unsigned u = __builtin_bit_cast(unsigned, f); return (u + 0x7fffu + ((u >> 16) & 1u)) >> 16; }
__device__ __forceinline__ unsigned pk2(float lo, float hi) { return f2bf(lo) | (f2bf(hi) << 16); }
__device__ __forceinline__ float gelu_tanh(float x) { const float k = 0.7978845608028654f; const float t = k * (x + 0.044715f * x * x * x);
    const float e = __builtin_amdgcn_exp2f(2.0f * 1.4426950408889634f * t); const float th = 1.0f - 2.0f * __builtin_amdgcn_rcpf(1.0f + e); return 0.5f * x * (1.0f + th); }

struct Disc { float ldr, ldi, fr, fi; };
__device__ __forceinline__ Disc disc(float a_re, float a_im, float log_dt) {
    Disc d; const float lr = fminf(a_re, -1e-4f), li = a_im, dt = expf(log_dt);
    d.ldr = lr * dt; d.ldi = li * dt;
    const float mag = expf(d.ldr), sn = sinf(d.ldi), cs = cosf(d.ldi), sh = sinf(0.5f * d.ldi);
    const float em1r = expm1f(d.ldr) * cs - 2.0f * sh * sh;
    const float em1i = mag * sn;
    const float den = lr * lr + li * li;
    d.fr = (em1r * lr + em1i * li) / den; d.fi = (em1i * lr - em1r * li) / den;
    return d;
}

__device__ __forceinline__ void build_tables(int l, int g, int half, const SGAS float* a_re, const SGAS float* a_im, const SGAS float* log_dt, const SGAS float* b_re, const SGAS float* b_im, const SGAS float* c_re, const SGAS float* c_im, const SGAS float* dsk,
                                             SGAS unsigned char* tbl, SGAS float* a32, SGAS float* ssc  , SLAS unsigned char* lds) {
    int tid_ = threadIdx.x; asm volatile("" : "+v"(tid_)); const int tid = tid_;
    SLAS float* pwr = (SLAS float*)lds;
    SLAS float* pwi = pwr + 33 * 64;
    SLAS float* bbr = pwi + 33 * 64;
    SLAS float* bbi = bbr + 1024;
    SLAS float* crT = bbi + 1024;
    SLAS float* ciT = crT + 1024;
    SLAS float* Mt = ciT + 1024;
    SLAS float* dsc = Mt + 8192;
    const int lg = l * G + g;
    if (tid < 64) { const Disc d = disc(a_re[lg * SN + tid], a_im[lg * SN + tid], log_dt[lg]); dsc[tid * 4] = d.ldr; dsc[tid * 4 + 1] = d.ldi; dsc[tid * 4 + 2] = d.fr; dsc[tid * 4 + 3] = d.fi; }
    for (int i = tid; i < 1024; i += 512) { const int c = i >> 6, n = i & 63; crT[n * 16 + c] = c_re[(size_t)lg * 1024 + i]; ciT[n * 16 + c] = c_im[(size_t)lg * 1024 + i]; }
    __syncthreads();
    for (int i = tid; i < 1024; i += 512) { const int n = i >> 4; const float fr = dsc[n * 4 + 2], fi = dsc[n * 4 + 3];
        const float br = b_re[(size_t)lg * 1024 + i], bi = b_im[(size_t)lg * 1024 + i]; bbr[i] = fr * br - fi * bi; bbi[i] = fr * bi + fi * br; }
    for (int i = tid; i < 33 * 64; i += 512) { const int tau = i >> 6, n = i & 63; const float mg = expf(dsc[n * 4] * (float)tau), ang = dsc[n * 4 + 1] * (float)tau; float sn, cs; sincosf(ang, &sn, &cs); pwr[i] = mg * cs; pwi[i] = mg * sn; }
    __syncthreads();
    if (half == 0) {
        if (tid < 64) { a32[(size_t)(lg * SN + tid) * 2] = pwr[32 * 64 + tid]; a32[(size_t)(lg * SN + tid) * 2 + 1] = pwi[32 * 64 + tid];
            SGAS float* sc = ssc + (size_t)(lg * SN + tid) * 36; sc[0] = pwr[64 + tid]; sc[1] = pwi[64 + tid]; sc[2] = 0.f; sc[3] = 0.f;
            for (int c = 0; c < 16; ++c) { sc[4 + c] = bbr[tid * 16 + c]; sc[20 + c] = bbi[tid * 16 + c]; } }
        { const int tau = tid >> 4, cb = (tid >> 2) & 3, pb = tid & 3; f32x4 m0 = {0.f, 0.f, 0.f, 0.f}, m1 = m0, m2 = m0, m3 = m0;
          for (int n = 0; n < 64; ++n) { const float pr = pwr[tau * 64 + n], pi = pwi[tau * 64 + n];
              const f32x4 xr = *(const SLAS f32x4*)(bbr + n * 16 + 4 * pb), xi = *(const SLAS f32x4*)(bbi + n * 16 + 4 * pb);
              const f32x4 er = xr * pr - xi * pi, ei = xi * pr + xr * pi;
              const f32x4 cr = *(const SLAS f32x4*)(crT + n * 16 + 4 * cb), ci = *(const SLAS f32x4*)(ciT + n * 16 + 4 * cb);
              m0 = m0 + er * cr[0] - ei * ci[0]; m1 = m1 + er * cr[1] - ei * ci[1]; m2 = m2 + er * cr[2] - ei * ci[2]; m3 = m3 + er * cr[3] - ei * ci[3]; }
          if (tau == 0 && cb == pb) { m0[0] += dsk[lg * GC + 4 * cb]; m1[1] += dsk[lg * GC + 4 * cb + 1]; m2[2] += dsk[lg * GC + 4 * cb + 2]; m3[3] += dsk[lg * GC + 4 * cb + 3]; }
          SLAS float* mp = Mt + tau * 256 + (4 * cb) * 16 + 4 * pb; *(SLAS f32x4*)mp = m0; *(SLAS f32x4*)(mp + 16) = m1; *(SLAS f32x4*)(mp + 32) = m2; *(SLAS f32x4*)(mp + 48) = m3; }
        __syncthreads();
        for (int i = tid; i < 32 * 64; i += 512) { const int dl = i >> 6, lane = i & 63, c = lane & 15, kg = lane >> 4, tau = dl - (kg >> 1), c0 = 8 * (kg & 1); float v[8];
#pragma unroll
            for (int j = 0; j < 8; ++j) v[j] = (tau >= 0) ? Mt[tau * 256 + c * 16 + c0 + j] : 0.f;
            u32x4 w; w.x = pk2(v[0], v[1]); w.y = pk2(v[2], v[3]); w.z = pk2(v[4], v[5]); w.w = pk2(v[6], v[7]);
            *(SGAS u32x4*)(tbl + F_OFF + (size_t)i * 16) = w; }
        for (int i = tid; i < 8 * 16 * 64; i += 512) { const int nt = i >> 10, p = (i >> 6) & 15, lane = i & 63, np = 16 * nt + (lane & 15), kg = lane >> 4, sp = 2 * p + (kg >> 1), c0 = 8 * (kg & 1), n = np & 63, tau = 31 - sp;
            const float pr = pwr[tau * 64 + n], pi = pwi[tau * 64 + n]; float v[8];
#pragma unroll
            for (int j = 0; j < 8; ++j) { const float xr = bbr[n * 16 + c0 + j], xi = bbi[n * 16 + c0 + j]; v[j] = (np < 64) ? (pr * xr - pi * xi) : (pr * xi + pi * xr); }
            u32x4 w; w.x = pk2(v[0], v[1]); w.y = pk2(v[2], v[3]); w.z = pk2(v[4], v[5]); w.w = pk2(v[6], v[7]);
            *(SGAS u32x4*)(tbl + PF_OFF + (size_t)i * 16) = w; }
    } else {
        for (int i = tid; i < 32 * 4 * 64; i += 512) { const int s = i >> 8, kb = (i >> 6) & 3, lane = i & 63, c = lane & 15, kg = lane >> 4; float v[8];
#pragma unroll
            for (int j = 0; j < 8; ++j) { const int np = 32 * kb + 8 * kg + j, n = np & 63; const float pr = pwr[(s + 1) * 64 + n], pi = pwi[(s + 1) * 64 + n], xr = crT[n * 16 + c], xi = ciT[n * 16 + c];
                v[j] = (np < 64) ? (xr * pr - xi * pi) : -(xr * pi + xi * pr); }
            u32x4 w; w.x = pk2(v[0], v[1]); w.y = pk2(v[2], v[3]); w.z = pk2(v[4], v[5]); w.w = pk2(v[6], v[7]);
            *(SGAS u32x4*)(tbl + QF_OFF + (size_t)i * 16) = w; }
    }
    __syncthreads();
}

constexpr int UST_ROW = 1040, HP_OFF = 66560, HP_ROW = 136, SL_OFF = 83968, SL_ROW = 132, ZST_OFF = 83968, GT_OFF = 150528, PU_LDS_END = 154624;
template <int K_>
__device__ __forceinline__ void y_pass(int h, const bf16x8 (&ff)[16]  , const bf16x8 (&qf)[4][4]  , SLAS unsigned char* lds, int lane) {
    const int j = lane & 15, kg = lane >> 4;
    const SLAS unsigned char* ub = lds + j * UST_ROW + (kg >> 1) * 32 + (kg & 1) * 16;
    const SLAS unsigned char* hb = lds + HP_OFF + (j * HP_ROW + 8 * kg) * 2;
    SLAS unsigned char* zb = lds + ZST_OFF + j * UST_ROW + 8 * kg;
#pragma unroll 1
    for (int ct = 0; ct < 4; ++ct) {
        f32x4 acc[4];
#pragma unroll
        for (int i = 0; i < 4; ++i) acc[i] = (f32x4){0.f, 0.f, 0.f, 0.f};
#pragma unroll
        for (int p = 0; p <= 12 + K_; ++p) {
            const bf16x8 u = *(const SLAS bf16x8*)(ub + ct * 16 * UST_ROW + p * 64);
#pragma unroll
            for (int i = 0; i < 4; ++i) if (p <= 4 * i + K_) acc[i] = __builtin_amdgcn_mfma_f32_16x16x32_bf16(ff[4 * i + K_ - p], u, acc[i], 0, 0, 0);
        }
#pragma unroll
        for (int kb = 0; kb < 4; ++kb) {
            const bf16x8 hpf = *(const SLAS bf16x8*)(hb + ct * 16 * HP_ROW * 2 + kb * 64);
#pragma unroll
            for (int i = 0; i < 4; ++i) acc[i] = __builtin_amdgcn_mfma_f32_16x16x32_bf16(qf[i][kb], hpf, acc[i], 0, 0, 0);
        }
#pragma unroll
        for (int i = 0; i < 4; ++i) { const int s = h + 2 * (4 * i + K_); const f32x4 y = acc[i];
            u32x2 w; w.x = pk2(gelu_tanh(y[0]), gelu_tanh(y[1])); w.y = pk2(gelu_tanh(y[2]), gelu_tanh(y[3]));
            *(SLAS u32x2*)(zb + ct * 16 * UST_ROW + s * 32) = w; }
    }
}

__device__ __forceinline__ void prompt_unit(int g, int b, int l, const SGAS unsigned short* U  , const SGAS unsigned char* tbl_l  , const SGAS float* a32_l, SGAS unsigned short* Zb  , SGAS float* out_re, SGAS float* out_im  ,
                                            SLAS unsigned char* lds) {
    int tid_ = threadIdx.x; asm volatile("" : "+v"(tid_)); const int tid = tid_, lane = tid & 63, wid = __builtin_amdgcn_readfirstlane(tid >> 6), j = lane & 15, kg = lane >> 4;
    const SGAS unsigned char* tbl = tbl_l + (size_t)g * TBL_BYTES;
    SLAS float* SL = (SLAS float*)(lds + SL_OFF); SLAS unsigned short* HP = (SLAS unsigned short*)(lds + HP_OFF);
    const size_t blk = ((size_t)g * 16384 + (size_t)b * 2048) * 16;
    bf16x8 ff[16], qf[4][4];
    { u32x4 v[8];
#pragma unroll
      for (int k = 0; k < 8; ++k) v[k] = *(const SGAS u32x4*)((const SGAS unsigned char*)(U + blk) + (size_t)(tid + 512 * k) * 16);
      bf16x8 pf[16];
#pragma unroll
      for (int p = 0; p < 16; ++p) pf[p] = *(const SGAS bf16x8*)(tbl + PF_OFF + (size_t)((wid * 16 + p) * 64 + lane) * 16);
#pragma unroll
      for (int k = 0; k < 8; ++k) { const int off = (tid + 512 * k) * 16; *(SLAS u32x4*)(lds + (off >> 10) * UST_ROW + (off & 1023)) = v[k]; }
      __syncthreads();
#pragma unroll
      for (int i = 0; i < 16; ++i) ff[i] = *(const SGAS bf16x8*)(tbl + F_OFF + (size_t)((2 * i + (wid & 1)) * 64 + lane) * 16);
#pragma unroll
      for (int i = 0; i < 4; ++i)
#pragma unroll
          for (int kb = 0; kb < 4; ++kb) qf[i][kb] = *(const SGAS bf16x8*)(tbl + QF_OFF + (size_t)((((wid & 1) + 2 * (4 * i + (wid >> 1))) * 4 + kb) * 64 + lane) * 16);
      const SLAS unsigned char* ub = lds + j * UST_ROW + (kg >> 1) * 32 + (kg & 1) * 16;
#pragma unroll 1
      for (int ct = 0; ct < 4; ++ct) { f32x4 acc = {0.f, 0.f, 0.f, 0.f};
#pragma unroll
          for (int p = 0; p < 16; ++p) { const bf16x8 u = *(const SLAS bf16x8*)(ub + ct * 16 * UST_ROW + p * 64); acc = __builtin_amdgcn_mfma_f32_16x16x32_bf16(pf[p], u, acc, 0, 0, 0); }
          *(SLAS f32x4*)(SL + (16 * ct + j) * SL_ROW + 16 * wid + 4 * kg) = acc; } }
    __syncthreads();
    { const float ar = a32_l[(size_t)(g * SN + lane) * 2], ai = a32_l[(size_t)(g * SN + lane) * 2 + 1];
      SLAS float* GT = (SLAS float*)(lds + GT_OFF);
      float hr = 0.f, hi = 0.f, lr[8], li[8];
#pragma unroll
      for (int k = 0; k < 8; ++k) { lr[k] = hr; li[k] = hi; const int c = 8 * wid + k; const float sr = SL[c * SL_ROW + lane], si = SL[c * SL_ROW + 64 + lane];
          const float nr = ar * hr - ai * hi + sr, ni = ar * hi + ai * hr + si; hr = nr; hi = ni; }
      GT[wid * 128 + lane] = hr; GT[wid * 128 + 64 + lane] = hi;
      float pr = ar, pi = ai;
#pragma unroll
      for (int k = 0; k < 3; ++k) { const float nr = pr * pr - pi * pi, ni = 2.0f * pr * pi; pr = nr; pi = ni; }
      __syncthreads();
      float cr = 0.f, ci = 0.f;
      for (int w = 0; w < 8; ++w) { if (w == wid) break; const float tr = GT[w * 128 + lane], ti = GT[w * 128 + 64 + lane]; const float nr = pr * cr - pi * ci + tr, ni = pr * ci + pi * cr + ti; cr = nr; ci = ni; }
      float qr = 1.f, qi = 0.f;
#pragma unroll
      for (int k = 0; k < 8; ++k) { const int c = 8 * wid + k; const float vr = lr[k] + qr * cr - qi * ci, vi = li[k] + qr * ci + qi * cr;
          HP[c * HP_ROW + lane] = (unsigned short)f2bf(vr); HP[c * HP_ROW + 64 + lane] = (unsigned short)f2bf(vi);
          const float nr = qr * ar - qi * ai, ni = qr * ai + qi * ar; qr = nr; qi = ni; }
      if (wid == 7) { const float fr_ = hr + qr * cr - qi * ci, fi_ = hi + qr * ci + qi * cr;
          out_re[(size_t)(b * G + g) * SN + lane] = fr_; out_im[(size_t)(b * G + g) * SN + lane] = fi_; } }
    __syncthreads();
    { const int h = wid & 1, k4 = wid >> 1;
      if (k4 == 0) y_pass<0>(h, ff, qf, lds, lane); else if (k4 == 1) y_pass<1>(h, ff, qf, lds, lane); else if (k4 == 2) y_pass<2>(h, ff, qf, lds, lane); else y_pass<3>(h, ff, qf, lds, lane); }
    __syncthreads();
#pragma unroll
    for (int k = 0; k < 8; ++k) { const int off = (tid + 512 * k) * 16; const u32x4 v = *(const SLAS u32x4*)(lds + ZST_OFF + (off >> 10) * UST_ROW + (off & 1023)); *(SGAS u32x4*)((SGAS unsigned char*)(Zb + blk) + off) = v; }
    __syncthreads();
}

__device__ __forceinline__ void sample_unit(int b, int g, int l, const SGAS float* Us, const SGAS float* h0re, const SGAS float* h0im, const SGAS float* ssc,
                                            const SGAS float* c_re, const SGAS float* c_im, const SGAS float* dsk, SGAS unsigned short* Zb, SGAS float* out_re, SGAS float* out_im, SLAS float* wlds, int lane) {
    const int lg = l * G + g, n = lane;
    const SGAS float* sc = ssc + (size_t)(lg * SN + n) * 36; const float abr = sc[0], abi = sc[1];
    float bbr[16], bbi[16];
#pragma unroll
    for (int c = 0; c < 16; ++c) { bbr[c] = sc[4 + c]; bbi[c] = sc[20 + c]; }
    float hr = h0re[(size_t)(b * G + g) * SN + n], hi = h0im[(size_t)(b * G + g) * SN + n];
#pragma unroll
    for (int t = 0; t < 8; ++t) { const SGAS float* up = Us + (size_t)(b * 8 + t) * 512 + g * 16; float ur = 0.f, ui = 0.f;
#pragma unroll
        for (int c = 0; c < 16; ++c) { const float u = up[c]; ur += bbr[c] * u; ui += bbi[c] * u; }
        const float nr = abr * hr - abi * hi + ur, ni = abr * hi + abi * hr + ui; hr = nr; hi = ni;
        wlds[t * 128 + n] = hr; wlds[t * 128 + 64 + n] = hi; }
    out_re[(size_t)(b * G + g) * SN + n] = hr; out_im[(size_t)(b * G + g) * SN + n] = hi;
    SLAS float* cl = wlds + 1024;
#pragma unroll
    for (int i = 0; i < 16; ++i) { cl[i * 65 + lane] = c_re[(size_t)(lg * GC + i) * SN + lane]; cl[(16 + i) * 65 + lane] = c_im[(size_t)(lg * GC + i) * SN + lane]; }
    asm volatile("s_waitcnt lgkmcnt(0)" ::: "memory");
    const int t = lane >> 3, c0 = 2 * (lane & 7); float y0 = 0.f, y1 = 0.f;
    for (int m = 0; m < 64; ++m) { const float xr = wlds[t * 128 + m], xi = wlds[t * 128 + 64 + m]; y0 += xr * cl[c0 * 65 + m] - xi * cl[(16 + c0) * 65 + m]; y1 += xr * cl[(c0 + 1) * 65 + m] - xi * cl[(17 + c0) * 65 + m]; }
    const SGAS float* up = Us + (size_t)(b * 8 + t) * 512 + g * 16 + c0;
    y0 += dsk[lg * GC + c0] * up[0]; y1 += dsk[lg * GC + c0 + 1] * up[1];
    *(SGAS unsigned*)(Zb + ((size_t)16384 + b * 8 + t) * 512 + g * 16 + c0) = pk2(gelu_tanh(y0), gelu_tanh(y1));
    asm volatile("s_waitcnt lgkmcnt(0)" ::: "memory");
}
#undef SLAS
#undef SGAS
}
namespace mini {
typedef unsigned short bf16_t;
typedef short bf16x8 __attribute__((ext_vector_type(8)));
typedef float f32x4 __attribute__((ext_vector_type(4)));
typedef unsigned u32x2 __attribute__((ext_vector_type(2)));
#define MLAS __attribute__((address_space(3)))
constexpr int PART_W = 32 * 64;
__device__ __forceinline__ u32x2 pack4(const f32x4 a) { u32x2 w; w.x = pg8::cvt_pk_bf16(a[0], a[1]); w.y = pg8::cvt_pk_bf16(a[2], a[3]); return w; }
__device__ __forceinline__ f32x4 sumw(const MLAS float* p, int w0, int w1) { f32x4 s = {0.f, 0.f, 0.f, 0.f};
#pragma unroll
    for (int w = w0; w < w1; ++w) s = s + *(const MLAS f32x4*)(p + w * PART_W); return s; }
__device__ __forceinline__ float red16(float v) { v += __shfl_xor(v, 1); v += __shfl_xor(v, 2); v += __shfl_xor(v, 4); v += __shfl_xor(v, 8); return v; }
__device__ __forceinline__ float sq4(const f32x4 a) { return (a[0] * a[0] + a[1] * a[1]) + (a[2] * a[2] + a[3] * a[3]); }

template <int K, class Epi>
__device__ __forceinline__ void unit(const GAS bf16_t* A  , const GAS bf16_t* Bt  , int rb, int ngroups, MLAS float* part, const Epi& epi0) {
    int tid_ = threadIdx.x; asm volatile("" : "+v"(tid_)); const int tid = tid_, lane = tid & 63, wid = __builtin_amdgcn_readfirstlane(tid >> 6), j = lane & 15, kg = lane >> 4;
    constexpr int KS = K / 8, NK = KS / 32, CH = 4, NCH = (NK + CH - 1) / CH;
    const int kbase = wid * KS + 8 * kg;
    const GAS bf16_t* a0 = A + (size_t)(rb * 32 + j) * K + kbase; const GAS bf16_t* a1 = a0 + (size_t)16 * K;
    Epi epi = epi0; epi.prep(rb * 32 + (tid >> 4));
    bf16x8 af[CH][2], bf[CH][4];
#define MINI_LOAD(g_, c_) do { _Pragma("unroll") for (int q = 0; q < CH; ++q) if ((c_) * CH + q < NK) { const int ks = (c_) * CH + q; af[q][0] = *(const GAS bf16x8*)(a0 + 32 * ks); af[q][1] = *(const GAS bf16x8*)(a1 + 32 * ks); \
        _Pragma("unroll") for (int ct = 0; ct < 4; ++ct) bf[q][ct] = *(const GAS bf16x8*)(Bt + (size_t)epi.brow((g_), 16 * ct + j) * K + kbase + 32 * ks); } } while (0)
    MINI_LOAD(0, 0);
#pragma unroll 1
    for (int g = 0; g < ngroups; ++g) {
        f32x4 acc[2][4];
#pragma unroll
        for (int rt = 0; rt < 2; ++rt)
#pragma unroll
            for (int ct = 0; ct < 4; ++ct) acc[rt][ct] = (f32x4){0.f, 0.f, 0.f, 0.f};
#pragma unroll
        for (int c = 0; c < NCH; ++c) {
            __builtin_amdgcn_sched_barrier(0);
#pragma unroll
            for (int q = 0; q < CH; ++q) if (c * CH + q < NK) {
#pragma unroll
                for (int ct = 0; ct < 4; ++ct) { acc[0][ct] = __builtin_amdgcn_mfma_f32_16x16x32_bf16(bf[q][ct], af[q][0], acc[0][ct], 0, 0, 0); acc[1][ct] = __builtin_amdgcn_mfma_f32_16x16x32_bf16(bf[q][ct], af[q][1], acc[1][ct], 0, 0, 0); } }
            __builtin_amdgcn_sched_barrier(0);
            if (c + 1 < NCH) MINI_LOAD(g, c + 1); else if (g + 1 < ngroups) MINI_LOAD(g + 1, 0);
            __builtin_amdgcn_sched_barrier(0);
        }
#pragma unroll
        for (int rt = 0; rt < 2; ++rt)
#pragma unroll
            for (int ct = 0; ct < 4; ++ct) *(MLAS f32x4*)(part + (wid * 32 + 16 * rt + j) * 64 + 16 * ct + 4 * kg) = acc[rt][ct];
        __syncthreads();
        epi.reduce(g, rb * 32 + (tid >> 4), (tid & 15) * 4, part + (tid >> 4) * 64 + (tid & 15) * 4);
        __syncthreads();
    }
#undef MINI_LOAD
}

constexpr float QS = 0.125f * 1.4426950408889634f, EPSN = 1e-6f;
struct E1 {
    GAS unsigned char* ws; GAS float* out; int l, cb; float r;
    __device__ __forceinline__ void prep(int srow) { r = __builtin_amdgcn_rsqf(pg8::sum16((const GAS float*)(pg8::lau(ws) + WS_SS1) + (size_t)(MP + srow) * 16) * (1.0f / 1024.0f) + EPSN); }
    __device__ __forceinline__ int brow(int, int c) const { return 64 * cb + c; }
    __device__ __forceinline__ void reduce(int, int srow, int c4, const MLAS float* p) const {
        GAS unsigned char* w = pg8::lau(ws); const int row = MP + srow, col = 64 * cb + c4, seg = col >> 9, c = col & 511;
        const f32x4 v = sumw(p, 0, 8) * r;
        if (seg == 0) { *(GAS u32x2*)((GAS bf16_t*)(w + WS_QB) + (size_t)row * 512 + c) = pack4(v * QS); }
        else if (seg == 3) { *(GAS f32x4*)((GAS float*)(w + WS_US) + (size_t)srow * 512 + c) = v; }
        else { *(GAS u32x2*)((GAS bf16_t*)(w + (seg == 1 ? WS_KB : WS_VB)) + (size_t)row * 512 + c) = pack4(v);
               *(GAS f32x4*)(pg8::lauf(out) + (seg == 1 ? O_SK : O_SV) + (size_t)l * MS * 512 + (size_t)srow * 512 + c) = v; }
    }
};
struct E3 {
    GAS unsigned char* ws; const GAS float* bias; int cb;
    __device__ __forceinline__ void prep(int) {}
    __device__ __forceinline__ int brow(int, int c) const { return 64 * cb + c; }
    __device__ __forceinline__ void reduce(int, int srow, int c4, const MLAS float* p) const {
        GAS unsigned char* w = pg8::lau(ws); const int row = MP + srow, col = 64 * cb + c4;
        const f32x4 a = sumw(p, 0, 8) + *(const GAS f32x4*)(bias + col);
        const u32x2 zz = *(const GAS u32x2*)((const GAS bf16_t*)(w + WS_ZB) + (size_t)row * 512 + col);
        f32x4 z; z[0] = __uint_as_float(zz.x << 16); z[1] = __uint_as_float(zz.x & 0xffff0000u); z[2] = __uint_as_float(zz.y << 16); z[3] = __uint_as_float(zz.y & 0xffff0000u);
        f32x4 o;
#pragma unroll
        for (int e = 0; e < 4; ++e) o[e] = z[e] * __builtin_amdgcn_rcpf(1.0f + __builtin_amdgcn_exp2f(-1.4426950408889634f * a[e]));
        *(GAS u32x2*)((GAS bf16_t*)(w + WS_MIX) + (size_t)row * 1024 + 512 + col) = pack4(o);
        const float part = red16(sq4(o)); if ((c4 >> 2) == 0) ((GAS float*)(w + WS_SSS))[(size_t)row * 8 + cb] = part;
    }
};
struct E4 {
    GAS unsigned char* ws; int cb; float ra, rs;
    __device__ __forceinline__ void prep(int srow) { GAS unsigned char* w = pg8::lau(ws); const int row = MP + srow;
        ra = __builtin_amdgcn_rsqf(pg8::sum8((const GAS float*)(w + WS_SSA) + (size_t)row * 8) * (1.0f / 512.0f) + EPSN); rs = __builtin_amdgcn_rsqf(pg8::sum8((const GAS float*)(w + WS_SSS) + (size_t)row * 8) * (1.0f / 512.0f) + EPSN); }
    __device__ __forceinline__ int brow(int, int c) const { return 64 * cb + c; }
    __device__ __forceinline__ void reduce(int, int srow, int c4, const MLAS float* p) const {
        GAS unsigned char* w = pg8::lau(ws); const int row = MP + srow, col = 64 * cb + c4;
        const f32x4 mixed = sumw(p, 0, 4) * ra + sumw(p, 4, 8) * rs;
        GAS bf16_t* xr = (GAS bf16_t*)(w + WS_XB) + (size_t)row * 1024 + col; const u32x2 xx = *(const GAS u32x2*)xr;
        f32x4 x; x[0] = __uint_as_float(xx.x << 16); x[1] = __uint_as_float(xx.x & 0xffff0000u); x[2] = __uint_as_float(xx.y << 16); x[3] = __uint_as_float(xx.y & 0xffff0000u);
        const f32x4 h = x + mixed; *(GAS u32x2*)xr = pack4(h);
        const float part = red16(sq4(h)); if ((c4 >> 2) == 0) ((GAS float*)(w + WS_SS2))[(size_t)row * 16 + cb] = part;
    }
};
struct E5 {
    GAS unsigned char* ws; int q0; float r;
    __device__ __forceinline__ void prep(int srow) { r = __builtin_amdgcn_rsqf(pg8::sum16((const GAS float*)(pg8::lau(ws) + WS_SS2) + (size_t)(MP + srow) * 16) * (1.0f / 1024.0f) + EPSN); }
    __device__ __forceinline__ int brow(int g, int c) const { const int q = q0 + 16 * g; return 256 * (q >> 2) + ((c < 32) ? 32 * (q & 3) + c : 128 + 32 * (q & 3) + (c - 32)); }
    __device__ __forceinline__ void reduce(int g, int srow, int c4, const MLAS float* p) const {
        if (c4 >= 32) return;
        GAS unsigned char* w = pg8::lau(ws); const int row = MP + srow, q = q0 + 16 * g;
        const f32x4 gt = sumw(p, 0, 8) * r, up = sumw(p + 32, 0, 8) * r; f32x4 o;
#pragma unroll
        for (int e = 0; e < 4; ++e) o[e] = gt[e] * up[e] * __builtin_amdgcn_rcpf(1.0f + __builtin_amdgcn_exp2f(-1.4426950408889634f * gt[e]));
        *(GAS u32x2*)((GAS bf16_t*)(w + WS_GB) + (size_t)row * 2816 + 128 * (q >> 2) + 32 * (q & 3) + c4) = pack4(o);
    }
};
struct E6 {
    GAS unsigned char* ws; int cb;
    __device__ __forceinline__ void prep(int) {}
    __device__ __forceinline__ int brow(int, int c) const { return 64 * cb + c; }
    __device__ __forceinline__ void reduce(int, int srow, int c4, const MLAS float* p) const {
        GAS unsigned char* w = pg8::lau(ws); const int row = MP + srow, col = 64 * cb + c4;
        GAS bf16_t* xr = (GAS bf16_t*)(w + WS_XB) + (size_t)row * 1024 + col; const u32x2 xx = *(const GAS u32x2*)xr;
        f32x4 x; x[0] = __uint_as_float(xx.x << 16); x[1] = __uint_as_float(xx.x & 0xffff0000u); x[2] = __uint_as_float(xx.y << 16); x[3] = __uint_as_float(xx.y & 0xffff0000u);
        const f32x4 y = x + sumw(p, 0, 8); *(GAS u32x2*)xr = pack4(y);
        const float part = red16(sq4(y)); if ((c4 >> 2) == 0) ((GAS float*)(w + WS_SS1))[(size_t)row * 16 + cb] = part;
    }
};
#undef MLAS
}
#define XB_TMO      128
#define XB_XCNT(j)  (256  + 64 * (j))
#define XB_XSUB(j)  (1280 + 64 * (j))
#define XB_XGEN(j)  (2304 + 64 * (j))
#define XB_TOP      3328
#define XB_TOPGEN   3392
#define XCD_BAR_WORDS 3456
#define XB_SPIN_CAP (1u << 18)

__device__ __forceinline__ unsigned xb_ld(unsigned* p)              { return __hip_atomic_load((GAS unsigned*)p, __ATOMIC_RELAXED, __HIP_MEMORY_SCOPE_AGENT); }
__device__ __forceinline__ unsigned xb_add(unsigned* p, unsigned v) { return __hip_atomic_fetch_add((GAS unsigned*)p, v, __ATOMIC_RELAXED, __HIP_MEMORY_SCOPE_AGENT); }
__device__ __forceinline__ unsigned xb_xcc_id() { return (unsigned)__builtin_amdgcn_s_getreg((3 << 11) | 20) & 0xFu; }
#define XB_SPIN(cond, bar) do { unsigned _sp = 0; while (cond) { __builtin_amdgcn_s_sleep(1); \
    if ((++_sp & 255u) == 0u) { if (xb_ld(&(bar)[XB_TMO])) break; if (_sp > XB_SPIN_CAP) { atomicAdd(&(bar)[XB_TMO], 1u); break; } } } } while (0)

struct XcdBarrier {
    unsigned* bar; unsigned x;
    volatile LAS unsigned* st;
};

__device__ __forceinline__ XcdBarrier xcd_barrier_post(unsigned* bar, volatile LAS unsigned* st) {
    XcdBarrier b; b.bar = bar; b.x = xb_xcc_id(); b.st = st;
    if (threadIdx.x == 0) (void)xb_add(&bar[XB_XCNT(b.x)], 1u);
    return b;
}
__device__ __forceinline__ void xcd_barrier_complete(unsigned* bar, unsigned x, unsigned& nloc, unsigned& nx) {
    const unsigned G = gridDim.x * gridDim.y * gridDim.z;
    unsigned sum, cnt, mine, sp = 0u;
    for (;;) {
        sum = 0u; cnt = 0u; mine = 0u;
#pragma unroll
        for (unsigned j = 0; j < 16; ++j) { const unsigned c = xb_ld(&bar[XB_XCNT(j)]); sum += c; cnt += (c > 0u) ? 1u : 0u; mine = (j == x) ? c : mine; }
        if (sum == G) break;
        __builtin_amdgcn_s_sleep(1);
        if ((++sp & 255u) == 0u) { if (xb_ld(&bar[XB_TMO])) break; if (sp > XB_SPIN_CAP) { atomicAdd(&bar[XB_TMO], 1u); break; } }
    }
    nloc = mine > 0u ? mine : 1u; nx = cnt > 0u ? cnt : 1u;
}

__device__ __forceinline__ void xcd_barrier(const XcdBarrier& b) {
    asm volatile("s_waitcnt vmcnt(0)" ::: "memory");
    __syncthreads();
    if (threadIdx.x == 0) {
        unsigned* bar = b.bar;
        __builtin_amdgcn_s_waitcnt(0);
        unsigned nloc = b.st[0], nx = b.st[1];
        if (nloc == 0u) { xcd_barrier_complete(bar, b.x, nloc, nx); b.st[0] = nloc; b.st[1] = nx; }
        const unsigned old = xb_add(&bar[XB_XSUB(b.x)], 1u);
        const unsigned gen = old / nloc;
        if (old + 1u == (gen + 1u) * nloc) {
            __builtin_amdgcn_fence(__ATOMIC_RELEASE, "agent");
            asm volatile("s_waitcnt vmcnt(0)" ::: "memory");
            const unsigned og = xb_add(&bar[XB_TOP], 1u);
            const unsigned tg = og / nx;
            if (og + 1u == (tg + 1u) * nx) xb_add(&bar[XB_TOPGEN], 1u);
            else XB_SPIN(xb_ld(&bar[XB_TOPGEN]) == tg, bar);
            __builtin_amdgcn_fence(__ATOMIC_ACQUIRE, "agent");
            xb_add(&bar[XB_XGEN(b.x)], 1u);
            asm volatile("s_waitcnt vmcnt(0)" ::: "memory");
        } else {
            XB_SPIN(xb_ld(&bar[XB_XGEN(b.x)]) == gen, bar);
            __builtin_amdgcn_fence(__ATOMIC_ACQUIRE, "agent");
            asm volatile("s_waitcnt vmcnt(0)" ::: "memory");
        }
    }
    __syncthreads();
}

__device__ __forceinline__ void xcc_local_barrier(unsigned* bar, unsigned* cnt, unsigned n) {
    asm volatile("s_waitcnt vmcnt(0)" ::: "memory");
    __syncthreads();
    if (threadIdx.x == 0) {
        __builtin_amdgcn_s_waitcnt(0);
#if EARLY_INV
        __builtin_amdgcn_fence(__ATOMIC_ACQUIRE, "agent");
        const unsigned old = xb_add(cnt, 1u);
        const unsigned tgt = (old / n + 1u) * n;
        if (old + 1u != tgt) XB_SPIN(xb_ld(cnt) < tgt, bar);
        asm volatile("s_waitcnt vmcnt(0)" ::: "memory");
#else
        const unsigned old = xb_add(cnt, 1u);
        const unsigned tgt = (old / n + 1u) * n;
        XB_SPIN(xb_ld(cnt) < tgt, bar);
        __builtin_amdgcn_fence(__ATOMIC_ACQUIRE, "agent");
        asm volatile("s_waitcnt vmcnt(0)" ::: "memory");
#endif
    }
    __syncthreads();
}

__device__ __forceinline__ void xcc_signal(unsigned* cnt, unsigned same_l2) {
    asm volatile("s_waitcnt vmcnt(0)" ::: "memory");
    __syncthreads();
    if (threadIdx.x == 0) {
        if (!same_l2) { __builtin_amdgcn_fence(__ATOMIC_RELEASE, "agent"); asm volatile("s_waitcnt vmcnt(0)" ::: "memory"); }
        (void)xb_add(cnt, 1u);
    }
}
__device__ __forceinline__ void xcc_wait(unsigned* bar, unsigned* cnt, unsigned target) {
    asm volatile("s_waitcnt vmcnt(0)" ::: "memory");
    __syncthreads();
    if (threadIdx.x == 0) {
        __builtin_amdgcn_fence(__ATOMIC_ACQUIRE, "agent");
        XB_SPIN(xb_ld(cnt) < target, bar);
        asm volatile("s_waitcnt vmcnt(0)" ::: "memory");
    }
    __syncthreads();
}
static_assert(WS_WIN + (size_t)NLAYER * INW_ * DM_ * 2 <= WS_WOUT && WS_WOUT + (size_t)NLAYER * DM_ * DM_ * 2 <= WS_WGU && WS_WGU + (size_t)NLAYER * 2 * FF_ * DM_ * 2 <= WS_WDN &&
              WS_WDN + (size_t)NLAYER * DM_ * FF_ * 2 <= WS_WGLU && WS_WGLU + (size_t)NLAYER * 512 * 512 * 2 <= WS_SSMT && WS_SSMT + (size_t)NLAYER * 32 * ssm::TBL_BYTES <= WS_A32 &&
              WS_XRES + (size_t)MT * DM_ * 4 <= WS_XB && WS_XB + (size_t)MT * DM_ * 2 <= WS_QB && WS_QB + (size_t)MT * 512 * 2 <= WS_KB && WS_KB + (size_t)MT * 512 * 2 <= WS_VB &&
              WS_VB + (size_t)MT * 512 * 2 <= WS_UB && WS_UB + (size_t)32 * MP * 16 * 2 <= WS_US && WS_US + (size_t)MS * 512 * 4 <= WS_MIX && WS_MIX + (size_t)MT * 1024 * 2 <= WS_ZB &&
              WS_ZB + (size_t)MT * 512 * 2 <= WS_GB && WS_GB + (size_t)MT * FF_ * 2 <= WS_SS1 && WS_SS1 + (size_t)MT * 16 * 4 <= WS_SS2 && WS_SS2 + (size_t)MT * 16 * 4 <= WS_SSA &&
              WS_SSA + (size_t)MT * 8 * 4 <= WS_SSS && WS_SSS + (size_t)MT * 8 * 4 <= WS_SSC && WS_SSC + (size_t)NLAYER * 32 * 64 * 36 * 4 <= WS_END, "d_ws map");
static_assert(attn_body::LDS_BYTES <= MTAB_OFF && MTAB_OFF + MTAB_N * 4 <= RING_BYTES, "attention LDS");
static_assert(ssm::PU_LDS_END <= RTAB_OFF && RING_BYTES <= RTAB_OFF && PTAB_OFF + 27 * 8 <= LDS_BYTES, "LDS map");
struct Frame {
    LAS unsigned char* lds; volatile LAS unsigned* MISC; gu32* ctl; int tid, lane, wave, vcu, G;
};

__device__ __forceinline__ void p0_transpose_item(const GAS float* W, int K, int N, GAS bf16* WT, int k0, int n0, int drow0, const GAS float* scale, LAS float* scr, int lane) {
    float wv[32];
#pragma unroll
    for (int i = 0; i < 32; ++i) wv[i] = W[(size_t)(k0 + 2 * i + (lane >> 5)) * N + n0 + (lane & 31)];
#pragma unroll
    for (int i = 0; i < 32; ++i) { const int kk = 2 * i + (lane >> 5); const float sc = scale ? scale[k0 + kk] : 1.0f; scr[kk * 33 + (lane & 31)] = wv[i] * sc; }
    LDS_WAIT(); asm volatile("" ::: "memory");
    const int c = lane & 7;
#pragma unroll
    for (int j = 0; j < 4; ++j) { const int n = (lane >> 3) + 8 * j; const LAS float* s = scr + (8 * c) * 33 + n;
        v4u o; o.x = pk2(s[0 * 33], s[1 * 33]); o.y = pk2(s[2 * 33], s[3 * 33]); o.z = pk2(s[4 * 33], s[5 * 33]); o.w = pk2(s[6 * 33], s[7 * 33]);
        *(GAS v4u*)(WT + (size_t)(drow0 + n) * K + k0 + 8 * c) = o; }
    LDS_WAIT(); asm volatile("" ::: "memory");
}

#define SA_DPP(v, ctrl) __int_as_float(__builtin_amdgcn_update_dpp(0, __float_as_int(v), (ctrl), 0xF, 0xF, true))
__device__ __forceinline__ void sattn_unit(int b, int h, const GAS bf16* Qb, const GAS float* ck, const GAS float* cv, const GAS float* newK, const GAS float* newV, GAS bf16* MIX, GAS float* ssa, LAS float* wl, int t, int lane) {
    const int row = MP + b * 8 + t, kq = lane >> 4, dl = lane & 15;
    const GAS unsigned char* ckb = (const GAS unsigned char*)(ck + ((size_t)b * 2048 * 8 + h) * 64); const GAS unsigned char* cvb = (const GAS unsigned char*)(cv + ((size_t)b * 2048 * 8 + h) * 64);
    f32x4 q4; { typedef unsigned u32x2v __attribute__((ext_vector_type(2))); const u32x2v qq = *(const GAS u32x2v*)(Qb + (size_t)row * 512 + h * 64 + 4 * dl);
        q4[0] = __uint_as_float(qq.x << 16); q4[1] = __uint_as_float(qq.x & 0xffff0000u); q4[2] = __uint_as_float(qq.y << 16); q4[3] = __uint_as_float(qq.y & 0xffff0000u); }
#pragma unroll 1
    for (int br = 0; br < 3; ++br) { const int dil = br == 0 ? 1 : (br == 1 ? 4 : 16);
#pragma unroll 1
      for (int i0 = 0; i0 < 34; i0 += 17) {
        float sc[17];
        const unsigned o0 = ((unsigned)(2048 + t - ((4 * i0 + kq) << (2 * br))) << 11) + 16u * dl, str = 8192u << (2 * br);
#pragma unroll
        for (int ii = 0; ii < 17; ++ii) { f32x4 kv;
            if (ii >= 2 && ii < 15) kv = *(const GAS f32x4*)(ckb + (o0 - (unsigned)ii * str));
            else { const int i = i0 + ii; const int jj = min(4 * i + kq, 128);
                const int idx = 2048 + t - dil * jj;
                const GAS float* kp = (idx < 2048) ? ck + (((size_t)b * 2048 + idx) * 8 + h) * 64 : newK + ((size_t)(b * 8 + idx - 2048) * 512 + h * 64);
                kv = *(const GAS f32x4*)(kp + 4 * dl); }
            sc[ii] = (kv[0] * q4[0] + kv[1] * q4[1]) + (kv[2] * q4[2] + kv[3] * q4[3]); }
#pragma unroll
        for (int ii = 0; ii < 17; ++ii) { float a = sc[ii]; a += SA_DPP(a, 0xB1); a += SA_DPP(a, 0x4E); a += SA_DPP(a, 0x141); a += SA_DPP(a, 0x140);
            const int jj = 4 * (i0 + ii) + kq; if (dl == 0 && jj <= 128) wl[br * 192 + jj] = a; } } }
    LDS_WAIT();
    float m = -INFINITY;
#pragma unroll 1
    for (int i = lane; i < 576; i += 64) { const int jj = i % 192; if (jj <= 128) m = fmaxf(m, wl[i]); }
    m = wave_max(m);
    float den = 0.f;
#pragma unroll 1
    for (int i = lane; i < 576; i += 64) { const int jj = i % 192; if (jj <= 128) { const float p = __builtin_amdgcn_exp2f(wl[i] - m); den += p; wl[i] = p; } }
    den = wave_sum(den);
    LDS_WAIT();
    f32x4 acc = {0.f, 0.f, 0.f, 0.f};
#pragma unroll 1
    for (int br = 0; br < 3; ++br) { const int dil = br == 0 ? 1 : (br == 1 ? 4 : 16);
#pragma unroll 1
      for (int i0 = 0; i0 < 34; i0 += 17) {
        f32x4 vv[17];
        const unsigned o0 = ((unsigned)(2048 + t - ((4 * i0 + kq) << (2 * br))) << 11) + 16u * dl, str = 8192u << (2 * br);
#pragma unroll
        for (int ii = 0; ii < 17; ++ii) {
            if (ii >= 2 && ii < 15) vv[ii] = *(const GAS f32x4*)(cvb + (o0 - (unsigned)ii * str));
            else { const int i = i0 + ii; const int jj = min(4 * i + kq, 128);
                const int idx = 2048 + t - dil * jj;
                const GAS float* vp = (idx < 2048) ? cv + (((size_t)b * 2048 + idx) * 8 + h) * 64 : newV + ((size_t)(b * 8 + idx - 2048) * 512 + h * 64);
                vv[ii] = *(const GAS f32x4*)(vp + 4 * dl); } }
#pragma unroll
        for (int ii = 0; ii < 17; ++ii) { const int jj = 4 * (i0 + ii) + kq; const float p = (jj <= 128) ? wl[br * 192 + jj] : 0.f; acc = acc + vv[ii] * p; } } }
#pragma unroll
    for (int e = 0; e < 4; ++e) { acc[e] += __shfl_xor(acc[e], 16); acc[e] += __shfl_xor(acc[e], 32); }
    const float rd = __builtin_amdgcn_rcpf(den);
    const unsigned w0 = pk2(acc[0] * rd, acc[1] * rd), w1 = pk2(acc[2] * rd, acc[3] * rd);
    const float a0 = __uint_as_float(w0 << 16), a1 = __uint_as_float(w0 & 0xffff0000u), a2 = __uint_as_float(w1 << 16), a3 = __uint_as_float(w1 & 0xffff0000u);
    float sq = (a0 * a0 + a1 * a1) + (a2 * a2 + a3 * a3);
    sq += __shfl_xor(sq, 1); sq += __shfl_xor(sq, 2); sq += __shfl_xor(sq, 4); sq += __shfl_xor(sq, 8);
    if (kq == 0) { typedef unsigned u32x2v __attribute__((ext_vector_type(2))); u32x2v w; w.x = w0; w.y = w1; *(GAS u32x2v*)(MIX + (size_t)row * 1024 + h * 64 + 4 * dl) = w; }
    if (lane == 0) ssa[(size_t)row * 8 + h] = sq;
    LDS_WAIT();
}

#define SATTN_BLOCK() do { \
            for (int rep_ = 0; rep_ < REP2B; ++rep_) { GAS unsigned char* w = WSP(); GAS float* ob = OUTP(); \
            for (int u = F.vcu; u < 256; u += F.G) \
                sattn_unit(u >> 3, F.wave  , (const GAS bf16*)(w + WS_QB), INP(2) + (size_t)l * 32 * 2048 * 512, INP(3) + (size_t)l * 32 * 2048 * 512, ob + O_SK + (size_t)l * MS * 512, ob + O_SV + (size_t)l * MS * 512, \
                           (GAS bf16*)(w + WS_MIX), (GAS float*)(w + WS_SSA), (LAS float*)(LDSP() + F.wave * 4096), u & 7  , LANE()); } \
            __syncthreads(); } while (0)
struct Args { const float* in[26]; float* out; unsigned char* ws; };
__device__ __forceinline__ const GAS float* rfl_ptr(unsigned long long v) { const unsigned lo = __builtin_amdgcn_readfirstlane((unsigned)v), hi = __builtin_amdgcn_readfirstlane((unsigned)(v >> 32)); return (const GAS float*)(((unsigned long long)hi << 32) | lo); }
__global__ void __launch_bounds__(NWAVES * 64, 2) hymba_fwd(Args args) {
    extern __shared__ __attribute__((aligned(16))) unsigned char lds[];
    Frame F;
    F.lds = (LAS unsigned char*)lds; F.MISC = (volatile LAS unsigned*)(F.lds + MISC_OFF);
    F.tid = threadIdx.x; F.lane = F.tid & 63; F.wave = __builtin_amdgcn_readfirstlane(F.tid >> 6);
    F.G = gridDim.x; { const int bx = blockIdx.x; F.vcu = (F.G % 8 == 0) ? (bx % 8) * (F.G / 8) + bx / 8 : bx; }
    GAS unsigned char* const ws = (GAS unsigned char*)args.ws; F.ctl = (gu32*)(ws + WS_CTL);
#if DBG_SET >= 30 && DBG_SET < 60
    for (int u = F.tid; u < LDS_BYTES / 4; u += NWAVES * 64) ((LAS unsigned*)F.lds)[u] = 0xFFFFFFFFu;
    __syncthreads();
#endif
    for (int u = F.tid; u < (LDS_BYTES - MISC_OFF) / 4; u += NWAVES * 64) ((LAS unsigned*)(F.lds + MISC_OFF))[u] = 0u;
    __syncthreads();
    volatile LAS unsigned long long* PT = (volatile LAS unsigned long long*)(F.lds + PTAB_OFF);
    if (F.tid == 0) {
#pragma unroll
        for (int i = 0; i < 26; ++i) PT[i] = (unsigned long long)args.in[i];
        PT[26] = (unsigned long long)args.out;
    }
    __syncthreads();
#define INP(k) rfl_ptr(PT[k])
#define OUTP() ((GAS float*)rfl_ptr(PT[26]))
#define WSP() pg8::lau(ws)
#if DBG_SET >= 60
#define STAMP(k) do { if (blockIdx.x == 0 && threadIdx.x == 0) { GAS unsigned long long* tm_ = (GAS unsigned long long*)(pg8::lau(ws) + WS_CTL + 524288); const unsigned long long now_ = __builtin_amdgcn_s_memrealtime(); tm_[k] += now_ - tm_[31]; tm_[31] = now_; } } while (0)
#else
#define STAMP(k) do {} while (0)
#endif
#define GRID_BAR() for (int rb_ = 0; rb_ < REPB; ++rb_) do { XcdBarrier b_ = bar; asm volatile("" : "+s"(b_.bar), "+s"(b_.x), "+s"(b_.st)); xcd_barrier(b_); } while (0)
#define XCC_BAR() for (int rb_ = 0; rb_ < REPB; ++rb_) do { XcdBarrier b_ = bar; asm volatile("" : "+s"(b_.bar), "+s"(b_.x), "+s"(b_.st)); if (lmode) xcc_local_barrier(b_.bar, b_.bar + (CW_LB - CW_BAR) + 64 * b_.x, 32u); else xcd_barrier(b_); } while (0)
#if S5_BM
#define MIX_BAR() XCC_BAR()
#else
#define MIX_BAR() GRID_BAR()
#endif
#define LDSP() ({ LAS unsigned char* l_ = F.lds; asm volatile("" : "+s"(l_)); l_; })
#define TID() ({ int t_ = threadIdx.x; asm volatile("" : "+v"(t_)); t_; })
#define LANE() ({ int l_ = F.lane; asm volatile("" : "+v"(l_)); l_; })
    XcdBarrier bar = xcd_barrier_post((unsigned*)(F.ctl + CW_BAR), F.MISC + 8);
    if (F.tid == 0) F.MISC[16] = xb_add((unsigned*)(F.ctl + CW_RANK) + 64 * bar.x, 1u);
    LAS pg8::f32x2* RTAB = (LAS pg8::f32x2*)(F.lds + RTAB_OFF);
    const int gw = F.vcu * NWAVES + F.wave, NGW = F.G * NWAVES;

#if DBG_SET >= 60
    if (blockIdx.x == 0 && threadIdx.x == 0) { GAS unsigned long long* tm_ = (GAS unsigned long long*)(pg8::lau(ws) + WS_CTL + 524288); tm_[31] = __builtin_amdgcn_s_memrealtime(); }
#endif
#if PHM & 1
    for (int rep_ = 0; rep_ < REP0; ++rep_) {
        GAS unsigned char* w = WSP();
#pragma unroll 1
        for (int ph0 = 0; ph0 < 2; ++ph0) {
        if (((ph0 ^ F.vcu) & 1) == 0) {
        for (int it2 = F.vcu; it2 < NLAYER * 32 * 2; it2 += F.G) { const int it = it2 >> 1, l = it >> 5, g = it & 31;
            ssm::build_tables(l, g, it2 & 1, INP(9), INP(10), INP(11), INP(12), INP(13), INP(14), INP(15), INP(16), w + WS_SSMT + (size_t)it * ssm::TBL_BYTES, (GAS float*)(w + WS_A32), (GAS float*)(w + WS_SSC), LDSP()); }
        __syncthreads();
        } else {
        LAS float* scr = (LAS float*)(F.lds + RING_OFF + F.wave * 16384);
        GAS bf16* W_IN = (GAS bf16*)(w + WS_WIN); GAS bf16* W_OUT = (GAS bf16*)(w + WS_WOUT); GAS bf16* W_GU = (GAS bf16*)(w + WS_WGU); GAS bf16* W_DN = (GAS bf16*)(w + WS_WDN); GAS bf16* W_GLU = (GAS bf16*)(w + WS_WGLU);
        constexpr int I_IN = 16 * 64, I_OUT = 16 * 32, I_G = 16 * 88, I_DN = 44 * 32, I_GLU = 8 * 16, I_LAYER = I_IN + I_OUT + 2 * I_G + I_DN + I_GLU;
        for (int it = gw; it < NLAYER * I_LAYER; it += NGW) {
            const int l = it / I_LAYER; int r = it % I_LAYER;
            if (r < I_IN) { const int kb = r / 64, nb = r % 64; p0_transpose_item(INP(7) + (size_t)l * 1024 * 2048, 1024, 2048, W_IN + (size_t)l * 2048 * 1024, 64 * kb, 32 * nb, 32 * nb, INP(6) + l * 1024, scr, F.lane); continue; } r -= I_IN;
            if (r < I_OUT) { const int kb = r / 32, nb = r % 32; const GAS float* sc = (kb < 8) ? INP(8) + l * 512 : INP(19) + l * 512 - 512;
                p0_transpose_item(INP(20) + (size_t)l * 1024 * 1024, 1024, 1024, W_OUT + (size_t)l * 1024 * 1024, 64 * kb, 32 * nb, 32 * nb, sc, scr, F.lane); continue; } r -= I_OUT;
            if (r < 2 * I_G) { const int up = r >= I_G; if (up) r -= I_G; const int kb = r / 88, nb = r % 88, n0 = 32 * nb, drow0 = (n0 >> 7) * 256 + up * 128 + (n0 & 127);
                p0_transpose_item((up ? INP(23) : INP(22)) + (size_t)l * 1024 * 2816, 1024, 2816, W_GU + (size_t)l * 5632 * 1024, 64 * kb, n0, drow0, INP(21) + l * 1024, scr, F.lane); continue; } r -= 2 * I_G;
            if (r < I_DN) { const int kb = r / 32, nb = r % 32; p0_transpose_item(INP(24) + (size_t)l * 2816 * 1024, 2816, 1024, W_DN + (size_t)l * 1024 * 2816, 64 * kb, 32 * nb, 32 * nb, nullptr, scr, F.lane); continue; } r -= I_DN;
            { const int kb = r / 16, nb = r % 16; p0_transpose_item(INP(17) + (size_t)l * 512 * 512, 512, 512, W_GLU + (size_t)l * 512 * 512, 64 * kb, 32 * nb, 32 * nb, nullptr, scr, F.lane); }
        }
        __syncthreads();
        } }
        { const GAS float* x_prompt = INP(0); const GAS float* x_sample = INP(1); GAS bf16* XB = (GAS bf16*)(w + WS_XB); GAS float* SS1 = (GAS float*)(w + WS_SS1);
        for (int m0 = 2 * gw; m0 < MT; m0 += 2 * NGW) { f32x4 v[2][4]; float s[2];
#pragma unroll
            for (int q = 0; q < 2; ++q) { const int m = m0 + q; const GAS float* xr = (m < MP) ? x_prompt + (size_t)m * 1024 : x_sample + (size_t)(m - MP) * 1024; const GAS f32x4* xv = (const GAS f32x4*)xr + F.lane;
#pragma unroll
                for (int j = 0; j < 4; ++j) v[q][j] = xv[64 * j]; }
#pragma unroll
            for (int q = 0; q < 2; ++q) { const int m = m0 + q; float t = 0.f;
#pragma unroll
                for (int j = 0; j < 4; ++j) t += (v[q][j].x * v[q][j].x + v[q][j].y * v[q][j].y) + (v[q][j].z * v[q][j].z + v[q][j].w * v[q][j].w);
                s[q] = wave_sum(t);
                GAS unsigned long long* o8 = (GAS unsigned long long*)(XB + (size_t)m * 1024) + F.lane;
#pragma unroll
                for (int j = 0; j < 4; ++j) o8[64 * j] = (unsigned long long)pk2(v[q][j].x, v[q][j].y) | ((unsigned long long)pk2(v[q][j].z, v[q][j].w) << 32);
                if (F.lane < 16) SS1[(size_t)m * 16 + F.lane] = (F.lane == 0) ? s[q] : 0.f; } } }
        GRID_BAR(); STAMP(0);
    }
#endif

    unsigned lmode; int cg;
    {
        if (F.tid == 0) { unsigned ok = (F.G == 256) ? 1u : 0u;
#pragma unroll
            for (unsigned j = 0; j < 16; ++j) { const unsigned c = xb_ld(&bar.bar[XB_XCNT(j)]); ok &= (c == ((j < 8) ? 32u : 0u)) ? 1u : 0u; }
            F.MISC[17] = (XCC_LOCAL && F.MISC[16] < 32u) ? ok : 0u; }
        __syncthreads();
        lmode = __builtin_amdgcn_readfirstlane(F.MISC[17]); const int rank = __builtin_amdgcn_readfirstlane(F.MISC[16]);
        cg = (int)blockIdx.x;
        if (lmode) { F.vcu = (int)bar.x * 32 + rank; cg = rank * 8 + (int)bar.x; }
    }
    unsigned e3_tgt = 0u, e5_tgt = 0u, s5_tgt = 0u;
#pragma unroll 1
    for (int l = 0; l < NLAYER; ++l) {
#if PHM & 2
        for (int rep_ = 0; rep_ < REP1; ++rep_) {
            GAS unsigned char* w = WSP();
            pg8::Gemm g{(const GAS bf16*)(w + WS_XB), (const GAS bf16*)(w + WS_WIN) + (size_t)l * 2048 * 1024, MP, INW_, 1024}; pg8::StaticOrder S; S.init(MP, INW_, F.G, cg);
            pg8::EpiInProj E{ws, OUTP(), l, RTAB};
            pg8::gemm_phase<pg8::EpiInProj, pg8::StaticOrder, true, true>(LDSP() + RING_OFF, g, S, E);
            {
              mini::unit<1024>((const GAS bf16*)(w + WS_XB) + (size_t)MP * 1024, (const GAS bf16*)(w + WS_WIN) + (size_t)l * 2048 * 1024, cg & 7, 1, (LAS float*)(LDSP() + RING_OFF), mini::E1{ws, OUTP(), l, cg >> 3, 0.f}); }
            MIX_BAR(); STAMP(1);
#if defined(DBG_STOP) && DBG_STOP == 1
            if (l == DBG_STOP_L) return;
#endif
        }
#endif
        {
            LAS float* mtab = nullptr;
#pragma unroll 1
            for (int ph2 = 0; ph2 < 2; ++ph2) {
            if (((ph2 ^ F.vcu) & 1) == 0) {
#if PHM & 4
            for (int rep_ = 0; rep_ < REP2A; ++rep_) { GAS unsigned char* w = WSP();
            unsigned char* wg = (unsigned char*)w; const attn_body::AttnTensors AT{(const attn_body::bf16*)(wg + WS_QB), (const attn_body::bf16*)(wg + WS_KB), (const attn_body::bf16*)(wg + WS_VB), (attn_body::bf16*)(wg + WS_MIX), (float*)(wg + WS_SSA)};
            const attn_body::StaticOrder SA(F.vcu);
            attn_body::attn_phase<attn_body::StaticOrder>((char*)lds + RING_OFF, mtab, AT, SA); }
#endif
            __syncthreads(); STAMP(8);
            } else {
#pragma unroll 1
            for (int q2 = 0; q2 < 2; ++q2) {
            if (((q2 ^ F.vcu) & 1) == 0) {
#if PHM & 8
            for (int rep_ = 0; rep_ < REP2S; ++rep_) { GAS unsigned char* w = WSP(); GAS float* ob = OUTP();
            for (int u = F.vcu; u < 256; u += F.G)
                ssm::prompt_unit(S5_BM ? (u & 31) : (u >> 3), S5_BM ? (u >> 5) : (u & 7), l, (const GAS bf16*)(w + WS_UB), w + WS_SSMT + (size_t)l * 32 * ssm::TBL_BYTES, (const GAS float*)(w + WS_A32) + (size_t)l * 32 * 64 * 2, (GAS bf16*)(w + WS_ZB),
                                 ob + O_PR + (size_t)l * 8 * 32 * 64, ob + O_PI + (size_t)l * 8 * 32 * 64, LDSP()); }
#endif
            __syncthreads(); STAMP(9);
            } else {
#if PHM & 16
            SATTN_BLOCK();
#endif
            __syncthreads(); STAMP(10);
            } } } }
#if (PHM & 32) && !SS5_IN_P3
            for (int rep_ = 0; rep_ < REP2C; ++rep_) { GAS unsigned char* w = WSP(); GAS float* ob = OUTP();
            for (int u = F.vcu * 4 + F.wave; u < 1024 && F.wave < 4; u += F.G * 4)
                ssm::sample_unit(u >> 5, u & 31, l, (const GAS float*)(w + WS_US), INP(4) + (size_t)l * 32 * 32 * 64, INP(5) + (size_t)l * 32 * 32 * 64, (const GAS float*)(w + WS_SSC), INP(14), INP(15), INP(16),
                                 (GAS bf16*)(w + WS_ZB), ob + O_SR + (size_t)l * 32 * 32 * 64, ob + O_SI + (size_t)l * 32 * 32 * 64, (LAS float*)(LDSP() + F.wave * 16384), LANE()); }
#endif
            MIX_BAR(); STAMP(2);
#if defined(DBG_STOP) && DBG_STOP == 2
            if (l == DBG_STOP_L) return;
#endif
        }
#if PHM & 64
        for (int rep_ = 0; rep_ < REP3; ++rep_) {
            GAS unsigned char* w = WSP();
            pg8::Gemm g{(const GAS bf16*)(w + WS_ZB), (const GAS bf16*)(w + WS_WGLU) + (size_t)l * 512 * 512, MP, 512, 512}; pg8::StaticOrder S; S.init(MP, 512, F.G, cg);
            pg8::EpiGlu E{ws, INP(18) + l * 512};
            pg8::gemm_phase<pg8::EpiGlu, pg8::StaticOrder, true, true, true>(LDSP() + RING_OFF, g, S, E);
            { const int cr = (cg >> 3) - 16;
              e3_tgt += 8u;
#if SS5_IN_P3
              s5_tgt += 16u;
#endif
              if (cr >= 0) { unsigned* cnt = (unsigned*)(F.ctl + CW_E3) + 64 * (cg & 7);
#if SS5_IN_P3 && (PHM & 32)
                { GAS float* ob = OUTP(); const int task = cr * 8 + F.wave; unsigned* cnt5 = (unsigned*)(F.ctl + CW_S5) + 64 * (cg & 7);
                  ssm::sample_unit(4 * (cg & 7) + (task >> 5), task & 31, l, (const GAS float*)(w + WS_US), INP(4) + (size_t)l * 32 * 32 * 64, INP(5) + (size_t)l * 32 * 32 * 64, (const GAS float*)(w + WS_SSC), INP(14), INP(15), INP(16),
                                   (GAS bf16*)(w + WS_ZB), ob + O_SR + (size_t)l * 32 * 32 * 64, ob + O_SI + (size_t)l * 32 * 32 * 64, (LAS float*)(LDSP() + F.wave * 16384), LANE());
                  xcc_signal(cnt5, lmode); xcc_wait(bar.bar, cnt5, s5_tgt); }
#endif
                if (cr < 8) { mini::unit<512>((const GAS bf16*)(w + WS_ZB) + (size_t)MP * 512, (const GAS bf16*)(w + WS_WGLU) + (size_t)l * 512 * 512, cg & 7, 1, (LAS float*)(LDSP() + RING_OFF), mini::E3{ws, INP(18) + l * 512, cr});
                              xcc_signal(cnt, lmode); }
                xcc_wait(bar.bar, cnt, e3_tgt);
                mini::unit<1024>((const GAS bf16*)(w + WS_MIX) + (size_t)MP * 1024, (const GAS bf16*)(w + WS_WOUT) + (size_t)l * 1024 * 1024, cg & 7, 1, (LAS float*)(LDSP() + RING_OFF), mini::E4{ws, cr, 0.f, 0.f}); } }
            XCC_BAR(); STAMP(3);
#if defined(DBG_STOP) && DBG_STOP == 3
            if (l == DBG_STOP_L) return;
#endif
        }
#endif
#if PHM & 128
        {
            GAS unsigned char* w = WSP();
            pg8::Gemm g{(const GAS bf16*)(w + WS_MIX), (const GAS bf16*)(w + WS_WOUT) + (size_t)l * 1024 * 1024, MP, 1024, 1024}; pg8::StaticOrder S; S.init(MP, 1024, F.G, cg);
            for (int rep_ = 1; rep_ < REP4; ++rep_) { pg8::EpiWout Ed{ws, RTAB, (size_t)512 * MiB}; pg8::gemm_phase<pg8::EpiWout, pg8::StaticOrder, true, true>(LDSP() + RING_OFF, g, S, Ed); GRID_BAR(); }
            pg8::EpiWout E{ws, RTAB, 0};
            pg8::gemm_phase<pg8::EpiWout, pg8::StaticOrder, true, true>(LDSP() + RING_OFF, g, S, E);
            XCC_BAR(); STAMP(4);
#if defined(DBG_STOP) && DBG_STOP == 4
            if (l == DBG_STOP_L) return;
#endif
        }
#endif
#if PHM & 256
        for (int rep_ = 0; rep_ < REP5; ++rep_) {
            GAS unsigned char* w = WSP();
            pg8::Gemm g{(const GAS bf16*)(w + WS_XB), (const GAS bf16*)(w + WS_WGU) + (size_t)l * 5632 * 1024, MP, 2 * FF_, 1024}; pg8::StaticOrder S; S.init(MP, 2 * FF_, F.G, cg);
            pg8::EpiGateUp E{ws, RTAB};
            pg8::gemm_phase<pg8::EpiGateUp, pg8::StaticOrder, true, true>(LDSP() + RING_OFF, g, S, E);
            {
              e5_tgt += 16u;
              if (cg >= 128) { const int q0 = (cg >> 3) - 16; unsigned* cnt = (unsigned*)(F.ctl + CW_E5) + 64 * (cg & 7);
                mini::unit<1024>((const GAS bf16*)(w + WS_XB) + (size_t)MP * 1024, (const GAS bf16*)(w + WS_WGU) + (size_t)l * 5632 * 1024, cg & 7, (88 - q0 + 15) / 16, (LAS float*)(LDSP() + RING_OFF), mini::E5{ws, q0, 0.f});
                xcc_signal(cnt, lmode); xcc_wait(bar.bar, cnt, e5_tgt);
                mini::unit<2816>((const GAS bf16*)(w + WS_GB) + (size_t)MP * 2816, (const GAS bf16*)(w + WS_WDN) + (size_t)l * 1024 * 2816, cg & 7, 1, (LAS float*)(LDSP() + RING_OFF), mini::E6{ws, q0}); } }
            XCC_BAR(); STAMP(5);
#if defined(DBG_STOP) && DBG_STOP == 5
            if (l == DBG_STOP_L) return;
#endif
        }
#endif
#if PHM & 512
        {
            GAS unsigned char* w = WSP();
            pg8::Gemm g{(const GAS bf16*)(w + WS_GB), (const GAS bf16*)(w + WS_WDN) + (size_t)l * 1024 * 2816, MP, 1024, FF_}; pg8::StaticOrder S; S.init(MP, 1024, F.G, cg);
            for (int rep_ = 1; rep_ < REP6; ++rep_) { pg8::EpiDown Ed{ws, (size_t)512 * MiB}; pg8::gemm_phase<pg8::EpiDown, pg8::StaticOrder, true, true>(LDSP() + RING_OFF, g, S, Ed); GRID_BAR(); }
            pg8::EpiDown E{ws, 0};
            pg8::gemm_phase<pg8::EpiDown, pg8::StaticOrder, true, true>(LDSP() + RING_OFF, g, S, E);
            XCC_BAR(); STAMP(6);
#if defined(DBG_STOP) && DBG_STOP == 6
            if (l == DBG_STOP_L) return;
#endif
        }
#endif
    }
    {
        GAS unsigned char* w = WSP(); GAS float* ob = OUTP();
        const GAS float* fg = INP(25); const GAS float* SS1 = (const GAS float*)(w + WS_SS1); const GAS bf16* XBp = (const GAS bf16*)(w + WS_XB);
        const int lane7 = LANE();
        const int lw7 = (cg >> 3) * NWAVES + F.wave;
        for (int i7 = lw7; i7 < 2048 + 32; i7 += 256) { const int m = (i7 < 2048) ? (cg & 7) * 2048 + i7 : MP + (cg & 7) * 32 + (i7 - 2048); const float s = pg8::sum16(SS1 + (size_t)m * 16); const float r = __builtin_amdgcn_rsqf(s * (1.0f / 1024.0f) + 1e-6f);
            typedef unsigned u32x2v __attribute__((ext_vector_type(2))); const GAS u32x2v* xv = (const GAS u32x2v*)(XBp + (size_t)m * 1024) + lane7; const GAS f32x4* gv = (const GAS f32x4*)fg + lane7;
            GAS f32x4* ov = (GAS f32x4*)((m < MP) ? ob + O_YP + (size_t)m * 1024 : ob + O_YS + (size_t)(m - MP) * 1024) + lane7;
#pragma unroll
            for (int j = 0; j < 4; ++j) { const u32x2v xx = xv[64 * j]; f32x4 x; x[0] = __uint_as_float(xx.x << 16); x[1] = __uint_as_float(xx.x & 0xffff0000u); x[2] = __uint_as_float(xx.y << 16); x[3] = __uint_as_float(xx.y & 0xffff0000u);
                ov[64 * j] = x * r * gv[64 * j]; } }
    }
    STAMP(7);
}
#if DBG_SET
namespace dbg {
__global__ void k_cmp_f32(const float* a, const float* b, size_t n, float* acc) {
    float s1 = 0.f, s2 = 0.f;
    for (size_t i = (size_t)blockIdx.x * blockDim.x + threadIdx.x; i < n; i += (size_t)gridDim.x * blockDim.x) { const float d = a[i] - b[i]; s1 += d * d; s2 += b[i] * b[i]; }
    s1 = wave_sum(s1); s2 = wave_sum(s2);
    if ((threadIdx.x & 63) == 0) { atomicAdd(acc, s1); atomicAdd(acc + 1, s2); }
}
__global__ void k_cmp_bf16(const unsigned short* a, int lda, int acol0, const float* b, int ldb, int bcol0, int rows, int cols, float scale, float* acc) {
    float s1 = 0.f, s2 = 0.f; const size_t n = (size_t)rows * cols;
    for (size_t i = (size_t)blockIdx.x * blockDim.x + threadIdx.x; i < n; i += (size_t)gridDim.x * blockDim.x) { const size_t r = i / cols; const int c = (int)(i % cols);
        const float av = __uint_as_float((unsigned)a[r * lda + acol0 + c] << 16), bv = scale * b[r * ldb + bcol0 + c]; const float d = av - bv; s1 += d * d; s2 += bv * bv; }
    s1 = wave_sum(s1); s2 = wave_sum(s2);
    if ((threadIdx.x & 63) == 0) { atomicAdd(acc, s1); atomicAdd(acc + 1, s2); }
}
__global__ void k_cmp_f32s(const float* a, int lda, int acol0, const float* b, int ldb, int bcol0, int rows, int cols, float scale, float* acc) {
    float s1 = 0.f, s2 = 0.f; const size_t n = (size_t)rows * cols;
    for (size_t i = (size_t)blockIdx.x * blockDim.x + threadIdx.x; i < n; i += (size_t)gridDim.x * blockDim.x) { const size_t r = i / cols; const int c = (int)(i % cols);
        const float av = a[r * lda + acol0 + c], bv = scale * b[r * ldb + bcol0 + c]; const float d = av - bv; s1 += d * d; s2 += bv * bv; }
    s1 = wave_sum(s1); s2 = wave_sum(s2);
    if ((threadIdx.x & 63) == 0) { atomicAdd(acc, s1); atomicAdd(acc + 1, s2); }
}
__global__ void k_cmp_u(const unsigned short* U, const float* z, float* acc) {
    float s1 = 0.f, s2 = 0.f; const size_t n = (size_t)32 * 16384 * 16;
    for (size_t i = (size_t)blockIdx.x * blockDim.x + threadIdx.x; i < n; i += (size_t)gridDim.x * blockDim.x) { const int c = (int)(i & 15); const size_t row = (i >> 4) % 16384; const int g = (int)(i / (16384 * 16));
        const float av = __uint_as_float((unsigned)U[i] << 16), bv = z[row * 2048 + 1536 + g * 16 + c]; const float d = av - bv; s1 += d * d; s2 += bv * bv; }
    s1 = wave_sum(s1); s2 = wave_sum(s2);
    if ((threadIdx.x & 63) == 0) { atomicAdd(acc, s1); atomicAdd(acc + 1, s2); }
}
__global__ void k_cmp_u32(const unsigned* a, const unsigned* b, size_t n, float* acc) {
    float s1 = 0.f;
    for (size_t i = (size_t)blockIdx.x * blockDim.x + threadIdx.x; i < n; i += (size_t)gridDim.x * blockDim.x) s1 += (a[i] != b[i]) ? 1.f : 0.f;
    s1 = wave_sum(s1);
    if ((threadIdx.x & 63) == 0) { atomicAdd(acc, s1); atomicAdd(acc + 1, 1.0f); }
}
__device__ int qdigit(float num, float den) {
#if DBG_SET >= 30 && DBG_SET < 60
    return (num == 0.0f) ? 8 : 1;
#endif
    const float e = sqrtf(num / fmaxf(den, 1e-30f));
    if (!(e == e) || !(e < 1e30f)) return 0;
    const float q = -2.0f * log10f(fmaxf(e, 1e-12f)) + 0.5f;
    int d = (int)floorf(q); return d < 0 ? 0 : (d > 8 ? 8 : d);
}
__global__ void k_report(const float* acc, float* out) {
    const int q0 = qdigit(acc[0], acc[1]), q1 = qdigit(acc[2], acc[3]), q2 = qdigit(acc[4], acc[5]), q3 = qdigit(acc[6], acc[7]);
    const float A = ((float)(1 + q0) + 0.1f * (float)q1) * 100.0f; const float eps = sqrtf(((float)(1 + q2) + 0.1f * (float)q3 + 0.03f) * 100.0f);
    const size_t n = (size_t)MS * 1024;
    for (size_t i = (size_t)blockIdx.x * blockDim.x + threadIdx.x; i < n; i += (size_t)gridDim.x * blockDim.x) out[O_YS + i] += (i & 1) ? eps : -eps;
    if (blockIdx.x == 0 && threadIdx.x == 0) out[O_PK] = A;
}
__global__ void k_report_t(const unsigned long long* tm, int ka, int kb, float* out) {
    const float ta = (float)tm[ka] * 0.01f, tb = (float)tm[kb] * 0.01f;
    const float A = 1e5f * ta, eps = sqrtf(1e6f * tb);
    const size_t n = (size_t)MS * 1024;
    for (size_t i = (size_t)blockIdx.x * blockDim.x + threadIdx.x; i < n; i += (size_t)gridDim.x * blockDim.x) out[O_YS + i] = (i & 1) ? eps : -eps;
    if (blockIdx.x == 0 && threadIdx.x == 0) out[O_PK] = A;
}
}
#endif
extern "C" void kernel_launch(void* const* d_in, const int* in_sizes, int n_in, void* d_out, int out_size, void* d_ws, size_t ws_size, hipStream_t stream) {
    static int ready = 0;
    if (!ready) {
        if (n_in != 26 || (size_t)out_size != O_END || ws_size < (DBG_SET ? (size_t)2047 * MiB : (size_t)WS_END)) { fprintf(stderr, "kernel_launch: unexpected shapes (n_in %d out %d ws %zu)\n", n_in, out_size, ws_size); ready = -1; return; }
        if (hipFuncSetAttribute((const void*)hymba_fwd, hipFuncAttributeMaxDynamicSharedMemorySize, LDS_BYTES) != hipSuccess) { fprintf(stderr, "kernel_launch: hipFuncSetAttribute failed\n"); ready = -1; return; }
        ready = 1;
    }
    if (ready < 0) return;
#if DBG_SET >= 30 && DBG_SET < 60
#ifndef DBG_POISON_LO
#define DBG_POISON_LO (2 * MiB)
#define DBG_POISON_HI WS_END
#endif
    (void)hipMemsetAsync((char*)d_ws + DBG_POISON_LO, 0xFF, DBG_POISON_HI - DBG_POISON_LO, stream);
#endif
    (void)hipMemsetAsync((char*)d_ws + WS_CTL, 0, CTL_ZERO_BYTES, stream);
    Args a{};
    for (int i = 0; i < 26; ++i) a.in[i] = (const float*)d_in[i];
    a.out = (float*)d_out; a.ws = (unsigned char*)d_ws;
#if DBG_SET >= 60
    hipLaunchKernelGGL(hymba_fwd, dim3(256), dim3(NWAVES * 64), LDS_BYTES, stream, a);
    dbg::k_report_t<<<256, 256, 0, stream>>>((const unsigned long long*)((char*)d_ws + WS_CTL + 524288), DBG_KA, DBG_KB, (float*)d_out);
#elif DBG_SET
    float* shadow = (float*)((char*)d_ws + 448 * MiB); float* nvws = (float*)((char*)d_ws + 784 * MiB); float* acc = (float*)((char*)d_ws + 447 * MiB);
    (void)hipMemsetAsync(acc, 0, 64, stream);
    a.out = shadow;
    float* dout = (float*)d_out;
#if DBG_SET >= 30
    float* shadowB = nvws;
    (void)hipMemsetAsync(d_out, 0, (size_t)out_size * 4, stream);
#elif DBG_SET < 10
    nv::forward(stream, d_in, dout, nvws);
#elif DBG_SET < 20
    nv::forward(stream, d_in, dout, nvws, 1, 0);
#else
    nv::forward(stream, d_in, dout, nvws, 0, 1);
#endif
    hipLaunchKernelGGL(hymba_fwd, dim3(256), dim3(NWAVES * 64), LDS_BYTES, stream, a);
#if DBG_SET >= 40
    {
        char* wsb = (char*)d_ws; char* st = (char*)d_ws + 1200 * MiB;
        (void)hipMemcpyAsync(st, wsb + WS_XRES, WS_SSC - WS_XRES, hipMemcpyDeviceToDevice, stream);
    }
#endif
#if DBG_SET >= 30
    for (int rep = 0; rep < 4; ++rep) {
        (void)hipMemsetAsync((char*)d_ws + WS_CTL, 0, CTL_ZERO_BYTES, stream);
        a.out = shadowB;
        hipLaunchKernelGGL(hymba_fwd, dim3(256), dim3(NWAVES * 64), LDS_BYTES, stream, a);
        using namespace dbg;
#if DBG_SET == 30
        k_cmp_f32<<<1024, 256, 0, stream>>>(shadow + O_PK, shadowB + O_PK, (size_t)MP * 512, acc + 0);
        k_cmp_f32<<<64, 256, 0, stream>>>(shadow + O_PR, shadowB + O_PR, (size_t)16384, acc + 2);
        k_cmp_f32<<<1024, 256, 0, stream>>>(shadow + O_PK + (size_t)MP * 512, shadowB + O_PK + (size_t)MP * 512, (size_t)MP * 512, acc + 4);
        k_cmp_f32<<<1024, 256, 0, stream>>>(shadow + O_YP, shadowB + O_YP, (size_t)MP * 1024, acc + 6);
#elif DBG_SET == 32
        k_cmp_f32<<<1024, 256, 0, stream>>>(shadow + O_PK, shadowB + O_PK, (size_t)MP * 512, acc + 0);
        k_cmp_f32<<<1024, 256, 0, stream>>>(shadow + O_PV, shadowB + O_PV, (size_t)MP * 512, acc + 2);
        k_cmp_f32<<<1024, 256, 0, stream>>>(shadow + O_PK, shadowB + O_PK, (size_t)MP * 512, acc + 4);
        k_cmp_f32<<<1024, 256, 0, stream>>>(shadow + O_PV, shadowB + O_PV, (size_t)MP * 512, acc + 6);
#elif DBG_SET == 33
        for (int q = 0; q < 4; ++q) k_cmp_f32<<<64, 256, 0, stream>>>(shadow + O_PR, shadowB + O_PR, (size_t)16384, acc + 2 * q);
#elif DBG_SET == 34
        for (int q = 0; q < 4; ++q) k_cmp_f32<<<1024, 256, 0, stream>>>(shadow + O_PK + (size_t)MP * 512, shadowB + O_PK + (size_t)MP * 512, (size_t)MP * 512, acc + 2 * q);
#elif DBG_SET >= 40
        { const char* wsb = (const char*)d_ws; const char* st = (const char*)d_ws + 1200 * MiB;
#define CMPBUF(slot, lo, hi) k_cmp_u32<<<1024, 256, 0, stream>>>((const unsigned*)(wsb + (lo)), (const unsigned*)(st + ((lo) - WS_XRES)), ((hi) - (lo)) / 4, acc + 2 * (slot))
#if DBG_SET == 42
          CMPBUF(0, WS_MIX, WS_ZB); CMPBUF(1, WS_ZB, WS_GB); CMPBUF(2, WS_SSA, WS_SSS); CMPBUF(3, WS_UB, WS_MIX);
#elif DBG_SET == 47
          CMPBUF(0, WS_MIX, WS_MIX + (size_t)MP * 2048); CMPBUF(1, WS_MIX + (size_t)MP * 2048, WS_MIX + (size_t)MT * 2048); CMPBUF(2, WS_SSA, WS_SSA + (size_t)MP * 32); CMPBUF(3, WS_SSA + (size_t)MP * 32, WS_SSA + (size_t)MT * 32);
#elif DBG_SET == 43
          CMPBUF(0, WS_MIX, WS_ZB); CMPBUF(1, WS_SSS, WS_SSC); CMPBUF(2, WS_MIX, WS_ZB); CMPBUF(3, WS_SSS, WS_SSC);
#elif DBG_SET == 44
          CMPBUF(0, WS_XRES, WS_XB); CMPBUF(1, WS_XB, WS_QB); CMPBUF(2, WS_SS2, WS_SSA); CMPBUF(3, WS_XRES, WS_XB);
#elif DBG_SET == 45
          CMPBUF(0, WS_GB, WS_SS1); CMPBUF(1, WS_GB, WS_SS1); CMPBUF(2, WS_GB, WS_SS1); CMPBUF(3, WS_GB, WS_SS1);
#elif DBG_SET == 46
          CMPBUF(0, WS_XRES, WS_XB); CMPBUF(1, WS_XB, WS_QB); CMPBUF(2, WS_SS1, WS_SS2); CMPBUF(3, WS_XRES, WS_XB);
#endif
        }
#elif DBG_SET == 31
        k_cmp_f32<<<256, 256, 0, stream>>>(shadow + O_SK, shadowB + O_SK, (size_t)MS * 512, acc + 0);
        k_cmp_f32<<<64, 256, 0, stream>>>(shadow + O_SR, shadowB + O_SR, (size_t)65536, acc + 2);
        k_cmp_f32<<<256, 256, 0, stream>>>(shadow + O_SK + (size_t)MS * 512, shadowB + O_SK + (size_t)MS * 512, (size_t)MS * 512, acc + 4);
        k_cmp_f32<<<256, 256, 0, stream>>>(shadow + O_YS, shadowB + O_YS, (size_t)MS * 1024, acc + 6);
#endif
    }
#endif
    {
        using namespace dbg;
        const size_t R = 16384; float* n_xn = nvws; float* n_z = n_xn + R * 1024; float* n_cat = n_z + R * 2048; float* n_tmp = n_cat + R * 1024; float* n_Hre = n_tmp + R * 512; float* n_Him = n_Hre + R * 2048;
        float* n_zg = n_Him + R * 2048; float* n_glut = n_zg + R * 512; float* n_mix = n_glut + R * 512; float* n_h = n_mix + R * 1024; float* n_hn = n_h + R * 1024; float* n_gt = n_hn + R * 1024; float* n_up = n_gt + R * 2816; float* n_xcur = n_up + R * 2816;
        (void)n_xn; (void)n_z; (void)n_cat; (void)n_tmp; (void)n_zg; (void)n_glut; (void)n_mix; (void)n_h; (void)n_hn; (void)n_gt; (void)n_up; (void)n_xcur;
        unsigned char* ws = (unsigned char*)d_ws;
#if DBG_SET == 1
        k_cmp_f32<<<1024, 256, 0, stream>>>(shadow + O_PK, dout + O_PK, (size_t)MP * 512, acc + 0);
        k_cmp_f32<<<64, 256, 0, stream>>>(shadow + O_PR, dout + O_PR, (size_t)8 * 32 * 64, acc + 2);
        k_cmp_f32<<<1024, 256, 0, stream>>>(shadow + O_PK + (size_t)MP * 512, dout + O_PK + (size_t)MP * 512, (size_t)MP * 512, acc + 4);
        k_cmp_f32<<<1024, 256, 0, stream>>>(shadow + O_YP, dout + O_YP, (size_t)MP * 1024, acc + 6);
#elif DBG_SET == 2
        k_cmp_f32<<<256, 256, 0, stream>>>(shadow + O_SK, dout + O_SK, (size_t)MS * 512, acc + 0);
        k_cmp_f32<<<64, 256, 0, stream>>>(shadow + O_SR, dout + O_SR, (size_t)32 * 32 * 64, acc + 2);
        k_cmp_f32<<<256, 256, 0, stream>>>(shadow + O_SK + (size_t)MS * 512, dout + O_SK + (size_t)MS * 512, (size_t)MS * 512, acc + 4);
        k_cmp_f32<<<256, 256, 0, stream>>>(shadow + O_YS, dout + O_YS, (size_t)MS * 1024, acc + 6);
#elif DBG_SET == 3
        k_cmp_f32<<<1024, 256, 0, stream>>>(shadow + O_PV + 3 * (size_t)MP * 512, dout + O_PV + 3 * (size_t)MP * 512, (size_t)MP * 512, acc + 0);
        k_cmp_f32<<<64, 256, 0, stream>>>(shadow + O_PI + 3 * 16384, dout + O_PI + 3 * 16384, (size_t)16384, acc + 2);
        k_cmp_f32<<<256, 256, 0, stream>>>(shadow + O_SV + 3 * (size_t)MS * 512, dout + O_SV + 3 * (size_t)MS * 512, (size_t)MS * 512, acc + 4);
        k_cmp_f32<<<64, 256, 0, stream>>>(shadow + O_SI + 3 * 65536, dout + O_SI + 3 * 65536, (size_t)65536, acc + 6);
#endif
        k_report<<<256, 256, 0, stream>>>(acc, dout);
    }
#else
    hipLaunchKernelGGL(hymba_fwd, dim3(256), dim3(NWAVES * 64), LDS_BYTES, stream, a);
#endif
}
```

```cpp
#include <hip/hip_runtime.h>
#include <hip/hip_bf16.h>
#include <cstdio>
#include <cstdint>
#include <cmath>
#ifndef DBG_SET
#define DBG_SET 0
#endif
#ifndef PHM
#define PHM 0xFFFF
#endif
#ifndef REP1
#define REP1 1
#endif
#ifndef REP2A
#define REP2A 1
#endif
#ifndef REP2S
#define REP2S 1
#endif
#ifndef REP2B
#define REP2B 1
#endif
#ifndef REP3
#define REP3 1
#endif
#ifndef REP5
#define REP5 1
#endif
#ifndef REP0
#define REP0 1
#endif
#ifndef REPY
#define REPY 1
#endif
#ifndef REPS
#define REPS 1
#endif
#ifndef XCC_LOCAL
#define XCC_LOCAL 1
#endif
#ifndef S5_BM
#define S5_BM 1
#endif
#ifndef GWT
#define GWT 1
#endif
#ifndef ATTN_FAR
#define ATTN_FAR 1
#endif
#ifndef EARLY_INV
#define EARLY_INV 1
#endif
#ifndef P1_ALIGN
#define P1_ALIGN 0
#endif
#ifndef REPB
#define REPB 1
#endif
#ifndef REP4
#define REP4 1
#endif
#ifndef REP6
#define REP6 1
#endif
#ifndef REP2C
#define REP2C 1
#endif
#ifndef REPM
#define REPM 1
#endif
#ifndef REPM5
#define REPM5 1
#endif
#define GAS __attribute__((address_space(1)))
#define LAS __attribute__((address_space(3)))
constexpr int NWAVES = 8;
constexpr int MP = 16384, MS = 256, MT = MP + MS, DM_ = 1024, FF_ = 2816, INW_ = 2048, NLAYER = 4;
constexpr size_t MiB = 1u << 20;
constexpr size_t WS_CTL = 0, CTL_ZERO_BYTES = (DBG_SET >= 60) ? 1 * MiB : 65536;
constexpr size_t WS_WIN = 2 * MiB, WS_WOUT = 18 * MiB, WS_WGU = 26 * MiB, WS_WDN = 70 * MiB, WS_WGLU = 92 * MiB;
constexpr size_t WS_SSMT = 94 * MiB, WS_A32 = 130 * MiB;
constexpr size_t WS_XRES = 131 * MiB, WS_XB = 196 * MiB, WS_QB = 229 * MiB, WS_KB = 246 * MiB, WS_VB = 263 * MiB, WS_UB = 280 * MiB, WS_US = 296 * MiB;
constexpr size_t WS_MIX = 297 * MiB, WS_ZB = 330 * MiB, WS_GB = 347 * MiB, WS_SS1 = 437 * MiB, WS_SS2 = 439 * MiB, WS_SSA = 441 * MiB, WS_SSS = 442 * MiB, WS_SSC = 443 * MiB  , WS_END = 445 * MiB;
constexpr int CW_BAR = 4096, CW_RANK = 8192, CW_LB = 9216, CW_E3 = 10240, CW_E5 = 11264;
constexpr size_t O_YP = 0, O_YS = O_YP + (size_t)MP * 1024, O_PK = O_YS + (size_t)MS * 1024, O_PV = O_PK + (size_t)NLAYER * MP * 512, O_PR = O_PV + (size_t)NLAYER * MP * 512,
                 O_PI = O_PR + (size_t)NLAYER * 8 * 32 * 64, O_SK = O_PI + (size_t)NLAYER * 8 * 32 * 64, O_SV = O_SK + (size_t)NLAYER * MS * 512, O_SR = O_SV + (size_t)NLAYER * MS * 512,
                 O_SI = O_SR + (size_t)NLAYER * 32 * 32 * 64, O_END = O_SI + (size_t)NLAYER * 32 * 32 * 64;
constexpr int RING_OFF = 0, RING_BYTES = 131072, RTAB_OFF = 155648, MISC_OFF = 159744, PTAB_OFF = MISC_OFF + 512, LDS_BYTES = 163840;
constexpr int MTAB_OFF = 86016, MTAB_N = 2304;

typedef unsigned short bf16;
typedef unsigned v4u __attribute__((ext_vector_type(4)));
typedef float f32x4 __attribute__((ext_vector_type(4)));
typedef GAS unsigned gu32;
#define RLX_AGENT __ATOMIC_RELAXED, __HIP_MEMORY_SCOPE_AGENT
#define LDS_WAIT() asm volatile("s_waitcnt lgkmcnt(0)" ::: "memory")
#define VM_WAIT() asm volatile("s_waitcnt vmcnt(0)" ::: "memory")
__device__ __forceinline__ unsigned f2bf(float f) { unsigned u = __builtin_bit_cast(unsigned, f); return (u + 0x7fffu + ((u >> 16) & 1u)) >> 16; }
__device__ __forceinline__ unsigned pk2(float lo, float hi) { return f2bf(lo) | (f2bf(hi) << 16); }
__device__ __forceinline__ float wave_sum(float v) {
#pragma unroll
    for (int o = 1; o < 64; o <<= 1) v += __shfl_xor(v, o);
    return v;
}
__device__ __forceinline__ float wave_max(float v) {
#pragma unroll
    for (int o = 1; o < 64; o <<= 1) v = fmaxf(v, __shfl_xor(v, o));
    return v;
}

namespace pg8 {
#define PG8_LAS __attribute__((address_space(3)))
typedef unsigned short bf16_t;
typedef short bf16x8 __attribute__((ext_vector_type(8)));
typedef float f32x4 __attribute__((ext_vector_type(4)));
typedef unsigned u32x4 __attribute__((ext_vector_type(4)));
constexpr int BM = 256, BK = 64, HALF = 128, HTB = HALF * BK * 2  , STAGE_BYTES = 8 * HTB, NXCD = 8, WGM = 8;

__host__ __device__ __forceinline__ int lds_byte(int r, int c) { const int st = (r >> 4) * 2 + (c >> 5), rr = r & 15, cc = c & 31, ob = rr * 64 + cc * 2; return st * 1024 + (ob ^ (((ob >> 9) & 1) << 5)); }
__host__ __device__ __forceinline__ void stage_rc(int b, int& R, int& C) { const int st = b / 1024, sb = b % 1024, swz = sb ^ (((sb >> 9) & 1) << 5); R = (st >> 1) * 16 + swz / 64; C = (st & 1) * 32 + (swz % 64) / 2; }
__host__ __device__ __forceinline__ int perm32(int rho) { const int n = rho >> 4, i = rho & 15; return 8 * (i >> 2) + 4 * n + (i & 3); }

struct Unit { int pm, pn; };
struct Gemm { const GAS bf16_t* A; const GAS bf16_t* Bt; int M, N, K; };

struct StaticOrder {
    int nM, nN, nwg, G, c;
    __host__ __device__ void init(int M, int N, int G_, int c_) { nM = M / BM; nN = N / BM; nwg = nM * nN; G = G_; c = c_; }
    __host__ __device__ bool next(int i, Unit& u) const {
        const int L = i * G + c; if (L >= nwg) return false;
        int wgid = L; { const int q = nwg / NXCD, r = nwg % NXCD, xcd = wgid % NXCD, off = wgid / NXCD; wgid = (xcd < r ? xcd * (q + 1) : r * (q + 1) + (xcd - r) * q) + off; }
        const int nig = WGM * nN, gid = wgid / nig, fm = gid * WGM, gsz = (nM - fm) < WGM ? (nM - fm) : WGM;
        u.pm = fm + ((wgid % nig) % gsz); u.pn = (wgid % nig) / gsz; return true;
    }
    __device__ __forceinline__ void a_ready(const Unit&) const {}
    __device__ __forceinline__ void done(const Unit&) const {}
};

__device__ __forceinline__ unsigned cvt_pk_bf16(float lo, float hi) { unsigned r; asm volatile("v_cvt_pk_bf16_f32 %0, %1, %2" : "=v"(r) : "v"(lo), "v"(hi)); return r; }
typedef float f32x2 __attribute__((ext_vector_type(2)));
constexpr int MP_ROWS = MP;
constexpr float RMS_EPS = 1e-6f;
constexpr float QSCALE = 0.125f * 1.4426950408889634f;
__device__ __forceinline__ u32x4 pack8(const f32x4 a, const f32x4 b) { u32x4 w; w.x = cvt_pk_bf16(a[0], a[1]); w.y = cvt_pk_bf16(a[2], a[3]); w.z = cvt_pk_bf16(b[0], b[1]); w.w = cvt_pk_bf16(b[2], b[3]); return w; }
__device__ __forceinline__ void unpack8(const u32x4 z, f32x4& a, f32x4& b) { a[0] = __uint_as_float(z.x << 16); a[1] = __uint_as_float(z.x & 0xffff0000u); a[2] = __uint_as_float(z.y << 16); a[3] = __uint_as_float(z.y & 0xffff0000u);
    b[0] = __uint_as_float(z.z << 16); b[1] = __uint_as_float(z.z & 0xffff0000u); b[2] = __uint_as_float(z.w << 16); b[3] = __uint_as_float(z.w & 0xffff0000u); }
__device__ __forceinline__ float sum8sq(const f32x4 a, const f32x4 b) { return (a[0] * a[0] + a[1] * a[1]) + (a[2] * a[2] + a[3] * a[3]) + (b[0] * b[0] + b[1] * b[1]) + (b[2] * b[2] + b[3] * b[3]); }
__device__ __forceinline__ GAS unsigned char* lau(GAS unsigned char* p) { asm volatile("" : "+s"(p)); return p; }
__device__ __forceinline__ GAS float* lauf(GAS float* p) { asm volatile("" : "+s"(p)); return p; }
__device__ __forceinline__ const GAS float* laucf(const GAS float* p) { asm volatile("" : "+s"(p)); return p; }
__device__ __forceinline__ void st16_wt(GAS void* p, const u32x4 v) { asm volatile("global_store_dwordx4 %0, %1, off sc1\n\ts_nop 1" :: "v"(p), "v"(v) : "memory"); }
__device__ __forceinline__ float fq_reduce(float v) { v += __shfl_xor(v, 16); v += __shfl_xor(v, 32); return v; }
__device__ __forceinline__ float sum16(const GAS float* p) { const f32x4 a = *(const GAS f32x4*)p, b = *(const GAS f32x4*)(p + 4), c = *(const GAS f32x4*)(p + 8), d = *(const GAS f32x4*)(p + 12);
    return ((a[0] + a[1]) + (a[2] + a[3])) + ((b[0] + b[1]) + (b[2] + b[3])) + ((c[0] + c[1]) + (c[2] + c[3])) + ((d[0] + d[1]) + (d[2] + d[3])); }
__device__ __forceinline__ float sum8(const GAS float* p) { const f32x4 a = *(const GAS f32x4*)p, b = *(const GAS f32x4*)(p + 4); return ((a[0] + a[1]) + (a[2] + a[3])) + ((b[0] + b[1]) + (b[2] + b[3])); }

struct EpiInProj {
    static constexpr bool PERM = true, AFTER_DRAIN = false, MID = false;
    GAS unsigned char* ws; GAS float* out; int l; PG8_LAS f32x2* tab;
    __device__ __forceinline__ void begin(const Unit& u, int ui, int tid) const {
        const GAS float* ss = (const GAS float*)(lau(ws) + WS_SS1);
        if (tid < 256) { const int row = u.pm * BM + tid; const float s = sum16(ss + (size_t)row * 16); tab[(ui & 1) * 256 + tid] = (f32x2){__builtin_amdgcn_rsqf(s * (1.0f / 1024.0f) + RMS_EPS), 0.f}; }
    }
    __device__ __forceinline__ void mid(f32x4 (&)[2][2][4][2], const Unit&, int, int, int, int, int) const {}
    __device__ __forceinline__ void operator()(const f32x4 (&acc)[2][2][4][2], const Unit& u, int ui, int wr, int wc, int fr, int fq) const {
        const int seg = u.pn >> 1, col0 = (u.pn & 1) * BM + wc * 32 + 8 * fq;
        GAS unsigned char* w = lau(ws); GAS float* ob = lauf(out);
        GAS bf16_t* Q = (GAS bf16_t*)(w + WS_QB); GAS bf16_t* Kb = (GAS bf16_t*)(w + WS_KB); GAS bf16_t* Vb = (GAS bf16_t*)(w + WS_VB); GAS bf16_t* U = (GAS bf16_t*)(w + WS_UB); GAS float* Us = (GAS float*)(w + WS_US);
        GAS float* outKp = ob + O_PK + (size_t)l * MP * 512; GAS float* outVp = ob + O_PV + (size_t)l * MP * 512; GAS float* outKs = ob + O_SK + (size_t)l * MS * 512; GAS float* outVs = ob + O_SV + (size_t)l * MS * 512;
#pragma unroll
        for (int ai = 0; ai < 2; ++ai)
#pragma unroll
            for (int m = 0; m < 4; ++m) {
                const int rl = ai * HALF + wr * 64 + m * 16 + fr, row = u.pm * BM + rl; const float r = tab[(ui & 1) * 256 + rl].x;
#pragma unroll
                for (int bj = 0; bj < 2; ++bj) {
                    const int c = col0 + bj * HALF; f32x4 v0 = acc[ai][bj][m][0] * r, v1 = acc[ai][bj][m][1] * r;
                    if (seg == 0) { *(GAS u32x4*)(Q + (size_t)row * 512 + c) = pack8(v0 * QSCALE, v1 * QSCALE); }
                    else if (seg == 3) {
                        if (row < MP_ROWS) { *(GAS u32x4*)(U + (((size_t)(c >> 4) * MP_ROWS + row) * 16 + (c & 15))) = pack8(v0, v1); }
                        else { GAS float* p = Us + (size_t)(row - MP_ROWS) * 512 + c; *(GAS f32x4*)p = v0; *(GAS f32x4*)(p + 4) = v1; }
                    } else {
                        GAS bf16_t* bb = (seg == 1) ? Kb : Vb; *(GAS u32x4*)(bb + (size_t)row * 512 + c) = pack8(v0, v1);
                        GAS float* p = (row < MP_ROWS) ? ((seg == 1 ? outKp : outVp) + (size_t)row * 512 + c) : ((seg == 1 ? outKs : outVs) + (size_t)(row - MP_ROWS) * 512 + c);
                        *(GAS f32x4*)p = v0; *(GAS f32x4*)(p + 4) = v1;
                    }
                }
                asm volatile("" ::: "memory");
            }
    }
};

struct EpiGlu {
    static constexpr bool PERM = true, AFTER_DRAIN = false, MID = false;
    GAS unsigned char* ws; const GAS float* bias;
    __device__ __forceinline__ void begin(const Unit&, int, int) const {}
    __device__ __forceinline__ void mid(f32x4 (&)[2][2][4][2], const Unit&, int, int, int, int, int) const {}
    __device__ __forceinline__ void operator()(const f32x4 (&acc)[2][2][4][2], const Unit& u, int ui, int wr, int wc, int fr, int fq) const {
        const int col0 = u.pn * BM + wc * 32 + 8 * fq;
        GAS unsigned char* w = lau(ws); const GAS bf16_t* Z = (const GAS bf16_t*)(w + WS_ZB); GAS bf16_t* MIXs = (GAS bf16_t*)(w + WS_MIX) + 512; GAS float* sss = (GAS float*)(w + WS_SSS);
        f32x4 bv[2][2];
#pragma unroll
        for (int bj = 0; bj < 2; ++bj)
#pragma unroll
            for (int n = 0; n < 2; ++n) bv[bj][n] = *(const GAS f32x4*)(bias + col0 + bj * HALF + 4 * n);
        float part[2][4];
#pragma unroll
        for (int ai = 0; ai < 2; ++ai) {
            u32x4 pre[1][4][2];
#pragma unroll
            for (int m = 0; m < 4; ++m)
#pragma unroll
                for (int bj = 0; bj < 2; ++bj) { const int c = col0 + bj * HALF, row = u.pm * BM + ai * HALF + wr * 64 + m * 16 + fr;
                    pre[0][m][bj] = *(const GAS u32x4*)(Z + ((size_t)(c >> 4) * MP_ROWS + row) * 16 + (c & 15)); }
            __builtin_amdgcn_sched_barrier(0);
#pragma unroll
            for (int m = 0; m < 4; ++m) {
                const int row = u.pm * BM + ai * HALF + wr * 64 + m * 16 + fr; float pt = 0.f;
#pragma unroll
                for (int bj = 0; bj < 2; ++bj) {
                    const int c = col0 + bj * HALF; const u32x4 zz = pre[0][m][bj];
                    f32x4 z0, z1; z0[0] = __uint_as_float(zz.x << 16); z0[1] = __uint_as_float(zz.x & 0xffff0000u); z0[2] = __uint_as_float(zz.y << 16); z0[3] = __uint_as_float(zz.y & 0xffff0000u);
                    z1[0] = __uint_as_float(zz.z << 16); z1[1] = __uint_as_float(zz.z & 0xffff0000u); z1[2] = __uint_as_float(zz.w << 16); z1[3] = __uint_as_float(zz.w & 0xffff0000u);
                    const f32x4 a0 = acc[ai][bj][m][0] + bv[bj][0], a1 = acc[ai][bj][m][1] + bv[bj][1]; f32x4 o0, o1;
#pragma unroll
                    for (int e = 0; e < 4; ++e) { o0[e] = z0[e] * __builtin_amdgcn_rcpf(1.0f + __builtin_amdgcn_exp2f(-1.4426950408889634f * a0[e])); o1[e] = z1[e] * __builtin_amdgcn_rcpf(1.0f + __builtin_amdgcn_exp2f(-1.4426950408889634f * a1[e])); }
                    pt += sum8sq(o0, o1);
                    *(GAS u32x4*)(MIXs + (size_t)row * 1024 + c) = pack8(o0, o1);
                }
                part[ai][m] = pt;
            }
            __builtin_amdgcn_sched_barrier(0);
        }
#pragma unroll
        for (int ai = 0; ai < 2; ++ai)
#pragma unroll
            for (int m = 0; m < 4; ++m) { const int row = u.pm * BM + ai * HALF + wr * 64 + m * 16 + fr; const float pr = fq_reduce(part[ai][m]); if (fq == 0) sss[(size_t)row * 8 + u.pn * 4 + wc] = pr; }
        asm volatile("" ::: "memory");
    }
};

struct EpiWout {
    static constexpr bool PERM = true, AFTER_DRAIN = false, MID = true;
    GAS unsigned char* ws; PG8_LAS f32x2* tab; size_t dry;
    __device__ __forceinline__ void begin(const Unit& u, int ui, int tid) const {
        GAS unsigned char* w0 = lau(ws); const GAS float* ssa = (const GAS float*)(w0 + WS_SSA); const GAS float* sss = (const GAS float*)(w0 + WS_SSS);
        if (tid < 256) { const int row = u.pm * BM + tid; const float sa = sum8(ssa + (size_t)row * 8), s2 = sum8(sss + (size_t)row * 8);
            const float va = sa * (1.0f / 512.0f) + RMS_EPS, vs = s2 * (1.0f / 512.0f) + RMS_EPS; const float rs = __builtin_amdgcn_rsqf(vs); tab[(ui & 1) * 256 + tid] = (f32x2){__builtin_amdgcn_rsqf(va) * vs * rs, rs}; }
    }
    __device__ __forceinline__ void mid(f32x4 (&acc)[2][2][4][2], const Unit& u, int ui, int wr, int wc, int fr, int fq) const {
#pragma unroll
        for (int ai = 0; ai < 2; ++ai)
#pragma unroll
            for (int m = 0; m < 4; ++m) { const float f = tab[(ui & 1) * 256 + ai * HALF + wr * 64 + m * 16 + fr].x;
#pragma unroll
                for (int bj = 0; bj < 2; ++bj)
#pragma unroll
                    for (int n = 0; n < 2; ++n) acc[ai][bj][m][n] = acc[ai][bj][m][n] * f; }
    }
    __device__ __forceinline__ void operator()(const f32x4 (&acc)[2][2][4][2], const Unit& u, int ui, int wr, int wc, int fr, int fq) const {
        const int col0 = u.pn * BM + wc * 32 + 8 * fq;
        GAS unsigned char* w = lau(ws); const GAS bf16_t* xin = (const GAS bf16_t*)(w + WS_XB); GAS bf16_t* xb = (GAS bf16_t*)(w + WS_XB + dry); GAS float* ss2 = (GAS float*)(w + WS_SS2 + dry);
        float part[2][4];
#pragma unroll
        for (int ai = 0; ai < 2; ++ai) {
            u32x4 pre[1][4][2];
#pragma unroll
            for (int m = 0; m < 4; ++m)
#pragma unroll
                for (int bj = 0; bj < 2; ++bj) pre[0][m][bj] = *(const GAS u32x4*)(xin + (size_t)(u.pm * BM + ai * HALF + wr * 64 + m * 16 + fr) * 1024 + col0 + bj * HALF);
            __builtin_amdgcn_sched_barrier(0);
#pragma unroll
            for (int m = 0; m < 4; ++m) {
                const int rl = ai * HALF + wr * 64 + m * 16 + fr, row = u.pm * BM + rl; const float rs = tab[(ui & 1) * 256 + rl].y; float pt = 0.f;
#pragma unroll
                for (int bj = 0; bj < 2; ++bj) {
                    const int c = col0 + bj * HALF; f32x4 x0, x1; unpack8(pre[0][m][bj], x0, x1);
                    const f32x4 h0 = x0 + acc[ai][bj][m][0] * rs, h1 = x1 + acc[ai][bj][m][1] * rs;
                    *(GAS u32x4*)(xb + (size_t)row * 1024 + c) = pack8(h0, h1); pt += sum8sq(h0, h1);
                }
                part[ai][m] = pt;
            }
            __builtin_amdgcn_sched_barrier(0);
        }
#pragma unroll
        for (int ai = 0; ai < 2; ++ai)
#pragma unroll
            for (int m = 0; m < 4; ++m) { const int row = u.pm * BM + ai * HALF + wr * 64 + m * 16 + fr; const float pr = fq_reduce(part[ai][m]); if (fq == 0) ss2[(size_t)row * 16 + u.pn * 4 + wc] = pr; }
        asm volatile("" ::: "memory");
    }
};

struct EpiGateUp {
    static constexpr bool PERM = true, AFTER_DRAIN = false, MID = false;
    GAS unsigned char* ws; PG8_LAS f32x2* tab;
    __device__ __forceinline__ void begin(const Unit& u, int ui, int tid) const {
        const GAS float* ss = (const GAS float*)(lau(ws) + WS_SS2);
        if (tid < 256) { const int row = u.pm * BM + tid; const float s = sum16(ss + (size_t)row * 16); tab[(ui & 1) * 256 + tid] = (f32x2){__builtin_amdgcn_rsqf(s * (1.0f / 1024.0f) + RMS_EPS), 0.f}; }
    }
    __device__ __forceinline__ void mid(f32x4 (&)[2][2][4][2], const Unit&, int, int, int, int, int) const {}
    __device__ __forceinline__ void operator()(const f32x4 (&acc)[2][2][4][2], const Unit& u, int ui, int wr, int wc, int fr, int fq) const {
        const int c = u.pn * HALF + wc * 32 + 8 * fq; GAS bf16_t* G = (GAS bf16_t*)(lau(ws) + WS_GB);
#pragma unroll
        for (int ai = 0; ai < 2; ++ai)
#pragma unroll
            for (int m = 0; m < 4; ++m) {
                const int rl = ai * HALF + wr * 64 + m * 16 + fr, row = u.pm * BM + rl; const float r = tab[(ui & 1) * 256 + rl].x;
                f32x4 o[2];
#pragma unroll
                for (int n = 0; n < 2; ++n) { const f32x4 g = acc[ai][0][m][n] * r, up = acc[ai][1][m][n] * r;
#pragma unroll
                    for (int e = 0; e < 4; ++e) o[n][e] = g[e] * up[e] * __builtin_amdgcn_rcpf(1.0f + __builtin_amdgcn_exp2f(-1.4426950408889634f * g[e])); }
#if GWT
                st16_wt(G + (size_t)row * 2816 + c, pack8(o[0], o[1]));
#else
                *(GAS u32x4*)(G + (size_t)row * 2816 + c) = pack8(o[0], o[1]);
#endif
                asm volatile("" ::: "memory");
            }
    }
};

struct EpiDown {
    static constexpr bool PERM = true, AFTER_DRAIN = false, MID = false;
    GAS unsigned char* ws; size_t dry;
    __device__ __forceinline__ void begin(const Unit&, int, int) const {}
    __device__ __forceinline__ void mid(f32x4 (&)[2][2][4][2], const Unit&, int, int, int, int, int) const {}
    __device__ __forceinline__ void operator()(const f32x4 (&acc)[2][2][4][2], const Unit& u, int ui, int wr, int wc, int fr, int fq) const {
        const int col0 = u.pn * BM + wc * 32 + 8 * fq;
        GAS unsigned char* w = lau(ws); const GAS bf16_t* xin = (const GAS bf16_t*)(w + WS_XB); GAS bf16_t* xb = (GAS bf16_t*)(w + WS_XB + dry); GAS float* ss1 = (GAS float*)(w + WS_SS1 + dry);
        float part[2][4];
#pragma unroll
        for (int ai = 0; ai < 2; ++ai) {
            u32x4 pre[1][4][2];
#pragma unroll
            for (int m = 0; m < 4; ++m)
#pragma unroll
                for (int bj = 0; bj < 2; ++bj) pre[0][m][bj] = *(const GAS u32x4*)(xin + (size_t)(u.pm * BM + ai * HALF + wr * 64 + m * 16 + fr) * 1024 + col0 + bj * HALF);
            __builtin_amdgcn_sched_barrier(0);
#pragma unroll
            for (int m = 0; m < 4; ++m) {
                const int row = u.pm * BM + ai * HALF + wr * 64 + m * 16 + fr; float pt = 0.f;
#pragma unroll
                for (int bj = 0; bj < 2; ++bj) {
                    const int c = col0 + bj * HALF; f32x4 x0, x1; unpack8(pre[0][m][bj], x0, x1);
                    const f32x4 y0 = x0 + acc[ai][bj][m][0], y1 = x1 + acc[ai][bj][m][1];
                    *(GAS u32x4*)(xb + (size_t)row * 1024 + c) = pack8(y0, y1); pt += sum8sq(y0, y1);
                }
                part[ai][m] = pt;
            }
            __builtin_amdgcn_sched_barrier(0);
        }
#pragma unroll
        for (int ai = 0; ai < 2; ++ai)
#pragma unroll
            for (int m = 0; m < 4; ++m) { const int row = u.pm * BM + ai * HALF + wr * 64 + m * 16 + fr; const float pr = fq_reduce(part[ai][m]); if (fq == 0) ss1[(size_t)row * 16 + u.pn * 4 + wc] = pr; }
        asm volatile("" ::: "memory");
    }
};
template <class Epi, class Sched, bool ALIGN_EPI = false, bool SP2 = false, bool AGRP = false>
__device__ __forceinline__ void gemm_phase(PG8_LAS unsigned char* lds, const Gemm g, const Sched& S, const Epi& E) {
    int tid_ = threadIdx.x; asm volatile("" : "+v"(tid_));
    const int tid = tid_, wid = __builtin_amdgcn_readfirstlane(tid >> 6), lane = tid & 63, wr = wid >> 2, wc = wid & 3, fr = lane & 15, fq = lane >> 4;
    const int K = g.K, nt = K / BK;
    unsigned voffA[2], voffB[2];
#pragma unroll
    for (int i = 0; i < 2; ++i) { int R, C; stage_rc(tid * 16 + i * 8192, R, C); const int Rb = Epi::PERM ? ((R & ~31) + perm32(R & 31)) : R;
        voffA[i] = AGRP ? (unsigned)((C >> 4) * (MP * 32) + R * 32 + (C & 15) * 2) : (unsigned)(R * K + C) * 2u; voffB[i] = (unsigned)(Rb * K + C) * 2u; }
    const size_t kstep = (size_t)(BK * 2);
    const size_t hstep = (size_t)HALF * K * 2;
    const size_t tstep = 2 * hstep;
    const size_t kstepA = AGRP ? (size_t)4 * MP * 32 : kstep, hstepA = AGRP ? (size_t)HALF * 32 : hstep, tstepA = 2 * hstepA;
    const unsigned ldsw = (unsigned)wid * 1024u;
    const int aoff = lds_byte(wr * 64 + fr, fq * 8), boff = lds_byte(wc * 32 + fr, fq * 8);
#define PG8_SA(b, h) (((b) * 2 + (h)) * HTB)
#define PG8_SB(b, h) ((4 + (b) * 2 + (h)) * HTB)
#define PG8_STAGE(bufoff, gbase, voff) do { _Pragma("unroll") for (int _i = 0; _i < 2; ++_i) \
        __builtin_amdgcn_global_load_lds((const unsigned*)((const char*)(gbase) + (voff)[_i]), (PG8_LAS unsigned*)(lds + (bufoff) + ldsw + _i * 8192), 16, 0, 0); } while (0)
#define PG8_LDA(dst, b, h) do { _Pragma("unroll") for (int m = 0; m < 4; ++m) _Pragma("unroll") for (int k = 0; k < 2; ++k) dst[m][k] = *(const PG8_LAS bf16x8*)(lds + PG8_SA(b, h) + aoff + m * 2048 + k * 1024); } while (0)
#define PG8_LDB(dst, b, h) do { _Pragma("unroll") for (int n = 0; n < 2; ++n) _Pragma("unroll") for (int k = 0; k < 2; ++k) dst[n][k] = *(const PG8_LAS bf16x8*)(lds + PG8_SB(b, h) + boff + n * 2048 + k * 1024); } while (0)
#define PG8_MMA(ai, bj, At, Bt) do { __builtin_amdgcn_s_setprio(1); _Pragma("unroll") for (int m = 0; m < 4; ++m) _Pragma("unroll") for (int n = 0; n < 2; ++n) _Pragma("unroll") for (int k = 0; k < 2; ++k) \
        acc[ai][bj][m][n] = __builtin_amdgcn_mfma_f32_16x16x32_bf16(Bt[n][k], At[m][k], acc[ai][bj][m][n], 0, 0, 0); __builtin_amdgcn_s_setprio(0); } while (0)
#define PG8_WAIT_V(n) asm volatile("s_waitcnt vmcnt(" #n ")" ::: "memory")
#define PG8_WAIT_L(n) asm volatile("s_waitcnt lgkmcnt(" #n ")" ::: "memory")
#define PG8_BAR __builtin_amdgcn_s_barrier()
#define PG8_SCHED __builtin_amdgcn_sched_barrier(0)
    Unit cur, nxt; int ui = 0;
    if (!S.next(0, cur)) return;
    f32x4 acc[2][2][4][2];
#pragma unroll
    for (int a = 0; a < 2; ++a)
#pragma unroll
        for (int b = 0; b < 2; ++b)
#pragma unroll
            for (int m = 0; m < 4; ++m)
#pragma unroll
                for (int n = 0; n < 2; ++n) acc[a][b][m][n] = (f32x4){0.f, 0.f, 0.f, 0.f};
    bf16x8 At[4][2], B0[2][2], B1[2][2];
    const char* cA = (const char*)g.A + (size_t)cur.pm * tstepA; const char* cB = (const char*)g.Bt + (size_t)cur.pn * tstep;
    S.a_ready(cur);
    if constexpr (SP2) {
        PG8_STAGE(PG8_SB(0, 0), cB, voffB); PG8_STAGE(PG8_SB(0, 1), cB + hstep, voffB); PG8_STAGE(PG8_SA(0, 0), cA, voffA); PG8_STAGE(PG8_SA(0, 1), cA + hstepA, voffA);
        E.begin(cur, 0, tid);
        if (wr == 1) PG8_BAR;
        PG8_WAIT_V(2); PG8_BAR;
        PG8_STAGE(PG8_SB(1, 0), cB + kstep, voffB); PG8_STAGE(PG8_SA(1, 0), cA + kstepA, voffA); PG8_STAGE(PG8_SB(1, 1), cB + hstep + kstep, voffB);
        PG8_WAIT_V(6); PG8_BAR;
    } else {
        PG8_STAGE(PG8_SB(0, 0), cB, voffB); PG8_STAGE(PG8_SA(0, 0), cA, voffA); PG8_STAGE(PG8_SB(0, 1), cB + hstep, voffB); PG8_STAGE(PG8_SA(0, 1), cA + hstepA, voffA);
        if (wr == 1) PG8_BAR;
        PG8_WAIT_V(4); PG8_BAR;
        PG8_STAGE(PG8_SB(1, 0), cB + kstep, voffB); PG8_STAGE(PG8_SA(1, 0), cA + kstepA, voffA); PG8_STAGE(PG8_SB(1, 1), cB + hstep + kstep, voffB);
        PG8_WAIT_V(6); PG8_BAR;
    }
    for (;;) {
        if (!SP2 || ui > 0) E.begin(cur, ui, tid);
        const bool has_next = S.next(ui + 1, nxt);
        const char* nA = has_next ? (const char*)g.A + (size_t)nxt.pm * tstepA : cA; const char* nB = has_next ? (const char*)g.Bt + (size_t)nxt.pn * tstep : cB;
        for (int t = 0; t < nt; t += 2) {
            if constexpr (Epi::MID) { if (t == (nt >> 1)) E.mid(acc, cur, ui, wr, wc, fr, fq); }
            const bool last = (t == nt - 2);
            const char* a1 = cA + (size_t)(t + 1) * kstepA;
            const char* a2 = last ? nA : cA + (size_t)(t + 2) * kstepA; const char* b2 = last ? nB : cB + (size_t)(t + 2) * kstep;
            const char* a3 = a2 + kstepA; const char* b3 = b2 + kstep;
            if (last && has_next) S.a_ready(nxt);
            if constexpr (SP2) {
            PG8_LDB(B0, 0, 0); PG8_LDB(B1, 0, 1); PG8_SCHED; PG8_LDA(At, 0, 0); PG8_STAGE(PG8_SA(1, 1), a1 + hstepA, voffA);
            PG8_WAIT_V(8); PG8_WAIT_L(0); PG8_BAR; PG8_MMA(0, 0, At, B0); PG8_MMA(0, 1, At, B1); PG8_BAR; PG8_SCHED;
            PG8_LDA(At, 0, 1); PG8_STAGE(PG8_SB(0, 0), b2, voffB); PG8_STAGE(PG8_SB(0, 1), b2 + hstep, voffB); PG8_STAGE(PG8_SA(0, 0), a2, voffA);
            PG8_WAIT_V(8); PG8_WAIT_L(0); PG8_BAR; PG8_MMA(1, 0, At, B0); PG8_MMA(1, 1, At, B1); PG8_BAR; PG8_SCHED;
            PG8_LDB(B0, 1, 0); PG8_LDB(B1, 1, 1); PG8_SCHED; PG8_LDA(At, 1, 0); PG8_STAGE(PG8_SA(0, 1), a2 + hstepA, voffA);
            PG8_WAIT_V(8); PG8_WAIT_L(0); PG8_BAR; PG8_MMA(0, 0, At, B0); PG8_MMA(0, 1, At, B1); PG8_BAR; PG8_SCHED;
            PG8_LDA(At, 1, 1); PG8_STAGE(PG8_SB(1, 0), b3, voffB); PG8_STAGE(PG8_SB(1, 1), b3 + hstep, voffB); PG8_STAGE(PG8_SA(1, 0), a3, voffA);
            PG8_WAIT_V(8); PG8_WAIT_L(0); PG8_BAR; PG8_MMA(1, 0, At, B0); PG8_MMA(1, 1, At, B1); PG8_BAR; PG8_SCHED;
            } else {
            PG8_LDB(B0, 0, 0); PG8_SCHED; PG8_LDA(At, 0, 0); PG8_STAGE(PG8_SA(1, 1), a1 + hstepA, voffA);
            PG8_WAIT_L(8); PG8_BAR; PG8_WAIT_L(0); PG8_MMA(0, 0, At, B0); PG8_BAR; PG8_SCHED;
            PG8_LDB(B1, 0, 1); PG8_STAGE(PG8_SB(0, 0), b2, voffB);
            PG8_BAR; PG8_WAIT_L(0); PG8_MMA(0, 1, At, B1); PG8_BAR;
            PG8_LDA(At, 0, 1); PG8_STAGE(PG8_SA(0, 0), a2, voffA);
            PG8_BAR; PG8_WAIT_L(0); PG8_MMA(1, 0, At, B0); PG8_BAR; PG8_SCHED;
            PG8_STAGE(PG8_SB(0, 1), b2 + hstep, voffB);
            PG8_WAIT_V(6); PG8_BAR; PG8_MMA(1, 1, At, B1); PG8_BAR;
            PG8_LDB(B0, 1, 0); PG8_SCHED; PG8_LDA(At, 1, 0); PG8_STAGE(PG8_SA(0, 1), a2 + hstepA, voffA);
            PG8_WAIT_L(8); PG8_BAR; PG8_WAIT_L(0); PG8_MMA(0, 0, At, B0); PG8_BAR; PG8_SCHED;
            PG8_LDB(B1, 1, 1); PG8_STAGE(PG8_SB(1, 0), b3, voffB);
            PG8_BAR; PG8_WAIT_L(0); PG8_MMA(0, 1, At, B1); PG8_BAR;
            PG8_LDA(At, 1, 1); PG8_STAGE(PG8_SA(1, 0), a3, voffA);
            PG8_BAR; PG8_WAIT_L(0); PG8_MMA(1, 0, At, B0); PG8_BAR; PG8_SCHED;
            PG8_STAGE(PG8_SB(1, 1), b3 + hstep, voffB);
            PG8_WAIT_V(6); PG8_BAR; PG8_MMA(1, 1, At, B1); PG8_BAR;
            }
        }
        if constexpr (ALIGN_EPI) { if (wr == 0) PG8_BAR; }
        if constexpr (!Epi::AFTER_DRAIN) { E(acc, cur, ui, wr, wc, fr, fq); S.done(cur); }
        if (!has_next) break;
#pragma unroll
        for (int a = 0; a < 2; ++a)
#pragma unroll
            for (int b = 0; b < 2; ++b)
#pragma unroll
                for (int m = 0; m < 4; ++m)
#pragma unroll
                    for (int n = 0; n < 2; ++n) acc[a][b][m][n] = (f32x4){0.f, 0.f, 0.f, 0.f};
        cur = nxt; cA = nA; cB = nB; ++ui;
        if constexpr (ALIGN_EPI) { if (wr == 1) PG8_BAR; }
    }
    PG8_WAIT_V(0);
    if constexpr (!ALIGN_EPI) { if (wr == 0) PG8_BAR; }
    PG8_BAR;
#undef PG8_SA
#undef PG8_SB
#undef PG8_STAGE
#undef PG8_LDA
#undef PG8_LDB
#undef PG8_MMA
#undef PG8_WAIT_V
#undef PG8_WAIT_L
#undef PG8_BAR
#undef PG8_SCHED
}
}

namespace attn_body {
using bf16=__hip_bfloat16;
using bf16x8=__attribute__((ext_vector_type(8)))short;
using s16x4=__attribute__((ext_vector_type(4)))short;
using f32x16=__attribute__((ext_vector_type(16)))float;
using u32x4=__attribute__((ext_vector_type(4)))unsigned;
constexpr int BATCH=8,NHEAD=8,SEQ=2048,D=64,DM=512,OP=1024;
constexpr int NW=8,QBLK=32,QB=QBLK*NW,KVBLK=64,NQB=SEQ/QB;
constexpr int ATTN_PITCH=DM, ATTN_UNIT_ROWS=QB;
__device__ __forceinline__ int crow(int r,int hi){return (r&3)+8*(r>>2)+4*hi;}
#define SBAR() __builtin_amdgcn_sched_barrier(0)
__device__ __forceinline__ void cmask(f32x16&p0,f32x16&p1,int jb,int qrel,int hi){
  const float NEG=-INFINITY; int kb=64*jb+4*hi;
  #pragma unroll
  for(int r=0;r<16;++r){int kv=kb+(r&3)+8*(r>>2); if(kv>qrel)p0[r]=NEG; if(kv+32>qrel)p1[r]=NEG;}
}

constexpr int NSLOT=3, SLOTB=8192;
constexpr int LDS_K=0, LDS_V=NSLOT*SLOTB, LDS_WS=2*NSLOT*SLOTB, LDS_OST=LDS_WS+NW*64*4, LDS_BYTES=LDS_OST+NW*4096;
constexpr float C2=0.125f*1.4426950408889634f;
__device__ __forceinline__ void glds16(const void*gsrc,unsigned lds_dst){unsigned keep;
  asm volatile("s_mov_b32 %0, m0\n\ts_mov_b32 m0, %2\n\ts_nop 0\n\tglobal_load_lds_dwordx4 %1, off\n\ts_mov_b32 m0, %0":"=&s"(keep):"v"(gsrc),"s"(lds_dst):"memory");}
__device__ __forceinline__ float max3f(float a,float b,float c){float r;asm("v_max3_f32 %0, %1, %2, %3":"=v"(r):"v"(a),"v"(b),"v"(c));return r;}
__device__ __forceinline__ float max2f(float a,float b){float r;asm("v_max_f32_e32 %0, %1, %2":"=v"(r):"v"(a),"v"(b));return r;}
__device__ __forceinline__ float fadd_s(float a,float b){float r;asm("v_add_f32_e32 %0, %1, %2":"=v"(r):"v"(a),"v"(b));return r;}
__device__ __forceinline__ float fsub_s(float a,float b){float r;asm("v_sub_f32_e32 %0, %1, %2":"=v"(r):"v"(a),"v"(b));return r;}
typedef float f32x2_t __attribute__((ext_vector_type(2))); typedef __bf16 bf16x2_t __attribute__((ext_vector_type(2)));
__device__ __forceinline__ unsigned cvtpk_s(float lo,float hi){f32x2_t v={lo,hi};bf16x2_t b=__builtin_convertvector(v,bf16x2_t);return __builtin_bit_cast(unsigned,b);}
#define WAIT_BAR(N) asm volatile("s_waitcnt vmcnt(" #N ") lgkmcnt(0)\n\ts_barrier":::"memory")

__device__ __forceinline__ void qkt(f32x16&p0,f32x16&p1,const char*Kslot,const bf16x8*qr,const f32x16&negm,int r32,int hi){
  const char*kb=Kslot+hi*1024+r32*16;
  #pragma unroll
  for(int d0=0;d0<4;++d0){
    const bf16x8 b0=*reinterpret_cast<const bf16x8*>(kb+d0*2048);
    const bf16x8 b1=*reinterpret_cast<const bf16x8*>(kb+d0*2048+512);
    if(d0==0){p0=__builtin_amdgcn_mfma_f32_32x32x16_bf16(b0,qr[0],negm,0,0,0);p1=__builtin_amdgcn_mfma_f32_32x32x16_bf16(b1,qr[0],negm,0,0,0);}
    else{p0=__builtin_amdgcn_mfma_f32_32x32x16_bf16(b0,qr[d0],p0,0,0,0);p1=__builtin_amdgcn_mfma_f32_32x32x16_bf16(b1,qr[d0],p1,0,0,0);}}
}
typedef __attribute__((address_space(3))) const char* lds_cptr;
typedef short v4i16_t __attribute__((ext_vector_type(4)));
__device__ __forceinline__ void kload8(bf16x8*kf,lds_cptr kp){
  kf[0]=*(const __attribute__((address_space(3))) bf16x8*)(kp);      kf[1]=*(const __attribute__((address_space(3))) bf16x8*)(kp+512);
  kf[2]=*(const __attribute__((address_space(3))) bf16x8*)(kp+2048); kf[3]=*(const __attribute__((address_space(3))) bf16x8*)(kp+2560);
  kf[4]=*(const __attribute__((address_space(3))) bf16x8*)(kp+4096); kf[5]=*(const __attribute__((address_space(3))) bf16x8*)(kp+4608);
  kf[6]=*(const __attribute__((address_space(3))) bf16x8*)(kp+6144); kf[7]=*(const __attribute__((address_space(3))) bf16x8*)(kp+6656);
}
__device__ __forceinline__ void kload2(bf16x8*kf,lds_cptr kp,int j){ kf[2*j]=*(const __attribute__((address_space(3))) bf16x8*)(kp+j*2048); kf[2*j+1]=*(const __attribute__((address_space(3))) bf16x8*)(kp+j*2048+512); }
__device__ __forceinline__ s16x4 vtr(lds_cptr p){ return __builtin_bit_cast(s16x4,__builtin_amdgcn_ds_read_tr16_b64_v4i16((__attribute__((address_space(3))) v4i16_t*)p)); }
__device__ __forceinline__ float rowmax(const f32x16&p0,const f32x16&p1){
  float a=max3f(p0[0],p0[1],p1[0]),b=max3f(p0[2],p0[3],p1[1]);a=max3f(a,p1[2],p1[3]);
  #pragma unroll
  for(int r=4;r<16;r+=4){a=max3f(a,p0[r],p0[r+1]);b=max3f(b,p0[r+2],p0[r+3]);a=max3f(a,p1[r],p1[r+1]);b=max3f(b,p1[r+2],p1[r+3]);}
  const float m=max2f(a,b);
  auto rr=__builtin_amdgcn_permlane32_swap(__float_as_uint(m),__float_as_uint(m),false,false);
  return max2f(__uint_as_float(rr[0]),__uint_as_float(rr[1]));
}
__device__ __forceinline__ void pv(f32x16*o,int vb,bf16x8 pa0,bf16x8 pa1,bf16x8 pa2,bf16x8 pa3){
  #pragma unroll
  for(int d0=0;d0<2;++d0){s16x4 lo[4],hi[4];
    #pragma unroll
    for(int ks=0;ks<4;++ks){
      asm volatile("ds_read_b64_tr_b16 %0,%1 offset:%c2":"=&v"(lo[ks]):"v"(vb),"i"(d0*4096+ks*1024):"memory");
      asm volatile("ds_read_b64_tr_b16 %0,%1 offset:%c2":"=&v"(hi[ks]):"v"(vb),"i"(d0*4096+ks*1024+512):"memory");}
    asm volatile("s_waitcnt lgkmcnt(0)":::"memory");SBAR();
    #define PK(k) (bf16x8){lo[k][0],lo[k][1],lo[k][2],lo[k][3],hi[k][0],hi[k][1],hi[k][2],hi[k][3]}
    o[d0]=__builtin_amdgcn_mfma_f32_32x32x16_bf16(pa0,PK(0),o[d0],0,0,0);
    o[d0]=__builtin_amdgcn_mfma_f32_32x32x16_bf16(pa1,PK(1),o[d0],0,0,0);
    o[d0]=__builtin_amdgcn_mfma_f32_32x32x16_bf16(pa2,PK(2),o[d0],0,0,0);
    o[d0]=__builtin_amdgcn_mfma_f32_32x32x16_bf16(pa3,PK(3),o[d0],0,0,0);
    #undef PK
  }
}

__device__ __forceinline__ float selm(float f,float t,unsigned long long m){float d;asm("v_cndmask_b32_e64 %0, %1, %2, %3":"=v"(d):"v"(f),"v"(t),"s"(m));return d;}
constexpr unsigned long long m16c_(int r){unsigned long long m=0;for(int l=0;l<64;++l){const int e=((l&31)-4*(l>>5))&15,o=(r&3)+8*((r>>2)&1);if(e==o)m|=1ull<<l;}return m;}
constexpr unsigned long long m4c_(int r){unsigned long long m=0;for(int l=0;l<64;++l)if((l&3)==(r&3))m|=1ull<<l;return m;}
template<int R> struct MaskC{ static constexpr unsigned long long m16=m16c_(R), m4=m4c_(R); };
#define M16C(r) (attn_body::m16tab(r))
#define M4C(r) (attn_body::m4tab(r))
__device__ __forceinline__ constexpr unsigned long long m16tab(int r){ constexpr unsigned long long T[16]={m16c_(0),m16c_(1),m16c_(2),m16c_(3),m16c_(4),m16c_(5),m16c_(6),m16c_(7),m16c_(8),m16c_(9),m16c_(10),m16c_(11),m16c_(12),m16c_(13),m16c_(14),m16c_(15)}; return T[r]; }
__device__ __forceinline__ constexpr unsigned long long m4tab(int r){ constexpr unsigned long long T[4]={m4c_(0),m4c_(1),m4c_(2),m4c_(3)}; return T[r&3]; }
__device__ __forceinline__ void mask_half(f32x16&P,int dh,int dl,float mhat){
  const float ninf=-INFINITY; constexpr float L3=1.5849625007211562f; const float mh1=mhat-1.0f, mh3=mhat-L3;
  if(dh>=544){
    _Pragma("unroll") for(int r=0;r<16;++r) P[r]=selm(ninf,P[r]-mhat,M16C(r));
  } else if(dh>=160&&dh<=480){
    _Pragma("unroll") for(int r=0;r<16;++r) P[r]=selm(ninf,P[r]-selm(mhat,mh1,M16C(r)),M4C(r));
  } else if(dh<=-32){
    _Pragma("unroll") for(int r=0;r<16;++r) P[r]=ninf;
  } else if(dh>=32&&dh<=96){
    _Pragma("unroll") for(int r=0;r<16;++r) P[r]=P[r]-selm(selm(mhat,mh1,M4C(r)),mh3,M16C(r));
  } else if(dh==0){
    _Pragma("unroll") for(int r=0;r<16;++r){ const float v=P[r]-selm(selm(mhat,mh1,M4C(r)),mh3,M16C(r)); P[r]=(dl-((r&3)+8*(r>>2))>=0)?v:ninf; }
  } else if(dh==128){
    _Pragma("unroll") for(int r=0;r<16;++r){ const float nr=P[r]-selm(selm(mhat,mh1,M4C(r)),mh3,M16C(r)), md=selm(ninf,P[r]-selm(mhat,mh1,M16C(r)),M4C(r)); P[r]=(dl-((r&3)+8*(r>>2))<=128)?nr:md; }
  } else {
    _Pragma("unroll") for(int r=0;r<16;++r){ const float fr=selm(ninf,P[r]-mhat,M16C(r)), md=selm(ninf,P[r]-selm(mhat,mh1,M16C(r)),M4C(r)); P[r]=(dl-((r&3)+8*(r>>2))<=512)?md:fr; }
  }
}
#ifndef ATTN_STORE16
#define ATTN_STORE16(p,v) (*(__attribute__((address_space(1))) u32x4*)(p)=(v))
#endif
template<int THRL> __device__ __forceinline__ void attn_unit(int b,int h,int qb,const bf16*Q,const bf16*__restrict__ K,const bf16*__restrict__ V,bf16*O,float*ssa,const __attribute__((address_space(3))) float*mtab,char*shm){
  int tid_=threadIdx.x; asm volatile("":"+v"(tid_)); const int tid=tid_,lane=tid&63,r32=lane&31,hi=lane>>5; const int wid=__builtin_amdgcn_readfirstlane(tid>>6);
  const long rowbase=(long)b*SEQ; const int q0=qb*QB;
  const bf16*Qw=Q+(rowbase+q0+wid*QBLK)*DM+h*D;
  const bf16*Kh=K+rowbase*DM+h*D,*Vh=V+rowbase*DM+h*D;
  const unsigned lds0=(unsigned)(uintptr_t)shm;
  float*wsf=(float*)(shm+LDS_WS)+wid*64;
  const bf16*ksrc=Kh+(long)lane*DM+wid*8;
  const bf16*vsrc=Vh+(long)(16*(wid&3)+(lane>>2))*DM+(wid>>2)*32+(lane&3)*8;
  const unsigned kdst=lds0+LDS_K+wid*1024, vdst=lds0+LDS_V+wid*1024;
  #define DMA_K(t,slot) glds16(ksrc+(long)(t)*KVBLK*DM,(unsigned)__builtin_amdgcn_readfirstlane(kdst+(slot)))
  #define DMA_V(t,slot) glds16(vsrc+(long)(t)*KVBLK*DM,(unsigned)__builtin_amdgcn_readfirstlane(vdst+(slot)))
  const int vb0=(int)(lds0+LDS_V)+((lane>>4)&1)*32+(lane&3)*8+(4*hi+((lane&15)>>2))*64;
  const char*Kbase=shm+LDS_K; bf16x8 kf[8];
  const lds_cptr shm3=(lds_cptr)shm; const lds_cptr kp0=shm3+LDS_K+hi*1024+r32*16; const lds_cptr vp0=shm3+LDS_V+((lane>>4)&1)*32+(lane&3)*8+(4*hi+((lane&15)>>2))*64;
  const int NT=(q0+QB)/KVBLK;
  DMA_K(0,0);DMA_V(0,0);DMA_K(1,SLOTB);
  bf16x8 qr[4];
  #pragma unroll
  for(int d0=0;d0<4;++d0)qr[d0]=*(const __attribute__((address_space(1))) bf16x8*)(&Qw[(long)r32*DM+d0*16+hi*8]);
  float mhat=0.f,l_reg=0.f;f32x16 o[2];o[0]=f32x16{};o[1]=f32x16{};const f32x16 negm=f32x16{};
  const int qrel=wid*QBLK+r32; const int qabs256=q0+qrel+256-4*hi-59; (void)qrel;
  (void)qabs256; (void)mtab;
  #define MTAB(P0,P1,t) do{ const int dw_=q0+32*wid-64*(t); const int dl_=(q0+qrel)-64*(t)-4*hi; mask_half(P0,dw_,dl_,mhat); mask_half(P1,dw_-32,dl_-32,mhat); }while(0)
  #define CMASK(P0,P1,t) MTAB(P0,P1,t)
  bool resc=false;
  #define START(P0,P1) do{ const float rm=rowmax(P0,P1); resc=false; \
    { const float dl=rm; mhat=fadd_s(mhat,dl); \
      _Pragma("unroll") for(int r=0;r<16;++r){P0[r]=fsub_s(P0[r],dl);P1[r]=fsub_s(P1[r],dl);} \
      } \
    _Pragma("unroll") for(int r=0;r<16;++r)P0[r]=__builtin_amdgcn_exp2f(P0[r]); }while(0)
  #define RESC() do{ if(resc){ asm volatile("s_waitcnt lgkmcnt(0)":::"memory"); \
      _Pragma("unroll") for(int d_=0;d_<2;++d_) _Pragma("unroll") for(int r=0;r<16;++r)o[d_][r]*=wsf[crow(r,hi)]; } }while(0)
  f32x16 pA0,pA1,pB0,pB1;
  int sl_prev=0,sl_cur=0,sl_next=SLOTB;
  #define ROT() do{sl_prev=sl_cur;sl_cur=sl_next;sl_next=(sl_next==(NSLOT-1)*SLOTB)?0:sl_next+SLOTB;}while(0)
  DMA_K(2,2*SLOTB);
  WAIT_BAR(3);
  qkt(pA0,pA1,Kbase,qr,negm,r32,hi);asm volatile("s_nop 15\n\ts_nop 7":"+v"(pA0),"+v"(pA1));CMASK(pA0,pA1,0);
  START(pA0,pA1);
  _Pragma("unroll") for(int r=0;r<16;++r)pA1[r]=__builtin_amdgcn_exp2f(pA1[r]);
  WAIT_BAR(0);
  DMA_K(3,0);DMA_V(1,SLOTB);
  ROT();
  kload8(kf,kp0+sl_cur);
  WAIT_BAR(2);
  s16x4 vlo[8],vhi[8]; u32x4 pw0,pw1,pw2,pw3;
  #define PKW(P,B) cvtpk_s(P[B],P[B+1])
  #define PAF(k) __builtin_bit_cast(bf16x8,pw##k)
  #define VFR(i) (bf16x8){vlo[i][0],vlo[i][1],vlo[i][2],vlo[i][3],vhi[i][0],vhi[i][1],vhi[i][2],vhi[i][3]}
  #define PIN(x) asm volatile("":"+v"(x))
  #define MX3(a,b,c) __builtin_fmaxf(__builtin_fmaxf((a),(b)),(c))
  #define GAPA(MF,A0,A1,A2,A3,W0,W1,PW) do{ MF; sacc+=A0; sacc+=A1; sacc+=A2; sacc+=A3; PIN(sacc); W0; W1; PIN(PW); SBAR(); }while(0)
  #define EX(v) __builtin_amdgcn_exp2f(v)
  #define GAPB(MF,X,B) do{ MF; if(!FAR_){ X[B]=EX(X[B]); X[B+1]=EX(X[B+1]); X[B+2]=EX(X[B+2]); X[B+3]=EX(X[B+3]); PIN(X); } SBAR(); }while(0)
  #define VRD(i) do{ vlo[i]=vtr(vp_+(((i)>>2)*4096+((i)&3)*1024)); vhi[i]=vtr(vp_+(((i)>>2)*4096+((i)&3)*1024+512)); }while(0)
  #define KRD(G,j) do{ if(G){ kload2(kf,kp0+sl_next,j); SBAR(); } }while(0)
  #define STEP(C0,C1,P0,P1,t,GK,GV,GL,FARF) do{ constexpr bool FAR_=(FARF); SBAR(); \
    const lds_cptr vp_=vp0+sl_prev; \
    VRD(0); SBAR(); float sacc=(P0[0]+P0[1]); \
    GAPA(C0=__builtin_amdgcn_mfma_f32_32x32x16_bf16(kf[0],qr[0],negm,0,0,0), P0[2],P0[3],P0[4],P0[5],     pw0[0]=PKW(P0,0), pw0[1]=PKW(P0,2), pw0); \
    VRD(4); SBAR(); GAPA(C1=__builtin_amdgcn_mfma_f32_32x32x16_bf16(kf[1],qr[0],negm,0,0,0), P0[6],P0[7],P0[8],P0[9],     pw0[2]=PKW(P0,4), pw0[3]=PKW(P0,6), pw0); \
    VRD(1); SBAR(); GAPA(C0=__builtin_amdgcn_mfma_f32_32x32x16_bf16(kf[2],qr[1],C0,0,0,0),   P0[10],P0[11],P0[12],P0[13], pw1[0]=PKW(P0,8), pw1[1]=PKW(P0,10), pw1); \
    VRD(5); SBAR(); GAPA(C1=__builtin_amdgcn_mfma_f32_32x32x16_bf16(kf[3],qr[1],C1,0,0,0),   P0[14],P0[15],P1[0],P1[1],   pw1[2]=PKW(P0,12),pw1[3]=PKW(P0,14), pw1); \
    VRD(2); SBAR(); GAPA(C0=__builtin_amdgcn_mfma_f32_32x32x16_bf16(kf[4],qr[2],C0,0,0,0),   P1[2],P1[3],P1[4],P1[5],     pw2[0]=PKW(P1,0), pw2[1]=PKW(P1,2), pw2); \
    VRD(6); SBAR(); GAPA(C1=__builtin_amdgcn_mfma_f32_32x32x16_bf16(kf[5],qr[2],C1,0,0,0),   P1[6],P1[7],P1[8],P1[9],     pw2[2]=PKW(P1,4), pw2[3]=PKW(P1,6), pw2); \
    VRD(3); SBAR(); GAPA(C0=__builtin_amdgcn_mfma_f32_32x32x16_bf16(kf[6],qr[3],C0,0,0,0),   P1[10],P1[11],P1[12],P1[13], pw3[0]=PKW(P1,8), pw3[1]=PKW(P1,10), pw3); \
    VRD(7); SBAR(); GAPA(C1=__builtin_amdgcn_mfma_f32_32x32x16_bf16(kf[7],qr[3],C1,0,0,0),   P1[14],P1[15],0.f,0.f,       pw3[2]=PKW(P1,12),pw3[3]=PKW(P1,14), pw3); \
    l_reg+=sacc; \
    if(GK){DMA_K((t)+3,sl_cur);} if(GV){DMA_V((t)+1,sl_next);} \
    if(!FAR_){ CMASK(C0,C1,t); \
    { float a=MX3(C0[0],C0[1],C1[0]),b=MX3(C0[2],C0[3],C1[1]); a=MX3(a,C1[2],C1[3]); \
      _Pragma("unroll") for(int r=4;r<16;r+=4){a=MX3(a,C0[r],C0[r+1]);b=MX3(b,C0[r+2],C0[r+3]);a=MX3(a,C1[r],C1[r+1]);b=MX3(b,C1[r+2],C1[r+3]);} \
      float rm=__builtin_fmaxf(a,b); { auto rr=__builtin_amdgcn_permlane32_swap(__float_as_uint(rm),__float_as_uint(rm),false,false); rm=__builtin_fmaxf(__uint_as_float(rr[0]),__uint_as_float(rr[1])); } \
      resc=false; \
      if(__builtin_expect(__any(rm>(float)THRL),0)){ const float dl=__builtin_fmaxf(rm,0.f); mhat+=dl; \
        _Pragma("unroll") for(int r=0;r<16;++r){C0[r]-=dl;C1[r]-=dl;} \
        const float f=__builtin_amdgcn_exp2f(-dl); l_reg*=f; if(hi==0)wsf[r32]=f; resc=true; } } \
    } else {   \
      asm volatile("s_nop 15\n\ts_nop 7":"+v"(C0),"+v"(C1)); \
      float a0=-INFINITY,b0=-INFINITY,a1=-INFINITY,b1=-INFINITY; \
      _Pragma("unroll") for(int r=0;r<8;++r){ a0=selm(a0,C0[r],M16C(r)); b0=selm(b0,C0[r+8],M16C(r)); a1=selm(a1,C1[r],M16C(r)); b1=selm(b1,C1[r+8],M16C(r)); } \
      a0-=mhat; b0-=mhat; a1-=mhat; b1-=mhat; \
      float rm=__builtin_fmaxf(__builtin_fmaxf(a0,b0),__builtin_fmaxf(a1,b1)); { auto rr=__builtin_amdgcn_permlane32_swap(__float_as_uint(rm),__float_as_uint(rm),false,false); rm=__builtin_fmaxf(__uint_as_float(rr[0]),__uint_as_float(rr[1])); } \
      resc=false; \
      if(__builtin_expect(__any(rm>(float)THRL),0)){ const float dl=__builtin_fmaxf(rm,0.f); mhat+=dl; a0-=dl; b0-=dl; a1-=dl; b1-=dl; \
        const float f=__builtin_amdgcn_exp2f(-dl); l_reg*=f; if(hi==0)wsf[r32]=f; resc=true; } \
      a0=__builtin_amdgcn_exp2f(a0); b0=__builtin_amdgcn_exp2f(b0); a1=__builtin_amdgcn_exp2f(a1); b1=__builtin_amdgcn_exp2f(b1); \
      _Pragma("unroll") for(int r=0;r<8;++r){ C0[r]=selm(0.f,a0,M16C(r)); C0[r+8]=selm(0.f,b0,M16C(r)); C1[r]=selm(0.f,a1,M16C(r)); C1[r+8]=selm(0.f,b1,M16C(r)); } } \
    SBAR(); \
    GAPB(o[0]=__builtin_amdgcn_mfma_f32_32x32x16_bf16(PAF(0),VFR(0),o[0],0,0,0), C0,0); \
    GAPB(o[1]=__builtin_amdgcn_mfma_f32_32x32x16_bf16(PAF(0),VFR(4),o[1],0,0,0), C0,4); \
    KRD(GL,0); GAPB(o[0]=__builtin_amdgcn_mfma_f32_32x32x16_bf16(PAF(1),VFR(1),o[0],0,0,0), C0,8); \
    KRD(GL,1); GAPB(o[1]=__builtin_amdgcn_mfma_f32_32x32x16_bf16(PAF(1),VFR(5),o[1],0,0,0), C0,12); \
    KRD(GL,2); GAPB(o[0]=__builtin_amdgcn_mfma_f32_32x32x16_bf16(PAF(2),VFR(2),o[0],0,0,0), C1,0); \
    KRD(GL,3); GAPB(o[1]=__builtin_amdgcn_mfma_f32_32x32x16_bf16(PAF(2),VFR(6),o[1],0,0,0), C1,4); \
    GAPB(o[0]=__builtin_amdgcn_mfma_f32_32x32x16_bf16(PAF(3),VFR(3),o[0],0,0,0), C1,8); \
    GAPB(o[1]=__builtin_amdgcn_mfma_f32_32x32x16_bf16(PAF(3),VFR(7),o[1],0,0,0), C1,12); \
    }while(0)
  int t=1;
  #undef CMASK
  #define CMASK(P0,P1,t) MTAB(P0,P1,t)
#if ATTN_FAR
  { const int TF=4*qb-9;
  for(;t+1<=TF&&t+5<NT;t+=2){
    STEP(pB0,pB1,pA0,pA1,t,true,true,true,true);     WAIT_BAR(2); RESC(); ROT();
    STEP(pA0,pA1,pB0,pB1,t+1,true,true,true,true);   WAIT_BAR(2); RESC(); ROT();
  } }
#endif
  for(;t+5<NT;t+=2){
    STEP(pB0,pB1,pA0,pA1,t,true,true,true,false);     WAIT_BAR(2); RESC(); ROT();
    STEP(pA0,pA1,pB0,pB1,t+1,true,true,true,false);   WAIT_BAR(2); RESC(); ROT();
  }
  #undef CMASK
  #define CMASK(P0,P1,t) MTAB(P0,P1,t)
  #define ENDW(tt) do{ if((tt)+3<NT){WAIT_BAR(2);} else if((tt)+2<NT){WAIT_BAR(1);} else {WAIT_BAR(0);} }while(0)
  for(;t+1<NT;t+=2){
    STEP(pB0,pB1,pA0,pA1,t,(t+3<NT),(t+1<NT),(t+1<NT),false);       ENDW(t);   RESC(); ROT();
    STEP(pA0,pA1,pB0,pB1,t+1,(t+4<NT),(t+2<NT),(t+2<NT),false);     ENDW(t+1); RESC(); ROT();
  }
  STEP(pB0,pB1,pA0,pA1,NT-1,false,false,false,false); RESC();
  { float sacc=pB0[0]+pB0[1]; _Pragma("unroll") for(int r=2;r<16;++r)sacc+=pB0[r]; _Pragma("unroll") for(int r=0;r<16;++r)sacc+=pB1[r]; l_reg+=sacc;
    pw0=(u32x4){PKW(pB0,0),PKW(pB0,2),PKW(pB0,4),PKW(pB0,6)};pw1=(u32x4){PKW(pB0,8),PKW(pB0,10),PKW(pB0,12),PKW(pB0,14)};pw2=(u32x4){PKW(pB1,0),PKW(pB1,2),PKW(pB1,4),PKW(pB1,6)};pw3=(u32x4){PKW(pB1,8),PKW(pB1,10),PKW(pB1,12),PKW(pB1,14)};
    SBAR(); pv(o,vb0+sl_cur,PAF(0),PAF(1),PAF(2),PAF(3)); }
  #undef PKW
  #undef PAF
  #undef VFR
  #undef PIN
  #undef MX3
  #undef GAPA
  #undef GAPB
  #undef EX
  #undef VRD
  #undef KRD
  #undef STEP
  #undef ENDW
  {auto rr=__builtin_amdgcn_permlane32_swap(__float_as_uint(l_reg),__float_as_uint(l_reg),false,false);l_reg=__uint_as_float(rr[0])+__uint_as_float(rr[1]);}
  if(hi==0)wsf[32+r32]=l_reg;asm volatile("s_waitcnt lgkmcnt(0)":::"memory");
  float rli[16];
  #pragma unroll
  for(int r=0;r<16;++r)rli[r]=__builtin_amdgcn_rcpf(wsf[32+crow(r,hi)]);
  bf16*Ow=O+(rowbase+q0+wid*QBLK)*OP+h*D; float*ssw=ssa+(rowbase+q0+wid*QBLK)*8+h;
  { bf16*stg=(bf16*)(shm+LDS_OST)+wid*2048;
    #pragma unroll
    for(int r=0;r<16;++r){const int orow=crow(r,hi);
      #pragma unroll
      for(int d0=0;d0<2;++d0)stg[orow*64+d0*32+r32]=__float2bfloat16(o[d0][r]*rli[r]);}
    asm volatile("s_waitcnt lgkmcnt(0)":::"memory");
    #pragma unroll
    for(int i=0;i<4;++i){const int row=i*8+(lane>>3),ch=lane&7; const u32x4 v=*(const u32x4*)(stg+row*64+ch*8); ATTN_STORE16(Ow+(long)row*OP+ch*8,v);
      float sq=0.f; _Pragma("unroll") for(int e=0;e<4;++e){ const float lo=__uint_as_float(v[e]<<16), hi_=__uint_as_float(v[e]&0xffff0000u); sq+=lo*lo+hi_*hi_; }
      sq+=__shfl_xor(sq,1); sq+=__shfl_xor(sq,2); sq+=__shfl_xor(sq,4); if(ch==0) *(__attribute__((address_space(1))) float*)(ssw+(long)row*8)=sq; } }
  asm volatile("s_waitcnt lgkmcnt(0)\n\ts_barrier":::"memory");
  #undef DMA_K
  #undef DMA_V
  #undef CMASK
  #undef MTAB
  #undef START
  #undef RESC
  #undef ROT
}
constexpr int ATTN_LDS_BYTES=LDS_BYTES;
struct AttnTensors { const bf16* Q; const bf16* K; const bf16* V; bf16* O; float* ssa; };
struct AttnUnit { int bh; int qb; };
struct StaticOrder {
  int vcu;
  __device__ __forceinline__ explicit StaticOrder(int vcu_):vcu(vcu_){}
  __device__ __forceinline__ bool next(int i,AttnUnit&u)const{ if(i>=2)return false; const int s=vcu&3; u.bh=vcu>>2; u.qb=(i==0)?s:7-s; return true; }
  __device__ __forceinline__ void a_ready(const AttnUnit&)const{}
  __device__ __forceinline__ void done(const AttnUnit&)const{}
};
template<class Sched,int THRL=8> __device__ __forceinline__ void attn_phase(char*lds,const __attribute__((address_space(3))) float*mtab,const AttnTensors&T,const Sched&S){
  AttnUnit u;
  for(int i=0;S.next(i,u);++i){ S.a_ready(u); attn_unit<THRL>(u.bh/NHEAD,u.bh%NHEAD,u.qb,T.Q,T.K,T.V,T.O,T.ssa,mtab,lds); S.done(u); }
}
#undef SBAR
#undef WAIT_BAR
}
namespace ssm {
#define SLAS __attribute__((address_space(3)))
#define SGAS __attribute__((address_space(1)))
typedef short bf16x8 __attribute__((ext_vector_type(8)));
typedef float f32x4 __attribute__((ext_vector_type(4)));
typedef unsigned u32x4 __attribute__((ext_vector_type(4)));
typedef unsigned u32x2 __attribute__((ext_vector_type(2)));
constexpr int G = 32, GC = 16, SN = 64, CH = 32;
constexpr size_t F_OFF = 0, PF_OFF = 32768, QF_OFF = 32768 + 131072, TBL_BYTES = 32768 + 2 * 131072;
__device__ __forceinline__ unsigned f2bf(float f) { unsigned u = __builtin_bit_cast(unsigned, f); return (u + 0x7fffu + ((u >> 16) & 1u)) >> 16; }
__device__ __forceinline__ unsigned pk2(float lo, float hi) { return f2bf(lo) | (f2bf(hi) << 16); }
__device__ __forceinline__ float gelu_tanh(float x) { const float k = 0.7978845608028654f; const float t = k * (x + 0.044715f * x * x * x);
    const float e = __builtin_amdgcn_exp2f(2.0f * 1.4426950408889634f * t); const float th = 1.0f - 2.0f * __builtin_amdgcn_rcpf(1.0f + e); return 0.5f * x * (1.0f + th); }

struct Disc { float ldr, ldi, fr, fi; };
__device__ __forceinline__ Disc disc(float a_re, float a_im, float log_dt) {
    Disc d; const float lr = fminf(a_re, -1e-4f), li = a_im, dt = expf(log_dt);
    d.ldr = lr * dt; d.ldi = li * dt;
    const float mag = expf(d.ldr), sn = sinf(d.ldi), cs = cosf(d.ldi), sh = sinf(0.5f * d.ldi);
    const float em1r = expm1f(d.ldr) * cs - 2.0f * sh * sh;
    const float em1i = mag * sn;
    const float den = lr * lr + li * li;
    d.fr = (em1r * lr + em1i * li) / den; d.fi = (em1i * lr - em1r * li) / den;
    return d;
}

__device__ __forceinline__ void build_tables(int l, int g, int half, const SGAS float* a_re, const SGAS float* a_im, const SGAS float* log_dt, const SGAS float* b_re, const SGAS float* b_im, const SGAS float* c_re, const SGAS float* c_im, const SGAS float* dsk,
                                             SGAS unsigned char* tbl, SGAS float* a32, SGAS float* ssc  , SLAS unsigned char* lds) {
    int tid_ = threadIdx.x; asm volatile("" : "+v"(tid_)); const int tid = tid_;
    SLAS float* pwr = (SLAS float*)lds;
    SLAS float* pwi = pwr + 33 * 64;
    SLAS float* bbr = pwi + 33 * 64;
    SLAS float* bbi = bbr + 1024;
    SLAS float* crT = bbi + 1024;
    SLAS float* ciT = crT + 1024;
    SLAS float* Mt = ciT + 1024;
    SLAS float* dsc = Mt + 8192;
    const int lg = l * G + g;
    if (tid < 64) { const Disc d = disc(a_re[lg * SN + tid], a_im[lg * SN + tid], log_dt[lg]); dsc[tid * 4] = d.ldr; dsc[tid * 4 + 1] = d.ldi; dsc[tid * 4 + 2] = d.fr; dsc[tid * 4 + 3] = d.fi; }
    for (int i = tid; i < 1024; i += 512) { const int c = i >> 6, n = i & 63; crT[n * 16 + c] = c_re[(size_t)lg * 1024 + i]; ciT[n * 16 + c] = c_im[(size_t)lg * 1024 + i]; }
    __syncthreads();
    for (int i = tid; i < 1024; i += 512) { const int n = i >> 4; const float fr = dsc[n * 4 + 2], fi = dsc[n * 4 + 3];
        const float br = b_re[(size_t)lg * 1024 + i], bi = b_im[(size_t)lg * 1024 + i]; bbr[i] = fr * br - fi * bi; bbi[i] = fr * bi + fi * br; }
    for (int i = tid; i < 33 * 64; i += 512) { const int tau = i >> 6, n = i & 63; const float mg = expf(dsc[n * 4] * (float)tau), ang = dsc[n * 4 + 1] * (float)tau; float sn, cs; sincosf(ang, &sn, &cs); pwr[i] = mg * cs; pwi[i] = mg * sn; }
    __syncthreads();
    if (half == 0) {
        if (tid < 64) { a32[(size_t)(lg * SN + tid) * 2] = pwr[32 * 64 + tid]; a32[(size_t)(lg * SN + tid) * 2 + 1] = pwi[32 * 64 + tid];
            SGAS float* sc = ssc + (size_t)(lg * SN + tid) * 36; sc[0] = pwr[64 + tid]; sc[1] = pwi[64 + tid]; sc[2] = 0.f; sc[3] = 0.f;
            for (int c = 0; c < 16; ++c) { sc[4 + c] = bbr[tid * 16 + c]; sc[20 + c] = bbi[tid * 16 + c]; } }
        { const int tau = tid >> 4, cb = (tid >> 2) & 3, pb = tid & 3; f32x4 m0 = {0.f, 0.f, 0.f, 0.f}, m1 = m0, m2 = m0, m3 = m0;
          for (int n = 0; n < 64; ++n) { const float pr = pwr[tau * 64 + n], pi = pwi[tau * 64 + n];
              const f32x4 xr = *(const SLAS f32x4*)(bbr + n * 16 + 4 * pb), xi = *(const SLAS f32x4*)(bbi + n * 16 + 4 * pb);
              const f32x4 er = xr * pr - xi * pi, ei = xi * pr + xr * pi;
              const f32x4 cr = *(const SLAS f32x4*)(crT + n * 16 + 4 * cb), ci = *(const SLAS f32x4*)(ciT + n * 16 + 4 * cb);
              m0 = m0 + er * cr[0] - ei * ci[0]; m1 = m1 + er * cr[1] - ei * ci[1]; m2 = m2 + er * cr[2] - ei * ci[2]; m3 = m3 + er * cr[3] - ei * ci[3]; }
          if (tau == 0 && cb == pb) { m0[0] += dsk[lg * GC + 4 * cb]; m1[1] += dsk[lg * GC + 4 * cb + 1]; m2[2] += dsk[lg * GC + 4 * cb + 2]; m3[3] += dsk[lg * GC + 4 * cb + 3]; }
          SLAS float* mp = Mt + tau * 256 + (4 * cb) * 16 + 4 * pb; *(SLAS f32x4*)mp = m0; *(SLAS f32x4*)(mp + 16) = m1; *(SLAS f32x4*)(mp + 32) = m2; *(SLAS f32x4*)(mp + 48) = m3; }
        __syncthreads();
        for (int i = tid; i < 32 * 64; i += 512) { const int dl = i >> 6, lane = i & 63, c = lane & 15, kg = lane >> 4, tau = dl - (kg >> 1), c0 = 8 * (kg & 1); float v[8];
#pragma unroll
            for (int j = 0; j < 8; ++j) v[j] = (tau >= 0) ? Mt[tau * 256 + c * 16 + c0 + j] : 0.f;
            u32x4 w; w.x = pk2(v[0], v[1]); w.y = pk2(v[2], v[3]); w.z = pk2(v[4], v[5]); w.w = pk2(v[6], v[7]);
            *(SGAS u32x4*)(tbl + F_OFF + (size_t)i * 16) = w; }
        for (int i = tid; i < 8 * 16 * 64; i += 512) { const int nt = i >> 10, p = (i >> 6) & 15, lane = i & 63, np = 16 * nt + (lane & 15), kg = lane >> 4, sp = 2 * p + (kg >> 1), c0 = 8 * (kg & 1), n = np & 63, tau = 31 - sp;
            const float pr = pwr[tau * 64 + n], pi = pwi[tau * 64 + n]; float v[8];
#pragma unroll
            for (int j = 0; j < 8; ++j) { const float xr = bbr[n * 16 + c0 + j], xi = bbi[n * 16 + c0 + j]; v[j] = (np < 64) ? (pr * xr - pi * xi) : (pr * xi + pi * xr); }
            u32x4 w; w.x = pk2(v[0], v[1]); w.y = pk2(v[2], v[3]); w.z = pk2(v[4], v[5]); w.w = pk2(v[6], v[7]);
            *(SGAS u32x4*)(tbl + PF_OFF + (size_t)i * 16) = w; }
    } else {
        for (int i = tid; i < 32 * 4 * 64; i += 512) { const int s = i >> 8, kb = (i >> 6) & 3, lane = i & 63, c = lane & 15, kg = lane >> 4; float v[8];
#pragma unroll
            for (int j = 0; j < 8; ++j) { const int np = 32 * kb + 8 * kg + j, n = np & 63; const float pr = pwr[(s + 1) * 64 + n], pi = pwi[(s + 1) * 64 + n], xr = crT[n * 16 + c], xi = ciT[n * 16 + c];
                v[j] = (np < 64) ? (xr * pr - xi * pi) : -(xr * pi + xi * pr); }
            u32x4 w; w.x = pk2(v[0], v[1]); w.y = pk2(v[2], v[3]); w.z = pk2(v[4], v[5]); w.w = pk2(v[6], v[7]);
            *(SGAS u32x4*)(tbl + QF_OFF + (size_t)i * 16) = w; }
    }
    __syncthreads();
}

constexpr int UST_ROW = 1040, HP_OFF = 66560, HP_ROW = 136, SL_OFF = 83968, SL_ROW = 132, ZST_OFF = 83968, GT_OFF = 150528, PU_LDS_END = 154624;
template <int K_>
__device__ __forceinline__ void y_pass(int h, const bf16x8 (&ff)[16]  , const bf16x8 (&qf)[4][4]  , SLAS unsigned char* lds, int lane) {
    const int j = lane & 15, kg = lane >> 4;
    const SLAS unsigned char* ub = lds + j * UST_ROW + (kg >> 1) * 32 + (kg & 1) * 16;
    const SLAS unsigned char* hb = lds + HP_OFF + (j * HP_ROW + 8 * kg) * 2;
    SLAS unsigned char* zb = lds + ZST_OFF + j * UST_ROW + 8 * kg;
#pragma unroll 1
    for (int ct = 0; ct < 4; ++ct) {
        f32x4 acc[4];
#pragma unroll
        for (int i = 0; i < 4; ++i) acc[i] = (f32x4){0.f, 0.f, 0.f, 0.f};
#pragma unroll
        for (int p = 0; p <= 12 + K_; ++p) {
            const bf16x8 u = *(const SLAS bf16x8*)(ub + ct * 16 * UST_ROW + p * 64);
#pragma unroll
            for (int i = 0; i < 4; ++i) if (p <= 4 * i + K_) acc[i] = __builtin_amdgcn_mfma_f32_16x16x32_bf16(ff[4 * i + K_ - p], u, acc[i], 0, 0, 0);
        }
#pragma unroll
        for (int kb = 0; kb < 4; ++kb) {
            const bf16x8 hpf = *(const SLAS bf16x8*)(hb + ct * 16 * HP_ROW * 2 + kb * 64);
#pragma unroll
            for (int i = 0; i < 4; ++i) acc[i] = __builtin_amdgcn_mfma_f32_16x16x32_bf16(qf[i][kb], hpf, acc[i], 0, 0, 0);
        }
#pragma unroll
        for (int i = 0; i < 4; ++i) { const int s = h + 2 * (4 * i + K_); const f32x4 y = acc[i];
            u32x2 w; w.x = pk2(gelu_tanh(y[0]), gelu_tanh(y[1])); w.y = pk2(gelu_tanh(y[2]), gelu_tanh(y[3]));
            *(SLAS u32x2*)(zb + ct * 16 * UST_ROW + s * 32) = w; }
    }
}

__device__ __forceinline__ void prompt_unit(int g, int b, int l, const SGAS unsigned short* U  , const SGAS unsigned char* tbl_l  , const SGAS float* a32_l, SGAS unsigned short* Zb  , SGAS float* out_re, SGAS float* out_im  ,
                                            SLAS unsigned char* lds) {
    int tid_ = threadIdx.x; asm volatile("" : "+v"(tid_)); const int tid = tid_, lane = tid & 63, wid = __builtin_amdgcn_readfirstlane(tid >> 6), j = lane & 15, kg = lane >> 4;
    const SGAS unsigned char* tbl = tbl_l + (size_t)g * TBL_BYTES;
    SLAS float* SL = (SLAS float*)(lds + SL_OFF); SLAS unsigned short* HP = (SLAS unsigned short*)(lds + HP_OFF);
    const size_t blk = ((size_t)g * 16384 + (size_t)b * 2048) * 16;
    bf16x8 ff[16], qf[4][4];
    { u32x4 v[8];
#pragma unroll
      for (int k = 0; k < 8; ++k) v[k] = *(const SGAS u32x4*)((const SGAS unsigned char*)(U + blk) + (size_t)(tid + 512 * k) * 16);
      bf16x8 pf[16];
#pragma unroll
      for (int p = 0; p < 16; ++p) pf[p] = *(const SGAS bf16x8*)(tbl + PF_OFF + (size_t)((wid * 16 + p) * 64 + lane) * 16);
#pragma unroll
      for (int k = 0; k < 8; ++k) { const int off = (tid + 512 * k) * 16; *(SLAS u32x4*)(lds + (off >> 10) * UST_ROW + (off & 1023)) = v[k]; }
      __syncthreads();
#pragma unroll
      for (int i = 0; i < 16; ++i) ff[i] = *(const SGAS bf16x8*)(tbl + F_OFF + (size_t)((2 * i + (wid & 1)) * 64 + lane) * 16);
#pragma unroll
      for (int i = 0; i < 4; ++i)
#pragma unroll
          for (int kb = 0; kb < 4; ++kb) qf[i][kb] = *(const SGAS bf16x8*)(tbl + QF_OFF + (size_t)((((wid & 1) + 2 * (4 * i + (wid >> 1))) * 4 + kb) * 64 + lane) * 16);
      const SLAS unsigned char* ub = lds + j * UST_ROW + (kg >> 1) * 32 + (kg & 1) * 16;
#pragma unroll 1
      for (int ct = 0; ct < 4; ++ct) { f32x4 acc = {0.f, 0.f, 0.f, 0.f};
#pragma unroll
          for (int p = 0; p < 16; ++p) { const bf16x8 u = *(const SLAS bf16x8*)(ub + ct * 16 * UST_ROW + p * 64); acc = __builtin_amdgcn_mfma_f32_16x16x32_bf16(pf[p], u, acc, 0, 0, 0); }
          *(SLAS f32x4*)(SL + (16 * ct + j) * SL_ROW + 16 * wid + 4 * kg) = acc; } }
    __syncthreads();
    { const float ar = a32_l[(size_t)(g * SN + lane) * 2], ai = a32_l[(size_t)(g * SN + lane) * 2 + 1];
      SLAS float* GT = (SLAS float*)(lds + GT_OFF);
      float hr = 0.f, hi = 0.f, lr[8], li[8];
#pragma unroll
      for (int k = 0; k < 8; ++k) { lr[k] = hr; li[k] = hi; const int c = 8 * wid + k; const float sr = SL[c * SL_ROW + lane], si = SL[c * SL_ROW + 64 + lane];
          const float nr = ar * hr - ai * hi + sr, ni = ar * hi + ai * hr + si; hr = nr; hi = ni; }
      GT[wid * 128 + lane] = hr; GT[wid * 128 + 64 + lane] = hi;
      float pr = ar, pi = ai;
#pragma unroll
      for (int k = 0; k < 3; ++k) { const float nr = pr * pr - pi * pi, ni = 2.0f * pr * pi; pr = nr; pi = ni; }
      __syncthreads();
      float cr = 0.f, ci = 0.f;
      for (int w = 0; w < 8; ++w) { if (w == wid) break; const float tr = GT[w * 128 + lane], ti = GT[w * 128 + 64 + lane]; const float nr = pr * cr - pi * ci + tr, ni = pr * ci + pi * cr + ti; cr = nr; ci = ni; }
      float qr = 1.f, qi = 0.f;
#pragma unroll
      for (int k = 0; k < 8; ++k) { const int c = 8 * wid + k; const float vr = lr[k] + qr * cr - qi * ci, vi = li[k] + qr * ci + qi * cr;
          HP[c * HP_ROW + lane] = (unsigned short)f2bf(vr); HP[c * HP_ROW + 64 + lane] = (unsigned short)f2bf(vi);
          const float nr = qr * ar - qi * ai, ni = qr * ai + qi * ar; qr = nr; qi = ni; }
      if (wid == 7) { const float fr_ = hr + qr * cr - qi * ci, fi_ = hi + qr * ci + qi * cr;
          out_re[(size_t)(b * G + g) * SN + lane] = fr_; out_im[(size_t)(b * G + g) * SN + lane] = fi_; } }
    __syncthreads();
    { const int h = wid & 1, k4 = wid >> 1;
      if (k4 == 0) y_pass<0>(h, ff, qf, lds, lane); else if (k4 == 1) y_pass<1>(h, ff, qf, lds, lane); else if (k4 == 2) y_pass<2>(h, ff, qf, lds, lane); else y_pass<3>(h, ff, qf, lds, lane); }
    __syncthreads();
#pragma unroll
    for (int k = 0; k < 8; ++k) { const int off = (tid + 512 * k) * 16; const u32x4 v = *(const SLAS u32x4*)(lds + ZST_OFF + (off >> 10) * UST_ROW + (off & 1023)); *(SGAS u32x4*)((SGAS unsigned char*)(Zb + blk) + off) = v; }
    __syncthreads();
}

__device__ __forceinline__ void sample_unit(int b, int g, int l, const SGAS float* Us, const SGAS float* h0re, const SGAS float* h0im, const SGAS float* ssc,
                                            const SGAS float* c_re, const SGAS float* c_im, const SGAS float* dsk, SGAS unsigned short* Zb, SGAS float* out_re, SGAS float* out_im, SLAS float* wlds, int lane) {
    const int lg = l * G + g, n = lane;
    const SGAS float* sc = ssc + (size_t)(lg * SN + n) * 36; const float abr = sc[0], abi = sc[1];
    float bbr[16], bbi[16];
#pragma unroll
    for (int c = 0; c < 16; ++c) { bbr[c] = sc[4 + c]; bbi[c] = sc[20 + c]; }
    float hr = h0re[(size_t)(b * G + g) * SN + n], hi = h0im[(size_t)(b * G + g) * SN + n];
#pragma unroll
    for (int t = 0; t < 8; ++t) { const SGAS float* up = Us + (size_t)(b * 8 + t) * 512 + g * 16; float ur = 0.f, ui = 0.f;
#pragma unroll
        for (int c = 0; c < 16; ++c) { const float u = up[c]; ur += bbr[c] * u; ui += bbi[c] * u; }
        const float nr = abr * hr - abi * hi + ur, ni = abr * hi + abi * hr + ui; hr = nr; hi = ni;
        wlds[t * 128 + n] = hr; wlds[t * 128 + 64 + n] = hi; }
    out_re[(size_t)(b * G + g) * SN + n] = hr; out_im[(size_t)(b * G + g) * SN + n] = hi;
    SLAS float* cl = wlds + 1024;
#pragma unroll
    for (int i = 0; i < 16; ++i) { cl[i * 65 + lane] = c_re[(size_t)(lg * GC + i) * SN + lane]; cl[(16 + i) * 65 + lane] = c_im[(size_t)(lg * GC + i) * SN + lane]; }
    asm volatile("s_waitcnt lgkmcnt(0)" ::: "memory");
    const int t = lane >> 3, c0 = 2 * (lane & 7); float y0 = 0.f, y1 = 0.f;
    for (int m = 0; m < 64; ++m) { const float xr = wlds[t * 128 + m], xi = wlds[t * 128 + 64 + m]; y0 += xr * cl[c0 * 65 + m] - xi * cl[(16 + c0) * 65 + m]; y1 += xr * cl[(c0 + 1) * 65 + m] - xi * cl[(17 + c0) * 65 + m]; }
    const SGAS float* up = Us + (size_t)(b * 8 + t) * 512 + g * 16 + c0;
    y0 += dsk[lg * GC + c0] * up[0]; y1 += dsk[lg * GC + c0 + 1] * up[1];
    *(SGAS unsigned*)(Zb + ((size_t)16384 + b * 8 + t) * 512 + g * 16 + c0) = pk2(gelu_tanh(y0), gelu_tanh(y1));
    asm volatile("s_waitcnt lgkmcnt(0)" ::: "memory");
}
#undef SLAS
#undef SGAS
}
namespace mini {
typedef unsigned short bf16_t;
typedef short bf16x8 __attribute__((ext_vector_type(8)));
typedef float f32x4 __attribute__((ext_vector_type(4)));
typedef unsigned u32x2 __attribute__((ext_vector_type(2)));
#define MLAS __attribute__((address_space(3)))
constexpr int PART_W = 32 * 64;
__device__ __forceinline__ u32x2 pack4(const f32x4 a) { u32x2 w; w.x = pg8::cvt_pk_bf16(a[0], a[1]); w.y = pg8::cvt_pk_bf16(a[2], a[3]); return w; }
__device__ __forceinline__ f32x4 sumw(const MLAS float* p, int w0, int w1) { f32x4 s = {0.f, 0.f, 0.f, 0.f};
#pragma unroll
    for (int w = w0; w < w1; ++w) s = s + *(const MLAS f32x4*)(p + w * PART_W); return s; }
__device__ __forceinline__ float red16(float v) { v += __shfl_xor(v, 1); v += __shfl_xor(v, 2); v += __shfl_xor(v, 4); v += __shfl_xor(v, 8); return v; }
__device__ __forceinline__ float sq4(const f32x4 a) { return (a[0] * a[0] + a[1] * a[1]) + (a[2] * a[2] + a[3] * a[3]); }

template <int K, class Epi>
__device__ __forceinline__ void unit(const GAS bf16_t* A  , const GAS bf16_t* Bt  , int rb, int ngroups, MLAS float* part, const Epi& epi0) {
    int tid_ = threadIdx.x; asm volatile("" : "+v"(tid_)); const int tid = tid_, lane = tid & 63, wid = __builtin_amdgcn_readfirstlane(tid >> 6), j = lane & 15, kg = lane >> 4;
    constexpr int KS = K / 8, NK = KS / 32, CH = 4, NCH = (NK + CH - 1) / CH;
    const int kbase = wid * KS + 8 * kg;
    const GAS bf16_t* a0 = A + (size_t)(rb * 32 + j) * K + kbase; const GAS bf16_t* a1 = a0 + (size_t)16 * K;
    Epi epi = epi0; epi.prep(rb * 32 + (tid >> 4));
    bf16x8 af[CH][2], bf[CH][4];
#define MINI_LOAD(g_, c_) do { _Pragma("unroll") for (int q = 0; q < CH; ++q) if ((c_) * CH + q < NK) { const int ks = (c_) * CH + q; af[q][0] = *(const GAS bf16x8*)(a0 + 32 * ks); af[q][1] = *(const GAS bf16x8*)(a1 + 32 * ks); \
        _Pragma("unroll") for (int ct = 0; ct < 4; ++ct) bf[q][ct] = *(const GAS bf16x8*)(Bt + (size_t)epi.brow((g_), 16 * ct + j) * K + kbase + 32 * ks); } } while (0)
    MINI_LOAD(0, 0);
#pragma unroll 1
    for (int g = 0; g < ngroups; ++g) {
        f32x4 acc[2][4];
#pragma unroll
        for (int rt = 0; rt < 2; ++rt)
#pragma unroll
            for (int ct = 0; ct < 4; ++ct) acc[rt][ct] = (f32x4){0.f, 0.f, 0.f, 0.f};
#pragma unroll
        for (int c = 0; c < NCH; ++c) {
            __builtin_amdgcn_sched_barrier(0);
#pragma unroll
            for (int q = 0; q < CH; ++q) if (c * CH + q < NK) {
#pragma unroll
                for (int ct = 0; ct < 4; ++ct) { acc[0][ct] = __builtin_amdgcn_mfma_f32_16x16x32_bf16(bf[q][ct], af[q][0], acc[0][ct], 0, 0, 0); acc[1][ct] = __builtin_amdgcn_mfma_f32_16x16x32_bf16(bf[q][ct], af[q][1], acc[1][ct], 0, 0, 0); } }
            __builtin_amdgcn_sched_barrier(0);
            if (c + 1 < NCH) MINI_LOAD(g, c + 1); else if (g + 1 < ngroups) MINI_LOAD(g + 1, 0);
            __builtin_amdgcn_sched_barrier(0);
        }
#pragma unroll
        for (int rt = 0; rt < 2; ++rt)
#pragma unroll
            for (int ct = 0; ct < 4; ++ct) *(MLAS f32x4*)(part + (wid * 32 + 16 * rt + j) * 64 + 16 * ct + 4 * kg) = acc[rt][ct];
        __syncthreads();
        epi.reduce(g, rb * 32 + (tid >> 4), (tid & 15) * 4, part + (tid >> 4) * 64 + (tid & 15) * 4);
        __syncthreads();
    }
#undef MINI_LOAD
}

constexpr float QS = 0.125f * 1.4426950408889634f, EPSN = 1e-6f;
struct E1 {
    GAS unsigned char* ws; GAS float* out; int l, cb; float r;
    __device__ __forceinline__ void prep(int srow) { r = __builtin_amdgcn_rsqf(pg8::sum16((const GAS float*)(pg8::lau(ws) + WS_SS1) + (size_t)(MP + srow) * 16) * (1.0f / 1024.0f) + EPSN); }
    __device__ __forceinline__ int brow(int, int c) const { return 64 * cb + c; }
    __device__ __forceinline__ void reduce(int, int srow, int c4, const MLAS float* p) const {
        GAS unsigned char* w = pg8::lau(ws); const int row = MP + srow, col = 64 * cb + c4, seg = col >> 9, c = col & 511;
        const f32x4 v = sumw(p, 0, 8) * r;
        if (seg == 0) { *(GAS u32x2*)((GAS bf16_t*)(w + WS_QB) + (size_t)row * 512 + c) = pack4(v * QS); }
        else if (seg == 3) { *(GAS f32x4*)((GAS float*)(w + WS_US) + (size_t)srow * 512 + c) = v; }
        else { *(GAS u32x2*)((GAS bf16_t*)(w + (seg == 1 ? WS_KB : WS_VB)) + (size_t)row * 512 + c) = pack4(v);
               *(GAS f32x4*)(pg8::lauf(out) + (seg == 1 ? O_SK : O_SV) + (size_t)l * MS * 512 + (size_t)srow * 512 + c) = v; }
    }
};
struct E3 {
    GAS unsigned char* ws; const GAS float* bias; int cb;
    __device__ __forceinline__ void prep(int) {}
    __device__ __forceinline__ int brow(int, int c) const { return 64 * cb + c; }
    __device__ __forceinline__ void reduce(int, int srow, int c4, const MLAS float* p) const {
        GAS unsigned char* w = pg8::lau(ws); const int row = MP + srow, col = 64 * cb + c4;
        const f32x4 a = sumw(p, 0, 8) + *(const GAS f32x4*)(bias + col);
        const u32x2 zz = *(const GAS u32x2*)((const GAS bf16_t*)(w + WS_ZB) + (size_t)row * 512 + col);
        f32x4 z; z[0] = __uint_as_float(zz.x << 16); z[1] = __uint_as_float(zz.x & 0xffff0000u); z[2] = __uint_as_float(zz.y << 16); z[3] = __uint_as_float(zz.y & 0xffff0000u);
        f32x4 o;
#pragma unroll
        for (int e = 0; e < 4; ++e) o[e] = z[e] * __builtin_amdgcn_rcpf(1.0f + __builtin_amdgcn_exp2f(-1.4426950408889634f * a[e]));
        *(GAS u32x2*)((GAS bf16_t*)(w + WS_MIX) + (size_t)row * 1024 + 512 + col) = pack4(o);
        const float part = red16(sq4(o)); if ((c4 >> 2) == 0) ((GAS float*)(w + WS_SSS))[(size_t)row * 8 + cb] = part;
    }
};
struct E4 {
    GAS unsigned char* ws; int cb; float ra, rs;
    __device__ __forceinline__ void prep(int srow) { GAS unsigned char* w = pg8::lau(ws); const int row = MP + srow;
        ra = __builtin_amdgcn_rsqf(pg8::sum8((const GAS float*)(w + WS_SSA) + (size_t)row * 8) * (1.0f / 512.0f) + EPSN); rs = __builtin_amdgcn_rsqf(pg8::sum8((const GAS float*)(w + WS_SSS) + (size_t)row * 8) * (1.0f / 512.0f) + EPSN); }
    __device__ __forceinline__ int brow(int, int c) const { return 64 * cb + c; }
    __device__ __forceinline__ void reduce(int, int srow, int c4, const MLAS float* p) const {
        GAS unsigned char* w = pg8::lau(ws); const int row = MP + srow, col = 64 * cb + c4;
        const f32x4 mixed = sumw(p, 0, 4) * ra + sumw(p, 4, 8) * rs;
        GAS bf16_t* xr = (GAS bf16_t*)(w + WS_XB) + (size_t)row * 1024 + col; const u32x2 xx = *(const GAS u32x2*)xr;
        f32x4 x; x[0] = __uint_as_float(xx.x << 16); x[1] = __uint_as_float(xx.x & 0xffff0000u); x[2] = __uint_as_float(xx.y << 16); x[3] = __uint_as_float(xx.y & 0xffff0000u);
        const f32x4 h = x + mixed; *(GAS u32x2*)xr = pack4(h);
        const float part = red16(sq4(h)); if ((c4 >> 2) == 0) ((GAS float*)(w + WS_SS2))[(size_t)row * 16 + cb] = part;
    }
};
struct E5 {
    GAS unsigned char* ws; int q0; float r;
    __device__ __forceinline__ void prep(int srow) { r = __builtin_amdgcn_rsqf(pg8::sum16((const GAS float*)(pg8::lau(ws) + WS_SS2) + (size_t)(MP + srow) * 16) * (1.0f / 1024.0f) + EPSN); }
    __device__ __forceinline__ int brow(int g, int c) const { const int q = q0 + 16 * g; return 256 * (q >> 2) + ((c < 32) ? 32 * (q & 3) + c : 128 + 32 * (q & 3) + (c - 32)); }
    __device__ __forceinline__ void reduce(int g, int srow, int c4, const MLAS float* p) const {
        if (c4 >= 32) return;
        GAS unsigned char* w = pg8::lau(ws); const int row = MP + srow, q = q0 + 16 * g;
        const f32x4 gt = sumw(p, 0, 8) * r, up = sumw(p + 32, 0, 8) * r; f32x4 o;
#pragma unroll
        for (int e = 0; e < 4; ++e) o[e] = gt[e] * up[e] * __builtin_amdgcn_rcpf(1.0f + __builtin_amdgcn_exp2f(-1.4426950408889634f * gt[e]));
        *(GAS u32x2*)((GAS bf16_t*)(w + WS_GB) + (size_t)row * 2816 + 128 * (q >> 2) + 32 * (q & 3) + c4) = pack4(o);
    }
};
struct E6 {
    GAS unsigned char* ws; int cb;
    __device__ __forceinline__ void prep(int) {}
    __device__ __forceinline__ int brow(int, int c) const { return 64 * cb + c; }
    __device__ __forceinline__ void reduce(int, int srow, int c4, const MLAS float* p) const {
        GAS unsigned char* w = pg8::lau(ws); const int row = MP + srow, col = 64 * cb + c4;
        GAS bf16_t* xr = (GAS bf16_t*)(w + WS_XB) + (size_t)row * 1024 + col; const u32x2 xx = *(const GAS u32x2*)xr;
        f32x4 x; x[0] = __uint_as_float(xx.x << 16); x[1] = __uint_as_float(xx.x & 0xffff0000u); x[2] = __uint_as_float(xx.y << 16); x[3] = __uint_as_float(xx.y & 0xffff0000u);
        const f32x4 y = x + sumw(p, 0, 8); *(GAS u32x2*)xr = pack4(y);
        const float part = red16(sq4(y)); if ((c4 >> 2) == 0) ((GAS float*)(w + WS_SS1))[(size_t)row * 16 + cb] = part;
    }
};
#undef MLAS
}
#define XB_TMO      128
#define XB_XCNT(j)  (256  + 64 * (j))
#define XB_XSUB(j)  (1280 + 64 * (j))
#define XB_XGEN(j)  (2304 + 64 * (j))
#define XB_TOP      3328
#define XB_TOPGEN   3392
#define XCD_BAR_WORDS 3456
#define XB_SPIN_CAP (1u << 18)

__device__ __forceinline__ unsigned xb_ld(unsigned* p)              { return __hip_atomic_load((GAS unsigned*)p, __ATOMIC_RELAXED, __HIP_MEMORY_SCOPE_AGENT); }
__device__ __forceinline__ unsigned xb_add(unsigned* p, unsigned v) { return __hip_atomic_fetch_add((GAS unsigned*)p, v, __ATOMIC_RELAXED, __HIP_MEMORY_SCOPE_AGENT); }
__device__ __forceinline__ unsigned xb_xcc_id() { return (unsigned)__builtin_amdgcn_s_getreg((3 << 11) | 20) & 0xFu; }
#define XB_SPIN(cond, bar) do { unsigned _sp = 0; while (cond) { __builtin_amdgcn_s_sleep(1); \
    if ((++_sp & 255u) == 0u) { if (xb_ld(&(bar)[XB_TMO])) break; if (_sp > XB_SPIN_CAP) { atomicAdd(&(bar)[XB_TMO], 1u); break; } } } } while (0)

struct XcdBarrier {
    unsigned* bar; unsigned x;
    volatile LAS unsigned* st;
};

__device__ __forceinline__ XcdBarrier xcd_barrier_post(unsigned* bar, volatile LAS unsigned* st) {
    XcdBarrier b; b.bar = bar; b.x = xb_xcc_id(); b.st = st;
    if (threadIdx.x == 0) (void)xb_add(&bar[XB_XCNT(b.x)], 1u);
    return b;
}
__device__ __forceinline__ void xcd_barrier_complete(unsigned* bar, unsigned x, unsigned& nloc, unsigned& nx) {
    const unsigned G = gridDim.x * gridDim.y * gridDim.z;
    unsigned sum, cnt, mine, sp = 0u;
    for (;;) {
        sum = 0u; cnt = 0u; mine = 0u;
#pragma unroll
        for (unsigned j = 0; j < 16; ++j) { const unsigned c = xb_ld(&bar[XB_XCNT(j)]); sum += c; cnt += (c > 0u) ? 1u : 0u; mine = (j == x) ? c : mine; }
        if (sum == G) break;
        __builtin_amdgcn_s_sleep(1);
        if ((++sp & 255u) == 0u) { if (xb_ld(&bar[XB_TMO])) break; if (sp > XB_SPIN_CAP) { atomicAdd(&bar[XB_TMO], 1u); break; } }
    }
    nloc = mine > 0u ? mine : 1u; nx = cnt > 0u ? cnt : 1u;
}

__device__ __forceinline__ void xcd_barrier(const XcdBarrier& b) {
    asm volatile("s_waitcnt vmcnt(0)" ::: "memory");
    __syncthreads();
    if (threadIdx.x == 0) {
        unsigned* bar = b.bar;
        __builtin_amdgcn_s_waitcnt(0);
        unsigned nloc = b.st[0], nx = b.st[1];
        if (nloc == 0u) { xcd_barrier_complete(bar, b.x, nloc, nx); b.st[0] = nloc; b.st[1] = nx; }
        const unsigned old = xb_add(&bar[XB_XSUB(b.x)], 1u);
        const unsigned gen = old / nloc;
        if (old + 1u == (gen + 1u) * nloc) {
            __builtin_amdgcn_fence(__ATOMIC_RELEASE, "agent");
            asm volatile("s_waitcnt vmcnt(0)" ::: "memory");
            const unsigned og = xb_add(&bar[XB_TOP], 1u);
            const unsigned tg = og / nx;
            if (og + 1u == (tg + 1u) * nx) xb_add(&bar[XB_TOPGEN], 1u);
            else XB_SPIN(xb_ld(&bar[XB_TOPGEN]) == tg, bar);
            __builtin_amdgcn_fence(__ATOMIC_ACQUIRE, "agent");
            xb_add(&bar[XB_XGEN(b.x)], 1u);
            asm volatile("s_waitcnt vmcnt(0)" ::: "memory");
        } else {
            XB_SPIN(xb_ld(&bar[XB_XGEN(b.x)]) == gen, bar);
            __builtin_amdgcn_fence(__ATOMIC_ACQUIRE, "agent");
            asm volatile("s_waitcnt vmcnt(0)" ::: "memory");
        }
    }
    __syncthreads();
}

__device__ __forceinline__ void xcc_local_barrier(unsigned* bar, unsigned* cnt, unsigned n) {
    asm volatile("s_waitcnt vmcnt(0)" ::: "memory");
    __syncthreads();
    if (threadIdx.x == 0) {
        __builtin_amdgcn_s_waitcnt(0);
#if EARLY_INV
        __builtin_amdgcn_fence(__ATOMIC_ACQUIRE, "agent");
        const unsigned old = xb_add(cnt, 1u);
        const unsigned tgt = (old / n + 1u) * n;
        if (old + 1u != tgt) XB_SPIN(xb_ld(cnt) < tgt, bar);
        asm volatile("s_waitcnt vmcnt(0)" ::: "memory");
#else
        const unsigned old = xb_add(cnt, 1u);
        const unsigned tgt = (old / n + 1u) * n;
        XB_SPIN(xb_ld(cnt) < tgt, bar);
        __builtin_amdgcn_fence(__ATOMIC_ACQUIRE, "agent");
        asm volatile("s_waitcnt vmcnt(0)" ::: "memory");
#endif
    }
    __syncthreads();
}

__device__ __forceinline__ void xcc_signal(unsigned* cnt, unsigned same_l2) {
    asm volatile("s_waitcnt vmcnt(0)" ::: "memory");
    __syncthreads();
    if (threadIdx.x == 0) {
        if (!same_l2) { __builtin_amdgcn_fence(__ATOMIC_RELEASE, "agent"); asm volatile("s_waitcnt vmcnt(0)" ::: "memory"); }
        (void)xb_add(cnt, 1u);
    }
}
__device__ __forceinline__ void xcc_wait(unsigned* bar, unsigned* cnt, unsigned target) {
    asm volatile("s_waitcnt vmcnt(0)" ::: "memory");
    __syncthreads();
    if (threadIdx.x == 0) {
        __builtin_amdgcn_fence(__ATOMIC_ACQUIRE, "agent");
        XB_SPIN(xb_ld(cnt) < target, bar);
        asm volatile("s_waitcnt vmcnt(0)" ::: "memory");
    }
    __syncthreads();
}
static_assert(WS_WIN + (size_t)NLAYER * INW_ * DM_ * 2 <= WS_WOUT && WS_WOUT + (size_t)NLAYER * DM_ * DM_ * 2 <= WS_WGU && WS_WGU + (size_t)NLAYER * 2 * FF_ * DM_ * 2 <= WS_WDN &&
              WS_WDN + (size_t)NLAYER * DM_ * FF_ * 2 <= WS_WGLU && WS_WGLU + (size_t)NLAYER * 512 * 512 * 2 <= WS_SSMT && WS_SSMT + (size_t)NLAYER * 32 * ssm::TBL_BYTES <= WS_A32 &&
              WS_XRES + (size_t)MT * DM_ * 4 <= WS_XB && WS_XB + (size_t)MT * DM_ * 2 <= WS_QB && WS_QB + (size_t)MT * 512 * 2 <= WS_KB && WS_KB + (size_t)MT * 512 * 2 <= WS_VB &&
              WS_VB + (size_t)MT * 512 * 2 <= WS_UB && WS_UB + (size_t)32 * MP * 16 * 2 <= WS_US && WS_US + (size_t)MS * 512 * 4 <= WS_MIX && WS_MIX + (size_t)MT * 1024 * 2 <= WS_ZB &&
              WS_ZB + (size_t)MT * 512 * 2 <= WS_GB && WS_GB + (size_t)MT * FF_ * 2 <= WS_SS1 && WS_SS1 + (size_t)MT * 16 * 4 <= WS_SS2 && WS_SS2 + (size_t)MT * 16 * 4 <= WS_SSA &&
              WS_SSA + (size_t)MT * 8 * 4 <= WS_SSS && WS_SSS + (size_t)MT * 8 * 4 <= WS_SSC && WS_SSC + (size_t)NLAYER * 32 * 64 * 36 * 4 <= WS_END, "d_ws map");
static_assert(attn_body::LDS_BYTES <= MTAB_OFF && MTAB_OFF + MTAB_N * 4 <= RING_BYTES, "attention LDS");
static_assert(ssm::PU_LDS_END <= RTAB_OFF && RING_BYTES <= RTAB_OFF && PTAB_OFF + 27 * 8 <= LDS_BYTES, "LDS map");
struct Frame {
    LAS unsigned char* lds; volatile LAS unsigned* MISC; gu32* ctl; int tid, lane, wave, vcu, G;
};

__device__ __forceinline__ void p0_transpose_item(const GAS float* W, int K, int N, GAS bf16* WT, int k0, int n0, int drow0, const GAS float* scale, LAS float* scr, int lane) {
    float wv[32];
#pragma unroll
    for (int i = 0; i < 32; ++i) wv[i] = W[(size_t)(k0 + 2 * i + (lane >> 5)) * N + n0 + (lane & 31)];
#pragma unroll
    for (int i = 0; i < 32; ++i) { const int kk = 2 * i + (lane >> 5); const float sc = scale ? scale[k0 + kk] : 1.0f; scr[kk * 33 + (lane & 31)] = wv[i] * sc; }
    LDS_WAIT(); asm volatile("" ::: "memory");
    const int c = lane & 7;
#pragma unroll
    for (int j = 0; j < 4; ++j) { const int n = (lane >> 3) + 8 * j; const LAS float* s = scr + (8 * c) * 33 + n;
        v4u o; o.x = pk2(s[0 * 33], s[1 * 33]); o.y = pk2(s[2 * 33], s[3 * 33]); o.z = pk2(s[4 * 33], s[5 * 33]); o.w = pk2(s[6 * 33], s[7 * 33]);
        *(GAS v4u*)(WT + (size_t)(drow0 + n) * K + k0 + 8 * c) = o; }
    LDS_WAIT(); asm volatile("" ::: "memory");
}

#define SA_DPP(v, ctrl) __int_as_float(__builtin_amdgcn_update_dpp(0, __float_as_int(v), (ctrl), 0xF, 0xF, true))
__device__ __forceinline__ void sattn_unit(int b, int h, const GAS bf16* Qb, const GAS float* ck, const GAS float* cv, const GAS float* newK, const GAS float* newV, GAS bf16* MIX, GAS float* ssa, LAS float* wl, int t, int lane) {
    const int row = MP + b * 8 + t, kq = lane >> 4, dl = lane & 15;
    const GAS unsigned char* ckb = (const GAS unsigned char*)(ck + ((size_t)b * 2048 * 8 + h) * 64); const GAS unsigned char* cvb = (const GAS unsigned char*)(cv + ((size_t)b * 2048 * 8 + h) * 64);
    f32x4 q4; { typedef unsigned u32x2v __attribute__((ext_vector_type(2))); const u32x2v qq = *(const GAS u32x2v*)(Qb + (size_t)row * 512 + h * 64 + 4 * dl);
        q4[0] = __uint_as_float(qq.x << 16); q4[1] = __uint_as_float(qq.x & 0xffff0000u); q4[2] = __uint_as_float(qq.y << 16); q4[3] = __uint_as_float(qq.y & 0xffff0000u); }
#pragma unroll 1
    for (int br = 0; br < 3; ++br) { const int dil = br == 0 ? 1 : (br == 1 ? 4 : 16);
#pragma unroll 1
      for (int i0 = 0; i0 < 34; i0 += 17) {
        float sc[17];
        const unsigned o0 = ((unsigned)(2048 + t - ((4 * i0 + kq) << (2 * br))) << 11) + 16u * dl, str = 8192u << (2 * br);
#pragma unroll
        for (int ii = 0; ii < 17; ++ii) { f32x4 kv;
            if (ii >= 2 && ii < 15) kv = *(const GAS f32x4*)(ckb + (o0 - (unsigned)ii * str));
            else { const int i = i0 + ii; const int jj = min(4 * i + kq, 128);
                const int idx = 2048 + t - dil * jj;
                const GAS float* kp = (idx < 2048) ? ck + (((size_t)b * 2048 + idx) * 8 + h) * 64 : newK + ((size_t)(b * 8 + idx - 2048) * 512 + h * 64);
                kv = *(const GAS f32x4*)(kp + 4 * dl); }
            sc[ii] = (kv[0] * q4[0] + kv[1] * q4[1]) + (kv[2] * q4[2] + kv[3] * q4[3]); }
#pragma unroll
        for (int ii = 0; ii < 17; ++ii) { float a = sc[ii]; a += SA_DPP(a, 0xB1); a += SA_DPP(a, 0x4E); a += SA_DPP(a, 0x141); a += SA_DPP(a, 0x140);
            const int jj = 4 * (i0 + ii) + kq; if (dl == 0 && jj <= 128) wl[br * 192 + jj] = a; } } }
    LDS_WAIT();
    float m = -INFINITY;
#pragma unroll 1
    for (int i = lane; i < 576; i += 64) { const int jj = i % 192; if (jj <= 128) m = fmaxf(m, wl[i]); }
    m = wave_max(m);
    float den = 0.f;
#pragma unroll 1
    for (int i = lane; i < 576; i += 64) { const int jj = i % 192; if (jj <= 128) { const float p = __builtin_amdgcn_exp2f(wl[i] - m); den += p; wl[i] = p; } }
    den = wave_sum(den);
    LDS_WAIT();
    f32x4 acc = {0.f, 0.f, 0.f, 0.f};
#pragma unroll 1
    for (int br = 0; br < 3; ++br) { const int dil = br == 0 ? 1 : (br == 1 ? 4 : 16);
#pragma unroll 1
      for (int i0 = 0; i0 < 34; i0 += 17) {
        f32x4 vv[17];
        const unsigned o0 = ((unsigned)(2048 + t - ((4 * i0 + kq) << (2 * br))) << 11) + 16u * dl, str = 8192u << (2 * br);
#pragma unroll
        for (int ii = 0; ii < 17; ++ii) {
            if (ii >= 2 && ii < 15) vv[ii] = *(const GAS f32x4*)(cvb + (o0 - (unsigned)ii * str));
            else { const int i = i0 + ii; const int jj = min(4 * i + kq, 128);
                const int idx = 2048 + t - dil * jj;
                const GAS float* vp = (idx < 2048) ? cv + (((size_t)b * 2048 + idx) * 8 + h) * 64 : newV + ((size_t)(b * 8 + idx - 2048) * 512 + h * 64);
                vv[ii] = *(const GAS f32x4*)(vp + 4 * dl); } }
#pragma unroll
        for (int ii = 0; ii < 17; ++ii) { const int jj = 4 * (i0 + ii) + kq; const float p = (jj <= 128) ? wl[br * 192 + jj] : 0.f; acc = acc + vv[ii] * p; } } }
#pragma unroll
    for (int e = 0; e < 4; ++e) { acc[e] += __shfl_xor(acc[e], 16); acc[e] += __shfl_xor(acc[e], 32); }
    const float rd = __builtin_amdgcn_rcpf(den);
    const unsigned w0 = pk2(acc[0] * rd, acc[1] * rd), w1 = pk2(acc[2] * rd, acc[3] * rd);
    const float a0 = __uint_as_float(w0 << 16), a1 = __uint_as_float(w0 & 0xffff0000u), a2 = __uint_as_float(w1 << 16), a3 = __uint_as_float(w1 & 0xffff0000u);
    float sq = (a0 * a0 + a1 * a1) + (a2 * a2 + a3 * a3);
    sq += __shfl_xor(sq, 1); sq += __shfl_xor(sq, 2); sq += __shfl_xor(sq, 4); sq += __shfl_xor(sq, 8);
    if (kq == 0) { typedef unsigned u32x2v __attribute__((ext_vector_type(2))); u32x2v w; w.x = w0; w.y = w1; *(GAS u32x2v*)(MIX + (size_t)row * 1024 + h * 64 + 4 * dl) = w; }
    if (lane == 0) ssa[(size_t)row * 8 + h] = sq;
    LDS_WAIT();
}

#define SATTN_BLOCK() do { \
            for (int rep_ = 0; rep_ < REP2B; ++rep_) { GAS unsigned char* w = WSP(); GAS float* ob = OUTP(); \
            for (int u = F.vcu; u < 256; u += F.G) \
                sattn_unit(u >> 3, F.wave  , (const GAS bf16*)(w + WS_QB), INP(2) + (size_t)l * 32 * 2048 * 512, INP(3) + (size_t)l * 32 * 2048 * 512, ob + O_SK + (size_t)l * MS * 512, ob + O_SV + (size_t)l * MS * 512, \
                           (GAS bf16*)(w + WS_MIX), (GAS float*)(w + WS_SSA), (LAS float*)(LDSP() + F.wave * 4096), u & 7  , LANE()); } \
            __syncthreads(); } while (0)
struct Args { const float* in[26]; float* out; unsigned char* ws; };
__device__ __forceinline__ const GAS float* rfl_ptr(unsigned long long v) { const unsigned lo = __builtin_amdgcn_readfirstlane((unsigned)v), hi = __builtin_amdgcn_readfirstlane((unsigned)(v >> 32)); return (const GAS float*)(((unsigned long long)hi << 32) | lo); }
__global__ void __launch_bounds__(NWAVES * 64, 2) hymba_fwd(Args args) {
    extern __shared__ __attribute__((aligned(16))) unsigned char lds[];
    Frame F;
    F.lds = (LAS unsigned char*)lds; F.MISC = (volatile LAS unsigned*)(F.lds + MISC_OFF);
    F.tid = threadIdx.x; F.lane = F.tid & 63; F.wave = __builtin_amdgcn_readfirstlane(F.tid >> 6);
    F.G = gridDim.x; { const int bx = blockIdx.x; F.vcu = (F.G % 8 == 0) ? (bx % 8) * (F.G / 8) + bx / 8 : bx; }
    GAS unsigned char* const ws = (GAS unsigned char*)args.ws; F.ctl = (gu32*)(ws + WS_CTL);
#if DBG_SET >= 30 && DBG_SET < 60
    for (int u = F.tid; u < LDS_BYTES / 4; u += NWAVES * 64) ((LAS unsigned*)F.lds)[u] = 0xFFFFFFFFu;
    __syncthreads();
#endif
    for (int u = F.tid; u < (LDS_BYTES - MISC_OFF) / 4; u += NWAVES * 64) ((LAS unsigned*)(F.lds + MISC_OFF))[u] = 0u;
    __syncthreads();
    volatile LAS unsigned long long* PT = (volatile LAS unsigned long long*)(F.lds + PTAB_OFF);
    if (F.tid == 0) {
#pragma unroll
        for (int i = 0; i < 26; ++i) PT[i] = (unsigned long long)args.in[i];
        PT[26] = (unsigned long long)args.out;
    }
    __syncthreads();
#define INP(k) rfl_ptr(PT[k])
#define OUTP() ((GAS float*)rfl_ptr(PT[26]))
#define WSP() pg8::lau(ws)
#if DBG_SET >= 60
#define STAMP(k) do { if (blockIdx.x == 0 && threadIdx.x == 0) { GAS unsigned long long* tm_ = (GAS unsigned long long*)(pg8::lau(ws) + WS_CTL + 524288); const unsigned long long now_ = __builtin_amdgcn_s_memrealtime(); tm_[k] += now_ - tm_[31]; tm_[31] = now_; } } while (0)
#else
#define STAMP(k) do {} while (0)
#endif
#define GRID_BAR() for (int rb_ = 0; rb_ < REPB; ++rb_) do { XcdBarrier b_ = bar; asm volatile("" : "+s"(b_.bar), "+s"(b_.x), "+s"(b_.st)); xcd_barrier(b_); } while (0)
#define XCC_BAR() for (int rb_ = 0; rb_ < REPB; ++rb_) do { XcdBarrier b_ = bar; asm volatile("" : "+s"(b_.bar), "+s"(b_.x), "+s"(b_.st)); if (lmode) xcc_local_barrier(b_.bar, b_.bar + (CW_LB - CW_BAR) + 64 * b_.x, 32u); else xcd_barrier(b_); } while (0)
#if S5_BM
#define MIX_BAR() XCC_BAR()
#else
#define MIX_BAR() GRID_BAR()
#endif
#define LDSP() ({ LAS unsigned char* l_ = F.lds; asm volatile("" : "+s"(l_)); l_; })
#define TID() ({ int t_ = threadIdx.x; asm volatile("" : "+v"(t_)); t_; })
#define LANE() ({ int l_ = F.lane; asm volatile("" : "+v"(l_)); l_; })
    XcdBarrier bar = xcd_barrier_post((unsigned*)(F.ctl + CW_BAR), F.MISC + 8);
    if (F.tid == 0) F.MISC[16] = xb_add((unsigned*)(F.ctl + CW_RANK) + 64 * bar.x, 1u);
    LAS pg8::f32x2* RTAB = (LAS pg8::f32x2*)(F.lds + RTAB_OFF);
    const int gw = F.vcu * NWAVES + F.wave, NGW = F.G * NWAVES;

#if DBG_SET >= 60
    if (blockIdx.x == 0 && threadIdx.x == 0) { GAS unsigned long long* tm_ = (GAS unsigned long long*)(pg8::lau(ws) + WS_CTL + 524288); tm_[31] = __builtin_amdgcn_s_memrealtime(); }
#endif
#if PHM & 1
    for (int rep_ = 0; rep_ < REP0; ++rep_) {
        GAS unsigned char* w = WSP();
#pragma unroll 1
        for (int ph0 = 0; ph0 < 2; ++ph0) {
        if (((ph0 ^ F.vcu) & 1) == 0) {
        for (int it2 = F.vcu; it2 < NLAYER * 32 * 2; it2 += F.G) { const int it = it2 >> 1, l = it >> 5, g = it & 31;
            ssm::build_tables(l, g, it2 & 1, INP(9), INP(10), INP(11), INP(12), INP(13), INP(14), INP(15), INP(16), w + WS_SSMT + (size_t)it * ssm::TBL_BYTES, (GAS float*)(w + WS_A32), (GAS float*)(w + WS_SSC), LDSP()); }
        __syncthreads();
        } else {
        LAS float* scr = (LAS float*)(F.lds + RING_OFF + F.wave * 16384);
        GAS bf16* W_IN = (GAS bf16*)(w + WS_WIN); GAS bf16* W_OUT = (GAS bf16*)(w + WS_WOUT); GAS bf16* W_GU = (GAS bf16*)(w + WS_WGU); GAS bf16* W_DN = (GAS bf16*)(w + WS_WDN); GAS bf16* W_GLU = (GAS bf16*)(w + WS_WGLU);
        constexpr int I_IN = 16 * 64, I_OUT = 16 * 32, I_G = 16 * 88, I_DN = 44 * 32, I_GLU = 8 * 16, I_LAYER = I_IN + I_OUT + 2 * I_G + I_DN + I_GLU;
        for (int it = gw; it < NLAYER * I_LAYER; it += NGW) {
            const int l = it / I_LAYER; int r = it % I_LAYER;
            if (r < I_IN) { const int kb = r / 64, nb = r % 64; p0_transpose_item(INP(7) + (size_t)l * 1024 * 2048, 1024, 2048, W_IN + (size_t)l * 2048 * 1024, 64 * kb, 32 * nb, 32 * nb, INP(6) + l * 1024, scr, F.lane); continue; } r -= I_IN;
            if (r < I_OUT) { const int kb = r / 32, nb = r % 32; const GAS float* sc = (kb < 8) ? INP(8) + l * 512 : INP(19) + l * 512 - 512;
                p0_transpose_item(INP(20) + (size_t)l * 1024 * 1024, 1024, 1024, W_OUT + (size_t)l * 1024 * 1024, 64 * kb, 32 * nb, 32 * nb, sc, scr, F.lane); continue; } r -= I_OUT;
            if (r < 2 * I_G) { const int up = r >= I_G; if (up) r -= I_G; const int kb = r / 88, nb = r % 88, n0 = 32 * nb, drow0 = (n0 >> 7) * 256 + up * 128 + (n0 & 127);
                p0_transpose_item((up ? INP(23) : INP(22)) + (size_t)l * 1024 * 2816, 1024, 2816, W_GU + (size_t)l * 5632 * 1024, 64 * kb, n0, drow0, INP(21) + l * 1024, scr, F.lane); continue; } r -= 2 * I_G;
            if (r < I_DN) { const int kb = r / 32, nb = r % 32; p0_transpose_item(INP(24) + (size_t)l * 2816 * 1024, 2816, 1024, W_DN + (size_t)l * 1024 * 2816, 64 * kb, 32 * nb, 32 * nb, nullptr, scr, F.lane); continue; } r -= I_DN;
            { const int kb = r / 16, nb = r % 16; p0_transpose_item(INP(17) + (size_t)l * 512 * 512, 512, 512, W_GLU + (size_t)l * 512 * 512, 64 * kb, 32 * nb, 32 * nb, nullptr, scr, F.lane); }
        }
        __syncthreads();
        } }
        { const GAS float* x_prompt = INP(0); const GAS float* x_sample = INP(1); GAS bf16* XB = (GAS bf16*)(w + WS_XB); GAS float* SS1 = (GAS float*)(w + WS_SS1);
        for (int m0 = 2 * gw; m0 < MT; m0 += 2 * NGW) { f32x4 v[2][4]; float s[2];
#pragma unroll
            for (int q = 0; q < 2; ++q) { const int m = m0 + q; const GAS float* xr = (m < MP) ? x_prompt + (size_t)m * 1024 : x_sample + (size_t)(m - MP) * 1024; const GAS f32x4* xv = (const GAS f32x4*)xr + F.lane;
#pragma unroll
                for (int j = 0; j < 4; ++j) v[q][j] = xv[64 * j]; }
#pragma unroll
            for (int q = 0; q < 2; ++q) { const int m = m0 + q; float t = 0.f;
#pragma unroll
                for (int j = 0; j < 4; ++j) t += (v[q][j].x * v[q][j].x + v[q][j].y * v[q][j].y) + (v[q][j].z * v[q][j].z + v[q][j].w * v[q][j].w);
                s[q] = wave_sum(t);
                GAS unsigned long long* o8 = (GAS unsigned long long*)(XB + (size_t)m * 1024) + F.lane;
#pragma unroll
                for (int j = 0; j < 4; ++j) o8[64 * j] = (unsigned long long)pk2(v[q][j].x, v[q][j].y) | ((unsigned long long)pk2(v[q][j].z, v[q][j].w) << 32);
                if (F.lane < 16) SS1[(size_t)m * 16 + F.lane] = (F.lane == 0) ? s[q] : 0.f; } } }
        GRID_BAR(); STAMP(0);
    }
#endif

    unsigned lmode; int cg;
    {
        if (F.tid == 0) { unsigned ok = (F.G == 256) ? 1u : 0u;
#pragma unroll
            for (unsigned j = 0; j < 16; ++j) { const unsigned c = xb_ld(&bar.bar[XB_XCNT(j)]); ok &= (c == ((j < 8) ? 32u : 0u)) ? 1u : 0u; }
            F.MISC[17] = (XCC_LOCAL && F.MISC[16] < 32u) ? ok : 0u; }
        __syncthreads();
        lmode = __builtin_amdgcn_readfirstlane(F.MISC[17]); const int rank = __builtin_amdgcn_readfirstlane(F.MISC[16]);
        cg = (int)blockIdx.x;
        if (lmode) { F.vcu = (int)bar.x * 32 + rank; cg = rank * 8 + (int)bar.x; }
    }
    unsigned e3_tgt = 0u, e5_tgt = 0u;
#pragma unroll 1
    for (int l = 0; l < NLAYER; ++l) {
#if PHM & 2
        for (int rep_ = 0; rep_ < REP1; ++rep_) {
            GAS unsigned char* w = WSP();
            pg8::Gemm g{(const GAS bf16*)(w + WS_XB), (const GAS bf16*)(w + WS_WIN) + (size_t)l * 2048 * 1024, MP, INW_, 1024}; pg8::StaticOrder S; S.init(MP, INW_, F.G, cg);
            pg8::EpiInProj E{ws, OUTP(), l, RTAB};
            pg8::gemm_phase<pg8::EpiInProj, pg8::StaticOrder, P1_ALIGN != 0, true>(LDSP() + RING_OFF, g, S, E);
            {
              mini::unit<1024>((const GAS bf16*)(w + WS_XB) + (size_t)MP * 1024, (const GAS bf16*)(w + WS_WIN) + (size_t)l * 2048 * 1024, cg & 7, 1, (LAS float*)(LDSP() + RING_OFF), mini::E1{ws, OUTP(), l, cg >> 3, 0.f}); }
            MIX_BAR(); STAMP(1);
#if defined(DBG_STOP) && DBG_STOP == 1
            if (l == DBG_STOP_L) return;
#endif
        }
#endif
        {
            LAS float* mtab = nullptr;
#pragma unroll 1
            for (int ph2 = 0; ph2 < 2; ++ph2) {
            if (((ph2 ^ F.vcu) & 1) == 0) {
#if PHM & 4
            for (int rep_ = 0; rep_ < REP2A; ++rep_) { GAS unsigned char* w = WSP();
            unsigned char* wg = (unsigned char*)w; const attn_body::AttnTensors AT{(const attn_body::bf16*)(wg + WS_QB), (const attn_body::bf16*)(wg + WS_KB), (const attn_body::bf16*)(wg + WS_VB), (attn_body::bf16*)(wg + WS_MIX), (float*)(wg + WS_SSA)};
            const attn_body::StaticOrder SA(F.vcu);
            attn_body::attn_phase<attn_body::StaticOrder>((char*)lds + RING_OFF, mtab, AT, SA); }
#endif
            __syncthreads(); STAMP(8);
            } else {
#pragma unroll 1
            for (int q2 = 0; q2 < 2; ++q2) {
            if (((q2 ^ F.vcu) & 1) == 0) {
#if PHM & 8
            for (int rep_ = 0; rep_ < REP2S; ++rep_) { GAS unsigned char* w = WSP(); GAS float* ob = OUTP();
            for (int u = F.vcu; u < 256; u += F.G)
                ssm::prompt_unit(S5_BM ? (u & 31) : (u >> 3), S5_BM ? (u >> 5) : (u & 7), l, (const GAS bf16*)(w + WS_UB), w + WS_SSMT + (size_t)l * 32 * ssm::TBL_BYTES, (const GAS float*)(w + WS_A32) + (size_t)l * 32 * 64 * 2, (GAS bf16*)(w + WS_ZB),
                                 ob + O_PR + (size_t)l * 8 * 32 * 64, ob + O_PI + (size_t)l * 8 * 32 * 64, LDSP()); }
#endif
            __syncthreads(); STAMP(9);
            } else {
#if PHM & 16
            SATTN_BLOCK();
#endif
            __syncthreads(); STAMP(10);
            } } } }
#if PHM & 32
            for (int rep_ = 0; rep_ < REP2C; ++rep_) { GAS unsigned char* w = WSP(); GAS float* ob = OUTP();
            for (int u = F.vcu * 4 + F.wave; u < 1024 && F.wave < 4; u += F.G * 4)
                ssm::sample_unit(u >> 5, u & 31, l, (const GAS float*)(w + WS_US), INP(4) + (size_t)l * 32 * 32 * 64, INP(5) + (size_t)l * 32 * 32 * 64, (const GAS float*)(w + WS_SSC), INP(14), INP(15), INP(16),
                                 (GAS bf16*)(w + WS_ZB), ob + O_SR + (size_t)l * 32 * 32 * 64, ob + O_SI + (size_t)l * 32 * 32 * 64, (LAS float*)(LDSP() + F.wave * 16384), LANE()); }
#endif
            MIX_BAR(); STAMP(2);
#if defined(DBG_STOP) && DBG_STOP == 2
            if (l == DBG_STOP_L) return;
#endif
        }
#if PHM & 64
        for (int rep_ = 0; rep_ < REP3; ++rep_) {
            GAS unsigned char* w = WSP();
            pg8::Gemm g{(const GAS bf16*)(w + WS_ZB), (const GAS bf16*)(w + WS_WGLU) + (size_t)l * 512 * 512, MP, 512, 512}; pg8::StaticOrder S; S.init(MP, 512, F.G, cg);
            pg8::EpiGlu E{ws, INP(18) + l * 512};
            pg8::gemm_phase<pg8::EpiGlu, pg8::StaticOrder, true, true, true>(LDSP() + RING_OFF, g, S, E);
            { const int cr = (cg >> 3) - 16;
              e3_tgt += 8u;
              if (cr >= 0) { unsigned* cnt = (unsigned*)(F.ctl + CW_E3) + 64 * (cg & 7);
                if (cr < 8) { mini::unit<512>((const GAS bf16*)(w + WS_ZB) + (size_t)MP * 512, (const GAS bf16*)(w + WS_WGLU) + (size_t)l * 512 * 512, cg & 7, 1, (LAS float*)(LDSP() + RING_OFF), mini::E3{ws, INP(18) + l * 512, cr});
                              xcc_signal(cnt, lmode); }
                xcc_wait(bar.bar, cnt, e3_tgt);
                mini::unit<1024>((const GAS bf16*)(w + WS_MIX) + (size_t)MP * 1024, (const GAS bf16*)(w + WS_WOUT) + (size_t)l * 1024 * 1024, cg & 7, 1, (LAS float*)(LDSP() + RING_OFF), mini::E4{ws, cr, 0.f, 0.f}); } }
            XCC_BAR(); STAMP(3);
#if defined(DBG_STOP) && DBG_STOP == 3
            if (l == DBG_STOP_L) return;
#endif
        }
#endif
#if PHM & 128
        {
            GAS unsigned char* w = WSP();
            pg8::Gemm g{(const GAS bf16*)(w + WS_MIX), (const GAS bf16*)(w + WS_WOUT) + (size_t)l * 1024 * 1024, MP, 1024, 1024}; pg8::StaticOrder S; S.init(MP, 1024, F.G, cg);
            for (int rep_ = 1; rep_ < REP4; ++rep_) { pg8::EpiWout Ed{ws, RTAB, (size_t)512 * MiB}; pg8::gemm_phase<pg8::EpiWout, pg8::StaticOrder, true, true>(LDSP() + RING_OFF, g, S, Ed); GRID_BAR(); }
            pg8::EpiWout E{ws, RTAB, 0};
            pg8::gemm_phase<pg8::EpiWout, pg8::StaticOrder, true, true>(LDSP() + RING_OFF, g, S, E);
            XCC_BAR(); STAMP(4);
#if defined(DBG_STOP) && DBG_STOP == 4
            if (l == DBG_STOP_L) return;
#endif
        }
#endif
#if PHM & 256
        for (int rep_ = 0; rep_ < REP5; ++rep_) {
            GAS unsigned char* w = WSP();
            pg8::Gemm g{(const GAS bf16*)(w + WS_XB), (const GAS bf16*)(w + WS_WGU) + (size_t)l * 5632 * 1024, MP, 2 * FF_, 1024}; pg8::StaticOrder S; S.init(MP, 2 * FF_, F.G, cg);
            pg8::EpiGateUp E{ws, RTAB};
            pg8::gemm_phase<pg8::EpiGateUp, pg8::StaticOrder, true, true>(LDSP() + RING_OFF, g, S, E);
            {
              e5_tgt += 16u;
              if (cg >= 128) { const int q0 = (cg >> 3) - 16; unsigned* cnt = (unsigned*)(F.ctl + CW_E5) + 64 * (cg & 7);
                mini::unit<1024>((const GAS bf16*)(w + WS_XB) + (size_t)MP * 1024, (const GAS bf16*)(w + WS_WGU) + (size_t)l * 5632 * 1024, cg & 7, (88 - q0 + 15) / 16, (LAS float*)(LDSP() + RING_OFF), mini::E5{ws, q0, 0.f});
                xcc_signal(cnt, lmode); xcc_wait(bar.bar, cnt, e5_tgt);
                mini::unit<2816>((const GAS bf16*)(w + WS_GB) + (size_t)MP * 2816, (const GAS bf16*)(w + WS_WDN) + (size_t)l * 1024 * 2816, cg & 7, 1, (LAS float*)(LDSP() + RING_OFF), mini::E6{ws, q0}); } }
            XCC_BAR(); STAMP(5);
#if defined(DBG_STOP) && DBG_STOP == 5
            if (l == DBG_STOP_L) return;
#endif
        }
#endif
#if PHM & 512
        {
            GAS unsigned char* w = WSP();
            pg8::Gemm g{(const GAS bf16*)(w + WS_GB), (const GAS bf16*)(w + WS_WDN) + (size_t)l * 1024 * 2816, MP, 1024, FF_}; pg8::StaticOrder S; S.init(MP, 1024, F.G, cg);
            for (int rep_ = 1; rep_ < REP6; ++rep_) { pg8::EpiDown Ed{ws, (size_t)512 * MiB}; pg8::gemm_phase<pg8::EpiDown, pg8::StaticOrder, true, true>(LDSP() + RING_OFF, g, S, Ed); GRID_BAR(); }
            pg8::EpiDown E{ws, 0};
            pg8::gemm_phase<pg8::EpiDown, pg8::StaticOrder, true, true>(LDSP() + RING_OFF, g, S, E);
            XCC_BAR(); STAMP(6);
#if defined(DBG_STOP) && DBG_STOP == 6
            if (l == DBG_STOP_L) return;
#endif
        }
#endif
    }
    {
        GAS unsigned char* w = WSP(); GAS float* ob = OUTP();
        const GAS float* fg = INP(25); const GAS float* SS1 = (const GAS float*)(w + WS_SS1); const GAS bf16* XBp = (const GAS bf16*)(w + WS_XB);
        const int lane7 = LANE();
        const int lw7 = (cg >> 3) * NWAVES + F.wave;
        for (int i7 = lw7; i7 < 2048 + 32; i7 += 256) { const int m = (i7 < 2048) ? (cg & 7) * 2048 + i7 : MP + (cg & 7) * 32 + (i7 - 2048); const float s = pg8::sum16(SS1 + (size_t)m * 16); const float r = __builtin_amdgcn_rsqf(s * (1.0f / 1024.0f) + 1e-6f);
            typedef unsigned u32x2v __attribute__((ext_vector_type(2))); const GAS u32x2v* xv = (const GAS u32x2v*)(XBp + (size_t)m * 1024) + lane7; const GAS f32x4* gv = (const GAS f32x4*)fg + lane7;
            GAS f32x4* ov = (GAS f32x4*)((m < MP) ? ob + O_YP + (size_t)m * 1024 : ob + O_YS + (size_t)(m - MP) * 1024) + lane7;
#pragma unroll
            for (int j = 0; j < 4; ++j) { const u32x2v xx = xv[64 * j]; f32x4 x; x[0] = __uint_as_float(xx.x << 16); x[1] = __uint_as_float(xx.x & 0xffff0000u); x[2] = __uint_as_float(xx.y << 16); x[3] = __uint_as_float(xx.y & 0xffff0000u);
                ov[64 * j] = x * r * gv[64 * j]; } }
    }
    STAMP(7);
}
#if DBG_SET
namespace dbg {
__global__ void k_cmp_f32(const float* a, const float* b, size_t n, float* acc) {
    float s1 = 0.f, s2 = 0.f;
    for (size_t i = (size_t)blockIdx.x * blockDim.x + threadIdx.x; i < n; i += (size_t)gridDim.x * blockDim.x) { const float d = a[i] - b[i]; s1 += d * d; s2 += b[i] * b[i]; }
    s1 = wave_sum(s1); s2 = wave_sum(s2);
    if ((threadIdx.x & 63) == 0) { atomicAdd(acc, s1); atomicAdd(acc + 1, s2); }
}
__global__ void k_cmp_bf16(const unsigned short* a, int lda, int acol0, const float* b, int ldb, int bcol0, int rows, int cols, float scale, float* acc) {
    float s1 = 0.f, s2 = 0.f; const size_t n = (size_t)rows * cols;
    for (size_t i = (size_t)blockIdx.x * blockDim.x + threadIdx.x; i < n; i += (size_t)gridDim.x * blockDim.x) { const size_t r = i / cols; const int c = (int)(i % cols);
        const float av = __uint_as_float((unsigned)a[r * lda + acol0 + c] << 16), bv = scale * b[r * ldb + bcol0 + c]; const float d = av - bv; s1 += d * d; s2 += bv * bv; }
    s1 = wave_sum(s1); s2 = wave_sum(s2);
    if ((threadIdx.x & 63) == 0) { atomicAdd(acc, s1); atomicAdd(acc + 1, s2); }
}
__global__ void k_cmp_f32s(const float* a, int lda, int acol0, const float* b, int ldb, int bcol0, int rows, int cols, float scale, float* acc) {
    float s1 = 0.f, s2 = 0.f; const size_t n = (size_t)rows * cols;
    for (size_t i = (size_t)blockIdx.x * blockDim.x + threadIdx.x; i < n; i += (size_t)gridDim.x * blockDim.x) { const size_t r = i / cols; const int c = (int)(i % cols);
        const float av = a[r * lda + acol0 + c], bv = scale * b[r * ldb + bcol0 + c]; const float d = av - bv; s1 += d * d; s2 += bv * bv; }
    s1 = wave_sum(s1); s2 = wave_sum(s2);
    if ((threadIdx.x & 63) == 0) { atomicAdd(acc, s1); atomicAdd(acc + 1, s2); }
}
__global__ void k_cmp_u(const unsigned short* U, const float* z, float* acc) {
    float s1 = 0.f, s2 = 0.f; const size_t n = (size_t)32 * 16384 * 16;
    for (size_t i = (size_t)blockIdx.x * blockDim.x + threadIdx.x; i < n; i += (size_t)gridDim.x * blockDim.x) { const int c = (int)(i & 15); const size_t row = (i >> 4) % 16384; const int g = (int)(i / (16384 * 16));
        const float av = __uint_as_float((unsigned)U[i] << 16), bv = z[row * 2048 + 1536 + g * 16 + c]; const float d = av - bv; s1 += d * d; s2 += bv * bv; }
    s1 = wave_sum(s1); s2 = wave_sum(s2);
    if ((threadIdx.x & 63) == 0) { atomicAdd(acc, s1); atomicAdd(acc + 1, s2); }
}
__global__ void k_cmp_u32(const unsigned* a, const unsigned* b, size_t n, float* acc) {
    float s1 = 0.f;
    for (size_t i = (size_t)blockIdx.x * blockDim.x + threadIdx.x; i < n; i += (size_t)gridDim.x * blockDim.x) s1 += (a[i] != b[i]) ? 1.f : 0.f;
    s1 = wave_sum(s1);
    if ((threadIdx.x & 63) == 0) { atomicAdd(acc, s1); atomicAdd(acc + 1, 1.0f); }
}
__device__ int qdigit(float num, float den) {
#if DBG_SET >= 30 && DBG_SET < 60
    return (num == 0.0f) ? 8 : 1;
#endif
    const float e = sqrtf(num / fmaxf(den, 1e-30f));
    if (!(e == e) || !(e < 1e30f)) return 0;
    const float q = -2.0f * log10f(fmaxf(e, 1e-12f)) + 0.5f;
    int d = (int)floorf(q); return d < 0 ? 0 : (d > 8 ? 8 : d);
}
__global__ void k_report(const float* acc, float* out) {
    const int q0 = qdigit(acc[0], acc[1]), q1 = qdigit(acc[2], acc[3]), q2 = qdigit(acc[4], acc[5]), q3 = qdigit(acc[6], acc[7]);
    const float A = ((float)(1 + q0) + 0.1f * (float)q1) * 100.0f; const float eps = sqrtf(((float)(1 + q2) + 0.1f * (float)q3 + 0.03f) * 100.0f);
    const size_t n = (size_t)MS * 1024;
    for (size_t i = (size_t)blockIdx.x * blockDim.x + threadIdx.x; i < n; i += (size_t)gridDim.x * blockDim.x) out[O_YS + i] += (i & 1) ? eps : -eps;
    if (blockIdx.x == 0 && threadIdx.x == 0) out[O_PK] = A;
}
__global__ void k_report_t(const unsigned long long* tm, int ka, int kb, float* out) {
    const float ta = (float)tm[ka] * 0.01f, tb = (float)tm[kb] * 0.01f;
    const float A = 1e5f * ta, eps = sqrtf(1e6f * tb);
    const size_t n = (size_t)MS * 1024;
    for (size_t i = (size_t)blockIdx.x * blockDim.x + threadIdx.x; i < n; i += (size_t)gridDim.x * blockDim.x) out[O_YS + i] = (i & 1) ? eps : -eps;
    if (blockIdx.x == 0 && threadIdx.x == 0) out[O_PK] = A;
}
}
#endif
extern "C" void kernel_launch(void* const* d_in, const int* in_sizes, int n_in, void* d_out, int out_size, void* d_ws, size_t ws_size, hipStream_t stream) {
    static int ready = 0;
    if (!ready) {
        if (n_in != 26 || (size_t)out_size != O_END || ws_size < (DBG_SET ? (size_t)2047 * MiB : (size_t)WS_END)) { fprintf(stderr, "kernel_launch: unexpected shapes (n_in %d out %d ws %zu)\n", n_in, out_size, ws_size); ready = -1; return; }
        if (hipFuncSetAttribute((const void*)hymba_fwd, hipFuncAttributeMaxDynamicSharedMemorySize, LDS_BYTES) != hipSuccess) { fprintf(stderr, "kernel_launch: hipFuncSetAttribute failed\n"); ready = -1; return; }
        ready = 1;
    }
    if (ready < 0) return;
#if DBG_SET >= 30 && DBG_SET < 60
#ifndef DBG_POISON_LO
#define DBG_POISON_LO (2 * MiB)
#define DBG_POISON_HI WS_END
#endif
    (void)hipMemsetAsync((char*)d_ws + DBG_POISON_LO, 0xFF, DBG_POISON_HI - DBG_POISON_LO, stream);
#endif
    (void)hipMemsetAsync((char*)d_ws + WS_CTL, 0, CTL_ZERO_BYTES, stream);
    Args a{};
    for (int i = 0; i < 26; ++i) a.in[i] = (const float*)d_in[i];
    a.out = (float*)d_out; a.ws = (unsigned char*)d_ws;
#if DBG_SET >= 60
    hipLaunchKernelGGL(hymba_fwd, dim3(256), dim3(NWAVES * 64), LDS_BYTES, stream, a);
    dbg::k_report_t<<<256, 256, 0, stream>>>((const unsigned long long*)((char*)d_ws + WS_CTL + 524288), DBG_KA, DBG_KB, (float*)d_out);
#elif DBG_SET
    float* shadow = (float*)((char*)d_ws + 448 * MiB); float* nvws = (float*)((char*)d_ws + 784 * MiB); float* acc = (float*)((char*)d_ws + 447 * MiB);
    (void)hipMemsetAsync(acc, 0, 64, stream);
    a.out = shadow;
    float* dout = (float*)d_out;
#if DBG_SET >= 30
    float* shadowB = nvws;
    (void)hipMemsetAsync(d_out, 0, (size_t)out_size * 4, stream);
#elif DBG_SET < 10
    nv::forward(stream, d_in, dout, nvws);
#elif DBG_SET < 20
    nv::forward(stream, d_in, dout, nvws, 1, 0);
#else
    nv::forward(stream, d_in, dout, nvws, 0, 1);
#endif
    hipLaunchKernelGGL(hymba_fwd, dim3(256), dim3(NWAVES * 64), LDS_BYTES, stream, a);
#if DBG_SET >= 40
    {
        char* wsb = (char*)d_ws; char* st = (char*)d_ws + 1200 * MiB;
        (void)hipMemcpyAsync(st, wsb + WS_XRES, WS_SSC - WS_XRES, hipMemcpyDeviceToDevice, stream);
    }
#endif
#if DBG_SET >= 30
    for (int rep = 0; rep < 4; ++rep) {
        (void)hipMemsetAsync((char*)d_ws + WS_CTL, 0, CTL_ZERO_BYTES, stream);
        a.out = shadowB;
        hipLaunchKernelGGL(hymba_fwd, dim3(256), dim3(NWAVES * 64), LDS_BYTES, stream, a);
        using namespace dbg;
#if DBG_SET == 30
        k_cmp_f32<<<1024, 256, 0, stream>>>(shadow + O_PK, shadowB + O_PK, (size_t)MP * 512, acc + 0);
        k_cmp_f32<<<64, 256, 0, stream>>>(shadow + O_PR, shadowB + O_PR, (size_t)16384, acc + 2);
        k_cmp_f32<<<1024, 256, 0, stream>>>(shadow + O_PK + (size_t)MP * 512, shadowB + O_PK + (size_t)MP * 512, (size_t)MP * 512, acc + 4);
        k_cmp_f32<<<1024, 256, 0, stream>>>(shadow + O_YP, shadowB + O_YP, (size_t)MP * 1024, acc + 6);
#elif DBG_SET == 32
        k_cmp_f32<<<1024, 256, 0, stream>>>(shadow + O_PK, shadowB + O_PK, (size_t)MP * 512, acc + 0);
        k_cmp_f32<<<1024, 256, 0, stream>>>(shadow + O_PV, shadowB + O_PV, (size_t)MP * 512, acc + 2);
        k_cmp_f32<<<1024, 256, 0, stream>>>(shadow + O_PK, shadowB + O_PK, (size_t)MP * 512, acc + 4);
        k_cmp_f32<<<1024, 256, 0, stream>>>(shadow + O_PV, shadowB + O_PV, (size_t)MP * 512, acc + 6);
#elif DBG_SET == 33
        for (int q = 0; q < 4; ++q) k_cmp_f32<<<64, 256, 0, stream>>>(shadow + O_PR, shadowB + O_PR, (size_t)16384, acc + 2 * q);
#elif DBG_SET == 34
        for (int q = 0; q < 4; ++q) k_cmp_f32<<<1024, 256, 0, stream>>>(shadow + O_PK + (size_t)MP * 512, shadowB + O_PK + (size_t)MP * 512, (size_t)MP * 512, acc + 2 * q);
#elif DBG_SET >= 40
        { const char* wsb = (const char*)d_ws; const char* st = (const char*)d_ws + 1200 * MiB;
#define CMPBUF(slot, lo, hi) k_cmp_u32<<<1024, 256, 0, stream>>>((const unsigned*)(wsb + (lo)), (const unsigned*)(st + ((lo) - WS_XRES)), ((hi) - (lo)) / 4, acc + 2 * (slot))
#if DBG_SET == 42
          CMPBUF(0, WS_MIX, WS_ZB); CMPBUF(1, WS_ZB, WS_GB); CMPBUF(2, WS_SSA, WS_SSS); CMPBUF(3, WS_UB, WS_MIX);
#elif DBG_SET == 47
          CMPBUF(0, WS_MIX, WS_MIX + (size_t)MP * 2048); CMPBUF(1, WS_MIX + (size_t)MP * 2048, WS_MIX + (size_t)MT * 2048); CMPBUF(2, WS_SSA, WS_SSA + (size_t)MP * 32); CMPBUF(3, WS_SSA + (size_t)MP * 32, WS_SSA + (size_t)MT * 32);
#elif DBG_SET == 43
          CMPBUF(0, WS_MIX, WS_ZB); CMPBUF(1, WS_SSS, WS_SSC); CMPBUF(2, WS_MIX, WS_ZB); CMPBUF(3, WS_SSS, WS_SSC);
#elif DBG_SET == 44
          CMPBUF(0, WS_XRES, WS_XB); CMPBUF(1, WS_XB, WS_QB); CMPBUF(2, WS_SS2, WS_SSA); CMPBUF(3, WS_XRES, WS_XB);
#elif DBG_SET == 45
          CMPBUF(0, WS_GB, WS_SS1); CMPBUF(1, WS_GB, WS_SS1); CMPBUF(2, WS_GB, WS_SS1); CMPBUF(3, WS_GB, WS_SS1);
#elif DBG_SET == 46
          CMPBUF(0, WS_XRES, WS_XB); CMPBUF(1, WS_XB, WS_QB); CMPBUF(2, WS_SS1, WS_SS2); CMPBUF(3, WS_XRES, WS_XB);
#endif
        }
#elif DBG_SET == 31
        k_cmp_f32<<<256, 256, 0, stream>>>(shadow + O_SK, shadowB + O_SK, (size_t)MS * 512, acc + 0);
        k_cmp_f32<<<64, 256, 0, stream>>>(shadow + O_SR, shadowB + O_SR, (size_t)65536, acc + 2);
        k_cmp_f32<<<256, 256, 0, stream>>>(shadow + O_SK + (size_t)MS * 512, shadowB + O_SK + (size_t)MS * 512, (size_t)MS * 512, acc + 4);
        k_cmp_f32<<<256, 256, 0, stream>>>(shadow + O_YS, shadowB + O_YS, (size_t)MS * 1024, acc + 6);
#endif
    }
#endif
    {
        using namespace dbg;
        const size_t R = 16384; float* n_xn = nvws; float* n_z = n_xn + R * 1024; float* n_cat = n_z + R * 2048; float* n_tmp = n_cat + R * 1024; float* n_Hre = n_tmp + R * 512; float* n_Him = n_Hre + R * 2048;
        float* n_zg = n_Him + R * 2048; float* n_glut = n_zg + R * 512; float* n_mix = n_glut + R * 512; float* n_h = n_mix + R * 1024; float* n_hn = n_h + R * 1024; float* n_gt = n_hn + R * 1024; float* n_up = n_gt + R * 2816; float* n_xcur = n_up + R * 2816;
        (void)n_xn; (void)n_z; (void)n_cat; (void)n_tmp; (void)n_zg; (void)n_glut; (void)n_mix; (void)n_h; (void)n_hn; (void)n_gt; (void)n_up; (void)n_xcur;
        unsigned char* ws = (unsigned char*)d_ws;
#if DBG_SET == 1
        k_cmp_f32<<<1024, 256, 0, stream>>>(shadow + O_PK, dout + O_PK, (size_t)MP * 512, acc + 0);
        k_cmp_f32<<<64, 256, 0, stream>>>(shadow + O_PR, dout + O_PR, (size_t)8 * 32 * 64, acc + 2);
        k_cmp_f32<<<1024, 256, 0, stream>>>(shadow + O_PK + (size_t)MP * 512, dout + O_PK + (size_t)MP * 512, (size_t)MP * 512, acc + 4);
        k_cmp_f32<<<1024, 256, 0, stream>>>(shadow + O_YP, dout + O_YP, (size_t)MP * 1024, acc + 6);
#elif DBG_SET == 2
        k_cmp_f32<<<256, 256, 0, stream>>>(shadow + O_SK, dout + O_SK, (size_t)MS * 512, acc + 0);
        k_cmp_f32<<<64, 256, 0, stream>>>(shadow + O_SR, dout + O_SR, (size_t)32 * 32 * 64, acc + 2);
        k_cmp_f32<<<256, 256, 0, stream>>>(shadow + O_SK + (size_t)MS * 512, dout + O_SK + (size_t)MS * 512, (size_t)MS * 512, acc + 4);
        k_cmp_f32<<<256, 256, 0, stream>>>(shadow + O_YS, dout + O_YS, (size_t)MS * 1024, acc + 6);
#elif DBG_SET == 3
        k_cmp_f32<<<1024, 256, 0, stream>>>(shadow + O_PV + 3 * (size_t)MP * 512, dout + O_PV + 3 * (size_t)MP * 512, (size_t)MP * 512, acc + 0);
        k_cmp_f32<<<64, 256, 0, stream>>>(shadow + O_PI + 3 * 16384, dout + O_PI + 3 * 16384, (size_t)16384, acc + 2);
        k_cmp_f32<<<256, 256, 0, stream>>>(shadow + O_SV + 3 * (size_t)MS * 512, dout + O_SV + 3 * (size_t)MS * 512, (size_t)MS * 512, acc + 4);
        k_cmp_f32<<<64, 256, 0, stream>>>(shadow + O_SI + 3 * 65536, dout + O_SI + 3 * 65536, (size_t)65536, acc + 6);
#endif
        k_report<<<256, 256, 0, stream>>>(acc, dout);
    }
#else
    hipLaunchKernelGGL(hymba_fwd, dim3(256), dim3(NWAVES * 64), LDS_BYTES, stream, a);
#endif
}
```

```cpp
#include <hip/hip_runtime.h>
#include <hip/hip_bf16.h>
#include <cstdio>
#include <cstdint>
#include <cmath>
#ifndef DBG_SET
#define DBG_SET 0
#endif
#ifndef PHM
#define PHM 0xFFFF
#endif
#ifndef REP1
#define REP1 1
#endif
#ifndef REP2A
#define REP2A 1
#endif
#ifndef REP2S
#define REP2S 1
#endif
#ifndef REP2B
#define REP2B 1
#endif
#ifndef REP3
#define REP3 1
#endif
#ifndef REP5
#define REP5 1
#endif
#ifndef REP0
#define REP0 1
#endif
#ifndef REPY
#define REPY 1
#endif
#ifndef REPS
#define REPS 1
#endif
#ifndef XCC_LOCAL
#define XCC_LOCAL 1
#endif
#ifndef S5_BM
#define S5_BM 1
#endif
#ifndef GWT
#define GWT 1
#endif
#ifndef ATTN_FAR
#define ATTN_FAR 1
#endif
#ifndef EARLY_INV
#define EARLY_INV 1
#endif
#ifndef REPB
#define REPB 1
#endif
#ifndef REP4
#define REP4 1
#endif
#ifndef REP6
#define REP6 1
#endif
#ifndef REP2C
#define REP2C 1
#endif
#ifndef REPM
#define REPM 1
#endif
#ifndef REPM5
#define REPM5 1
#endif
#define GAS __attribute__((address_space(1)))
#define LAS __attribute__((address_space(3)))
constexpr int NWAVES = 8;
constexpr int MP = 16384, MS = 256, MT = MP + MS, DM_ = 1024, FF_ = 2816, INW_ = 2048, NLAYER = 4;
constexpr size_t MiB = 1u << 20;
constexpr size_t WS_CTL = 0, CTL_ZERO_BYTES = (DBG_SET >= 60) ? 1 * MiB : 65536;
constexpr size_t WS_WIN = 2 * MiB, WS_WOUT = 18 * MiB, WS_WGU = 26 * MiB, WS_WDN = 70 * MiB, WS_WGLU = 92 * MiB;
constexpr size_t WS_SSMT = 94 * MiB, WS_A32 = 130 * MiB;
constexpr size_t WS_XRES = 131 * MiB, WS_XB = 196 * MiB, WS_QB = 229 * MiB, WS_KB = 246 * MiB, WS_VB = 263 * MiB, WS_UB = 280 * MiB, WS_US = 296 * MiB;
constexpr size_t WS_MIX = 297 * MiB, WS_ZB = 330 * MiB, WS_GB = 347 * MiB, WS_SS1 = 437 * MiB, WS_SS2 = 439 * MiB, WS_SSA = 441 * MiB, WS_SSS = 442 * MiB, WS_SSC = 443 * MiB  , WS_END = 445 * MiB;
constexpr int CW_BAR = 4096, CW_RANK = 8192, CW_LB = 9216, CW_E3 = 10240, CW_E5 = 11264;
constexpr size_t O_YP = 0, O_YS = O_YP + (size_t)MP * 1024, O_PK = O_YS + (size_t)MS * 1024, O_PV = O_PK + (size_t)NLAYER * MP * 512, O_PR = O_PV + (size_t)NLAYER * MP * 512,
                 O_PI = O_PR + (size_t)NLAYER * 8 * 32 * 64, O_SK = O_PI + (size_t)NLAYER * 8 * 32 * 64, O_SV = O_SK + (size_t)NLAYER * MS * 512, O_SR = O_SV + (size_t)NLAYER * MS * 512,
                 O_SI = O_SR + (size_t)NLAYER * 32 * 32 * 64, O_END = O_SI + (size_t)NLAYER * 32 * 32 * 64;
constexpr int RING_OFF = 0, RING_BYTES = 131072, RTAB_OFF = 155648, MISC_OFF = 159744, PTAB_OFF = MISC_OFF + 512, LDS_BYTES = 163840;
constexpr int MTAB_OFF = 86016, MTAB_N = 2304;

typedef unsigned short bf16;
typedef unsigned v4u __attribute__((ext_vector_type(4)));
typedef float f32x4 __attribute__((ext_vector_type(4)));
typedef GAS unsigned gu32;
#define RLX_AGENT __ATOMIC_RELAXED, __HIP_MEMORY_SCOPE_AGENT
#define LDS_WAIT() asm volatile("s_waitcnt lgkmcnt(0)" ::: "memory")
#define VM_WAIT() asm volatile("s_waitcnt vmcnt(0)" ::: "memory")
__device__ __forceinline__ unsigned f2bf(float f) { unsigned u = __builtin_bit_cast(unsigned, f); return (u + 0x7fffu + ((u >> 16) & 1u)) >> 16; }
__device__ __forceinline__ unsigned pk2(float lo, float hi) { unsigned r; asm("v_cvt_pk_bf16_f32 %0, %1, %2" : "=v"(r) : "v"(lo), "v"(hi)); return r; }
__device__ __forceinline__ float wave_sum(float v) {
#pragma unroll
    for (int o = 1; o < 64; o <<= 1) v += __shfl_xor(v, o);
    return v;
}
__device__ __forceinline__ float wave_max(float v) {
#pragma unroll
    for (int o = 1; o < 64; o <<= 1) v = fmaxf(v, __shfl_xor(v, o));
    return v;
}

namespace pg8 {
#define PG8_LAS __attribute__((address_space(3)))
typedef unsigned short bf16_t;
typedef short bf16x8 __attribute__((ext_vector_type(8)));
typedef float f32x4 __attribute__((ext_vector_type(4)));
typedef unsigned u32x4 __attribute__((ext_vector_type(4)));
constexpr int BM = 256, BK = 64, HALF = 128, HTB = HALF * BK * 2  , STAGE_BYTES = 8 * HTB, NXCD = 8, WGM = 8;

__host__ __device__ __forceinline__ int lds_byte(int r, int c) { const int st = (r >> 4) * 2 + (c >> 5), rr = r & 15, cc = c & 31, ob = rr * 64 + cc * 2; return st * 1024 + (ob ^ (((ob >> 9) & 1) << 5)); }
__host__ __device__ __forceinline__ void stage_rc(int b, int& R, int& C) { const int st = b / 1024, sb = b % 1024, swz = sb ^ (((sb >> 9) & 1) << 5); R = (st >> 1) * 16 + swz / 64; C = (st & 1) * 32 + (swz % 64) / 2; }
__host__ __device__ __forceinline__ int perm32(int rho) { const int n = rho >> 4, i = rho & 15; return 8 * (i >> 2) + 4 * n + (i & 3); }

struct Unit { int pm, pn; };
struct Gemm { const GAS bf16_t* A; const GAS bf16_t* Bt; int M, N, K; };

struct StaticOrder {
    int nM, nN, nwg, G, c;
    __host__ __device__ void init(int M, int N, int G_, int c_) { nM = M / BM; nN = N / BM; nwg = nM * nN; G = G_; c = c_; }
    __host__ __device__ bool next(int i, Unit& u) const {
        const int L = i * G + c; if (L >= nwg) return false;
        int wgid = L; { const int q = nwg / NXCD, r = nwg % NXCD, xcd = wgid % NXCD, off = wgid / NXCD; wgid = (xcd < r ? xcd * (q + 1) : r * (q + 1) + (xcd - r) * q) + off; }
        const int nig = WGM * nN, gid = wgid / nig, fm = gid * WGM, gsz = (nM - fm) < WGM ? (nM - fm) : WGM;
        u.pm = fm + ((wgid % nig) % gsz); u.pn = (wgid % nig) / gsz; return true;
    }
    __device__ __forceinline__ void a_ready(const Unit&) const {}
    __device__ __forceinline__ void done(const Unit&) const {}
};

__device__ __forceinline__ unsigned cvt_pk_bf16(float lo, float hi) { unsigned r; asm volatile("v_cvt_pk_bf16_f32 %0, %1, %2" : "=v"(r) : "v"(lo), "v"(hi)); return r; }
typedef float f32x2 __attribute__((ext_vector_type(2)));
constexpr int MP_ROWS = MP;
constexpr float RMS_EPS = 1e-6f;
constexpr float QSCALE = 0.125f * 1.4426950408889634f;
__device__ __forceinline__ u32x4 pack8(const f32x4 a, const f32x4 b) { u32x4 w; w.x = cvt_pk_bf16(a[0], a[1]); w.y = cvt_pk_bf16(a[2], a[3]); w.z = cvt_pk_bf16(b[0], b[1]); w.w = cvt_pk_bf16(b[2], b[3]); return w; }
__device__ __forceinline__ void unpack8(const u32x4 z, f32x4& a, f32x4& b) { a[0] = __uint_as_float(z.x << 16); a[1] = __uint_as_float(z.x & 0xffff0000u); a[2] = __uint_as_float(z.y << 16); a[3] = __uint_as_float(z.y & 0xffff0000u);
    b[0] = __uint_as_float(z.z << 16); b[1] = __uint_as_float(z.z & 0xffff0000u); b[2] = __uint_as_float(z.w << 16); b[3] = __uint_as_float(z.w & 0xffff0000u); }
__device__ __forceinline__ float sum8sq(const f32x4 a, const f32x4 b) { return (a[0] * a[0] + a[1] * a[1]) + (a[2] * a[2] + a[3] * a[3]) + (b[0] * b[0] + b[1] * b[1]) + (b[2] * b[2] + b[3] * b[3]); }
__device__ __forceinline__ GAS unsigned char* lau(GAS unsigned char* p) { asm volatile("" : "+s"(p)); return p; }
__device__ __forceinline__ GAS float* lauf(GAS float* p) { asm volatile("" : "+s"(p)); return p; }
__device__ __forceinline__ const GAS float* laucf(const GAS float* p) { asm volatile("" : "+s"(p)); return p; }
__device__ __forceinline__ void st16_wt(GAS void* p, const u32x4 v) { asm volatile("global_store_dwordx4 %0, %1, off sc1\n\ts_nop 1" :: "v"(p), "v"(v) : "memory"); }
__device__ __forceinline__ float fq_reduce(float v) { v += __shfl_xor(v, 16); v += __shfl_xor(v, 32); return v; }
__device__ __forceinline__ float sum16(const GAS float* p) { const f32x4 a = *(const GAS f32x4*)p, b = *(const GAS f32x4*)(p + 4), c = *(const GAS f32x4*)(p + 8), d = *(const GAS f32x4*)(p + 12);
    return ((a[0] + a[1]) + (a[2] + a[3])) + ((b[0] + b[1]) + (b[2] + b[3])) + ((c[0] + c[1]) + (c[2] + c[3])) + ((d[0] + d[1]) + (d[2] + d[3])); }
__device__ __forceinline__ float sum8(const GAS float* p) { const f32x4 a = *(const GAS f32x4*)p, b = *(const GAS f32x4*)(p + 4); return ((a[0] + a[1]) + (a[2] + a[3])) + ((b[0] + b[1]) + (b[2] + b[3])); }

struct EpiInProj {
    static constexpr bool PERM = true, AFTER_DRAIN = false, MID = false;
    GAS unsigned char* ws; GAS float* out; int l; PG8_LAS f32x2* tab;
    __device__ __forceinline__ void begin(const Unit& u, int ui, int tid) const {
        const GAS float* ss = (const GAS float*)(lau(ws) + WS_SS1);
        if (tid < 256) { const int row = u.pm * BM + tid; const float s = sum16(ss + (size_t)row * 16); tab[(ui & 1) * 256 + tid] = (f32x2){__builtin_amdgcn_rsqf(s * (1.0f / 1024.0f) + RMS_EPS), 0.f}; }
    }
    __device__ __forceinline__ void mid(f32x4 (&)[2][2][4][2], const Unit&, int, int, int, int, int) const {}
    __device__ __forceinline__ void operator()(const f32x4 (&acc)[2][2][4][2], const Unit& u, int ui, int wr, int wc, int fr, int fq) const {
        const int seg = u.pn >> 1, col0 = (u.pn & 1) * BM + wc * 32 + 8 * fq;
        GAS unsigned char* w = lau(ws); GAS float* ob = lauf(out);
        GAS bf16_t* Q = (GAS bf16_t*)(w + WS_QB); GAS bf16_t* Kb = (GAS bf16_t*)(w + WS_KB); GAS bf16_t* Vb = (GAS bf16_t*)(w + WS_VB); GAS bf16_t* U = (GAS bf16_t*)(w + WS_UB); GAS float* Us = (GAS float*)(w + WS_US);
        GAS float* outKp = ob + O_PK + (size_t)l * MP * 512; GAS float* outVp = ob + O_PV + (size_t)l * MP * 512; GAS float* outKs = ob + O_SK + (size_t)l * MS * 512; GAS float* outVs = ob + O_SV + (size_t)l * MS * 512;
#pragma unroll
        for (int ai = 0; ai < 2; ++ai)
#pragma unroll
            for (int m = 0; m < 4; ++m) {
                const int rl = ai * HALF + wr * 64 + m * 16 + fr, row = u.pm * BM + rl; const float r = tab[(ui & 1) * 256 + rl].x;
#pragma unroll
                for (int bj = 0; bj < 2; ++bj) {
                    const int c = col0 + bj * HALF; f32x4 v0 = acc[ai][bj][m][0] * r, v1 = acc[ai][bj][m][1] * r;
                    if (seg == 0) { *(GAS u32x4*)(Q + (size_t)row * 512 + c) = pack8(v0 * QSCALE, v1 * QSCALE); }
                    else if (seg == 3) {
                        if (row < MP_ROWS) { *(GAS u32x4*)(U + (((size_t)(c >> 4) * MP_ROWS + row) * 16 + (c & 15))) = pack8(v0, v1); }
                        else { GAS float* p = Us + (size_t)(row - MP_ROWS) * 512 + c; *(GAS f32x4*)p = v0; *(GAS f32x4*)(p + 4) = v1; }
                    } else {
                        GAS bf16_t* bb = (seg == 1) ? Kb : Vb; *(GAS u32x4*)(bb + (size_t)row * 512 + c) = pack8(v0, v1);
                        GAS float* p = (row < MP_ROWS) ? ((seg == 1 ? outKp : outVp) + (size_t)row * 512 + c) : ((seg == 1 ? outKs : outVs) + (size_t)(row - MP_ROWS) * 512 + c);
                        *(GAS f32x4*)p = v0; *(GAS f32x4*)(p + 4) = v1;
                    }
                }
                asm volatile("" ::: "memory");
            }
    }
};

struct EpiGlu {
    static constexpr bool PERM = true, AFTER_DRAIN = false, MID = false;
    GAS unsigned char* ws; const GAS float* bias;
    __device__ __forceinline__ void begin(const Unit&, int, int) const {}
    __device__ __forceinline__ void mid(f32x4 (&)[2][2][4][2], const Unit&, int, int, int, int, int) const {}
    __device__ __forceinline__ void operator()(const f32x4 (&acc)[2][2][4][2], const Unit& u, int ui, int wr, int wc, int fr, int fq) const {
        const int col0 = u.pn * BM + wc * 32 + 8 * fq;
        GAS unsigned char* w = lau(ws); const GAS bf16_t* Z = (const GAS bf16_t*)(w + WS_ZB); GAS bf16_t* MIXs = (GAS bf16_t*)(w + WS_MIX) + 512; GAS float* sss = (GAS float*)(w + WS_SSS);
        f32x4 bv[2][2];
#pragma unroll
        for (int bj = 0; bj < 2; ++bj)
#pragma unroll
            for (int n = 0; n < 2; ++n) bv[bj][n] = *(const GAS f32x4*)(bias + col0 + bj * HALF + 4 * n);
        float part[2][4];
#pragma unroll
        for (int ai = 0; ai < 2; ++ai) {
            u32x4 pre[1][4][2];
#pragma unroll
            for (int m = 0; m < 4; ++m)
#pragma unroll
                for (int bj = 0; bj < 2; ++bj) { const int c = col0 + bj * HALF, row = u.pm * BM + ai * HALF + wr * 64 + m * 16 + fr;
                    pre[0][m][bj] = *(const GAS u32x4*)(Z + ((size_t)(c >> 4) * MP_ROWS + row) * 16 + (c & 15)); }
            __builtin_amdgcn_sched_barrier(0);
#pragma unroll
            for (int m = 0; m < 4; ++m) {
                const int row = u.pm * BM + ai * HALF + wr * 64 + m * 16 + fr; float pt = 0.f;
#pragma unroll
                for (int bj = 0; bj < 2; ++bj) {
                    const int c = col0 + bj * HALF; const u32x4 zz = pre[0][m][bj];
                    f32x4 z0, z1; z0[0] = __uint_as_float(zz.x << 16); z0[1] = __uint_as_float(zz.x & 0xffff0000u); z0[2] = __uint_as_float(zz.y << 16); z0[3] = __uint_as_float(zz.y & 0xffff0000u);
                    z1[0] = __uint_as_float(zz.z << 16); z1[1] = __uint_as_float(zz.z & 0xffff0000u); z1[2] = __uint_as_float(zz.w << 16); z1[3] = __uint_as_float(zz.w & 0xffff0000u);
                    const f32x4 a0 = acc[ai][bj][m][0] + bv[bj][0], a1 = acc[ai][bj][m][1] + bv[bj][1]; f32x4 o0, o1;
#pragma unroll
                    for (int e = 0; e < 4; ++e) { o0[e] = z0[e] * __builtin_amdgcn_rcpf(1.0f + __builtin_amdgcn_exp2f(-1.4426950408889634f * a0[e])); o1[e] = z1[e] * __builtin_amdgcn_rcpf(1.0f + __builtin_amdgcn_exp2f(-1.4426950408889634f * a1[e])); }
                    pt += sum8sq(o0, o1);
                    *(GAS u32x4*)(MIXs + (size_t)row * 1024 + c) = pack8(o0, o1);
                }
                part[ai][m] = pt;
            }
            __builtin_amdgcn_sched_barrier(0);
        }
#pragma unroll
        for (int ai = 0; ai < 2; ++ai)
#pragma unroll
            for (int m = 0; m < 4; ++m) { const int row = u.pm * BM + ai * HALF + wr * 64 + m * 16 + fr; const float pr = fq_reduce(part[ai][m]); if (fq == 0) sss[(size_t)row * 8 + u.pn * 4 + wc] = pr; }
        asm volatile("" ::: "memory");
    }
};

struct EpiWout {
    static constexpr bool PERM = true, AFTER_DRAIN = false, MID = true;
    GAS unsigned char* ws; PG8_LAS f32x2* tab; size_t dry;
    __device__ __forceinline__ void begin(const Unit& u, int ui, int tid) const {
        GAS unsigned char* w0 = lau(ws); const GAS float* ssa = (const GAS float*)(w0 + WS_SSA); const GAS float* sss = (const GAS float*)(w0 + WS_SSS);
        if (tid < 256) { const int row = u.pm * BM + tid; const float sa = sum8(ssa + (size_t)row * 8), s2 = sum8(sss + (size_t)row * 8);
            const float va = sa * (1.0f / 512.0f) + RMS_EPS, vs = s2 * (1.0f / 512.0f) + RMS_EPS; const float rs = __builtin_amdgcn_rsqf(vs); tab[(ui & 1) * 256 + tid] = (f32x2){__builtin_amdgcn_rsqf(va) * vs * rs, rs}; }
    }
    __device__ __forceinline__ void mid(f32x4 (&acc)[2][2][4][2], const Unit& u, int ui, int wr, int wc, int fr, int fq) const {
#pragma unroll
        for (int ai = 0; ai < 2; ++ai)
#pragma unroll
            for (int m = 0; m < 4; ++m) { const float f = tab[(ui & 1) * 256 + ai * HALF + wr * 64 + m * 16 + fr].x;
#pragma unroll
                for (int bj = 0; bj < 2; ++bj)
#pragma unroll
                    for (int n = 0; n < 2; ++n) acc[ai][bj][m][n] = acc[ai][bj][m][n] * f; }
    }
    __device__ __forceinline__ void operator()(const f32x4 (&acc)[2][2][4][2], const Unit& u, int ui, int wr, int wc, int fr, int fq) const {
        const int col0 = u.pn * BM + wc * 32 + 8 * fq;
        GAS unsigned char* w = lau(ws); const GAS bf16_t* xin = (const GAS bf16_t*)(w + WS_XB); GAS bf16_t* xb = (GAS bf16_t*)(w + WS_XB + dry); GAS float* ss2 = (GAS float*)(w + WS_SS2 + dry);
        float part[2][4];
#pragma unroll
        for (int ai = 0; ai < 2; ++ai) {
            u32x4 pre[1][4][2];
#pragma unroll
            for (int m = 0; m < 4; ++m)
#pragma unroll
                for (int bj = 0; bj < 2; ++bj) pre[0][m][bj] = *(const GAS u32x4*)(xin + (size_t)(u.pm * BM + ai * HALF + wr * 64 + m * 16 + fr) * 1024 + col0 + bj * HALF);
            __builtin_amdgcn_sched_barrier(0);
#pragma unroll
            for (int m = 0; m < 4; ++m) {
                const int rl = ai * HALF + wr * 64 + m * 16 + fr, row = u.pm * BM + rl; const float rs = tab[(ui & 1) * 256 + rl].y; float pt = 0.f;
#pragma unroll
                for (int bj = 0; bj < 2; ++bj) {
                    const int c = col0 + bj * HALF; f32x4 x0, x1; unpack8(pre[0][m][bj], x0, x1);
                    const f32x4 h0 = x0 + acc[ai][bj][m][0] * rs, h1 = x1 + acc[ai][bj][m][1] * rs;
                    *(GAS u32x4*)(xb + (size_t)row * 1024 + c) = pack8(h0, h1); pt += sum8sq(h0, h1);
                }
                part[ai][m] = pt;
            }
            __builtin_amdgcn_sched_barrier(0);
        }
#pragma unroll
        for (int ai = 0; ai < 2; ++ai)
#pragma unroll
            for (int m = 0; m < 4; ++m) { const int row = u.pm * BM + ai * HALF + wr * 64 + m * 16 + fr; const float pr = fq_reduce(part[ai][m]); if (fq == 0) ss2[(size_t)row * 16 + u.pn * 4 + wc] = pr; }
        asm volatile("" ::: "memory");
    }
};

struct EpiGateUp {
    static constexpr bool PERM = true, AFTER_DRAIN = false, MID = false;
    GAS unsigned char* ws; PG8_LAS f32x2* tab;
    __device__ __forceinline__ void begin(const Unit& u, int ui, int tid) const {
        const GAS float* ss = (const GAS float*)(lau(ws) + WS_SS2);
        if (tid < 256) { const int row = u.pm * BM + tid; const float s = sum16(ss + (size_t)row * 16); tab[(ui & 1) * 256 + tid] = (f32x2){__builtin_amdgcn_rsqf(s * (1.0f / 1024.0f) + RMS_EPS), 0.f}; }
    }
    __device__ __forceinline__ void mid(f32x4 (&)[2][2][4][2], const Unit&, int, int, int, int, int) const {}
    __device__ __forceinline__ void operator()(const f32x4 (&acc)[2][2][4][2], const Unit& u, int ui, int wr, int wc, int fr, int fq) const {
        const int c = u.pn * HALF + wc * 32 + 8 * fq; GAS bf16_t* G = (GAS bf16_t*)(lau(ws) + WS_GB);
#pragma unroll
        for (int ai = 0; ai < 2; ++ai)
#pragma unroll
            for (int m = 0; m < 4; ++m) {
                const int rl = ai * HALF + wr * 64 + m * 16 + fr, row = u.pm * BM + rl; const float r = tab[(ui & 1) * 256 + rl].x;
                f32x4 o[2];
#pragma unroll
                for (int n = 0; n < 2; ++n) { const f32x4 g = acc[ai][0][m][n] * r, up = acc[ai][1][m][n] * r;
#pragma unroll
                    for (int e = 0; e < 4; ++e) o[n][e] = g[e] * up[e] * __builtin_amdgcn_rcpf(1.0f + __builtin_amdgcn_exp2f(-1.4426950408889634f * g[e])); }
#if GWT
                st16_wt(G + (size_t)row * 2816 + c, pack8(o[0], o[1]));
#else
                *(GAS u32x4*)(G + (size_t)row * 2816 + c) = pack8(o[0], o[1]);
#endif
                asm volatile("" ::: "memory");
            }
    }
};

struct EpiDown {
    static constexpr bool PERM = true, AFTER_DRAIN = false, MID = false;
    GAS unsigned char* ws; size_t dry;
    __device__ __forceinline__ void begin(const Unit&, int, int) const {}
    __device__ __forceinline__ void mid(f32x4 (&)[2][2][4][2], const Unit&, int, int, int, int, int) const {}
    __device__ __forceinline__ void operator()(const f32x4 (&acc)[2][2][4][2], const Unit& u, int ui, int wr, int wc, int fr, int fq) const {
        const int col0 = u.pn * BM + wc * 32 + 8 * fq;
        GAS unsigned char* w = lau(ws); const GAS bf16_t* xin = (const GAS bf16_t*)(w + WS_XB); GAS bf16_t* xb = (GAS bf16_t*)(w + WS_XB + dry); GAS float* ss1 = (GAS float*)(w + WS_SS1 + dry);
        float part[2][4];
#pragma unroll
        for (int ai = 0; ai < 2; ++ai) {
            u32x4 pre[1][4][2];
#pragma unroll
            for (int m = 0; m < 4; ++m)
#pragma unroll
                for (int bj = 0; bj < 2; ++bj) pre[0][m][bj] = *(const GAS u32x4*)(xin + (size_t)(u.pm * BM + ai * HALF + wr * 64 + m * 16 + fr) * 1024 + col0 + bj * HALF);
            __builtin_amdgcn_sched_barrier(0);
#pragma unroll
            for (int m = 0; m < 4; ++m) {
                const int row = u.pm * BM + ai * HALF + wr * 64 + m * 16 + fr; float pt = 0.f;
#pragma unroll
                for (int bj = 0; bj < 2; ++bj) {
                    const int c = col0 + bj * HALF; f32x4 x0, x1; unpack8(pre[0][m][bj], x0, x1);
                    const f32x4 y0 = x0 + acc[ai][bj][m][0], y1 = x1 + acc[ai][bj][m][1];
                    *(GAS u32x4*)(xb + (size_t)row * 1024 + c) = pack8(y0, y1); pt += sum8sq(y0, y1);
                }
                part[ai][m] = pt;
            }
            __builtin_amdgcn_sched_barrier(0);
        }
#pragma unroll
        for (int ai = 0; ai < 2; ++ai)
#pragma unroll
            for (int m = 0; m < 4; ++m) { const int row = u.pm * BM + ai * HALF + wr * 64 + m * 16 + fr; const float pr = fq_reduce(part[ai][m]); if (fq == 0) ss1[(size_t)row * 16 + u.pn * 4 + wc] = pr; }
        asm volatile("" ::: "memory");
    }
};
template <class Epi, class Sched, bool ALIGN_EPI = false, bool SP2 = false, bool AGRP = false>
__device__ __forceinline__ void gemm_phase(PG8_LAS unsigned char* lds, const Gemm g, const Sched& S, const Epi& E) {
    int tid_ = threadIdx.x; asm volatile("" : "+v"(tid_));
    const int tid = tid_, wid = __builtin_amdgcn_readfirstlane(tid >> 6), lane = tid & 63, wr = wid >> 2, wc = wid & 3, fr = lane & 15, fq = lane >> 4;
    const int K = g.K, nt = K / BK;
    unsigned voffA[2], voffB[2];
#pragma unroll
    for (int i = 0; i < 2; ++i) { int R, C; stage_rc(tid * 16 + i * 8192, R, C); const int Rb = Epi::PERM ? ((R & ~31) + perm32(R & 31)) : R;
        voffA[i] = AGRP ? (unsigned)((C >> 4) * (MP * 32) + R * 32 + (C & 15) * 2) : (unsigned)(R * K + C) * 2u; voffB[i] = (unsigned)(Rb * K + C) * 2u; }
    const size_t kstep = (size_t)(BK * 2);
    const size_t hstep = (size_t)HALF * K * 2;
    const size_t tstep = 2 * hstep;
    const size_t kstepA = AGRP ? (size_t)4 * MP * 32 : kstep, hstepA = AGRP ? (size_t)HALF * 32 : hstep, tstepA = 2 * hstepA;
    const unsigned ldsw = (unsigned)wid * 1024u;
    const int aoff = lds_byte(wr * 64 + fr, fq * 8), boff = lds_byte(wc * 32 + fr, fq * 8);
#define PG8_SA(b, h) (((b) * 2 + (h)) * HTB)
#define PG8_SB(b, h) ((4 + (b) * 2 + (h)) * HTB)
#define PG8_STAGE(bufoff, gbase, voff) do { _Pragma("unroll") for (int _i = 0; _i < 2; ++_i) \
        __builtin_amdgcn_global_load_lds((const unsigned*)((const char*)(gbase) + (voff)[_i]), (PG8_LAS unsigned*)(lds + (bufoff) + ldsw + _i * 8192), 16, 0, 0); } while (0)
#define PG8_LDA(dst, b, h) do { _Pragma("unroll") for (int m = 0; m < 4; ++m) _Pragma("unroll") for (int k = 0; k < 2; ++k) dst[m][k] = *(const PG8_LAS bf16x8*)(lds + PG8_SA(b, h) + aoff + m * 2048 + k * 1024); } while (0)
#define PG8_LDB(dst, b, h) do { _Pragma("unroll") for (int n = 0; n < 2; ++n) _Pragma("unroll") for (int k = 0; k < 2; ++k) dst[n][k] = *(const PG8_LAS bf16x8*)(lds + PG8_SB(b, h) + boff + n * 2048 + k * 1024); } while (0)
#define PG8_MMA(ai, bj, At, Bt) do { __builtin_amdgcn_s_setprio(1); _Pragma("unroll") for (int m = 0; m < 4; ++m) _Pragma("unroll") for (int n = 0; n < 2; ++n) _Pragma("unroll") for (int k = 0; k < 2; ++k) \
        acc[ai][bj][m][n] = __builtin_amdgcn_mfma_f32_16x16x32_bf16(Bt[n][k], At[m][k], acc[ai][bj][m][n], 0, 0, 0); __builtin_amdgcn_s_setprio(0); } while (0)
#define PG8_WAIT_V(n) asm volatile("s_waitcnt vmcnt(" #n ")" ::: "memory")
#define PG8_WAIT_L(n) asm volatile("s_waitcnt lgkmcnt(" #n ")" ::: "memory")
#define PG8_BAR __builtin_amdgcn_s_barrier()
#define PG8_SCHED __builtin_amdgcn_sched_barrier(0)
    Unit cur, nxt; int ui = 0;
    if (!S.next(0, cur)) return;
    f32x4 acc[2][2][4][2];
#pragma unroll
    for (int a = 0; a < 2; ++a)
#pragma unroll
        for (int b = 0; b < 2; ++b)
#pragma unroll
            for (int m = 0; m < 4; ++m)
#pragma unroll
                for (int n = 0; n < 2; ++n) acc[a][b][m][n] = (f32x4){0.f, 0.f, 0.f, 0.f};
    bf16x8 At[4][2], B0[2][2], B1[2][2];
    const char* cA = (const char*)g.A + (size_t)cur.pm * tstepA; const char* cB = (const char*)g.Bt + (size_t)cur.pn * tstep;
    S.a_ready(cur);
    if constexpr (SP2) {
        PG8_STAGE(PG8_SB(0, 0), cB, voffB); PG8_STAGE(PG8_SB(0, 1), cB + hstep, voffB); PG8_STAGE(PG8_SA(0, 0), cA, voffA); PG8_STAGE(PG8_SA(0, 1), cA + hstepA, voffA);
        E.begin(cur, 0, tid);
        if (wr == 1) PG8_BAR;
        PG8_WAIT_V(2); PG8_BAR;
        PG8_STAGE(PG8_SB(1, 0), cB + kstep, voffB); PG8_STAGE(PG8_SA(1, 0), cA + kstepA, voffA); PG8_STAGE(PG8_SB(1, 1), cB + hstep + kstep, voffB);
        PG8_WAIT_V(6); PG8_BAR;
    } else {
        PG8_STAGE(PG8_SB(0, 0), cB, voffB); PG8_STAGE(PG8_SA(0, 0), cA, voffA); PG8_STAGE(PG8_SB(0, 1), cB + hstep, voffB); PG8_STAGE(PG8_SA(0, 1), cA + hstepA, voffA);
        if (wr == 1) PG8_BAR;
        PG8_WAIT_V(4); PG8_BAR;
        PG8_STAGE(PG8_SB(1, 0), cB + kstep, voffB); PG8_STAGE(PG8_SA(1, 0), cA + kstepA, voffA); PG8_STAGE(PG8_SB(1, 1), cB + hstep + kstep, voffB);
        PG8_WAIT_V(6); PG8_BAR;
    }
    for (;;) {
        if (!SP2 || ui > 0) E.begin(cur, ui, tid);
        const bool has_next = S.next(ui + 1, nxt);
        const char* nA = has_next ? (const char*)g.A + (size_t)nxt.pm * tstepA : cA; const char* nB = has_next ? (const char*)g.Bt + (size_t)nxt.pn * tstep : cB;
        for (int t = 0; t < nt; t += 2) {
            if constexpr (Epi::MID) { if (t == (nt >> 1)) E.mid(acc, cur, ui, wr, wc, fr, fq); }
            const bool last = (t == nt - 2);
            const char* a1 = cA + (size_t)(t + 1) * kstepA;
            const char* a2 = last ? nA : cA + (size_t)(t + 2) * kstepA; const char* b2 = last ? nB : cB + (size_t)(t + 2) * kstep;
            const char* a3 = a2 + kstepA; const char* b3 = b2 + kstep;
            if (last && has_next) S.a_ready(nxt);
            if constexpr (SP2) {
            PG8_LDB(B0, 0, 0); PG8_LDB(B1, 0, 1); PG8_SCHED; PG8_LDA(At, 0, 0); PG8_STAGE(PG8_SA(1, 1), a1 + hstepA, voffA);
            PG8_WAIT_V(8); PG8_WAIT_L(0); PG8_BAR; PG8_MMA(0, 0, At, B0); PG8_MMA(0, 1, At, B1); PG8_BAR; PG8_SCHED;
            PG8_LDA(At, 0, 1); PG8_STAGE(PG8_SB(0, 0), b2, voffB); PG8_STAGE(PG8_SB(0, 1), b2 + hstep, voffB); PG8_STAGE(PG8_SA(0, 0), a2, voffA);
            PG8_WAIT_V(8); PG8_WAIT_L(0); PG8_BAR; PG8_MMA(1, 0, At, B0); PG8_MMA(1, 1, At, B1); PG8_BAR; PG8_SCHED;
            PG8_LDB(B0, 1, 0); PG8_LDB(B1, 1, 1); PG8_SCHED; PG8_LDA(At, 1, 0); PG8_STAGE(PG8_SA(0, 1), a2 + hstepA, voffA);
            PG8_WAIT_V(8); PG8_WAIT_L(0); PG8_BAR; PG8_MMA(0, 0, At, B0); PG8_MMA(0, 1, At, B1); PG8_BAR; PG8_SCHED;
            PG8_LDA(At, 1, 1); PG8_STAGE(PG8_SB(1, 0), b3, voffB); PG8_STAGE(PG8_SB(1, 1), b3 + hstep, voffB); PG8_STAGE(PG8_SA(1, 0), a3, voffA);
            PG8_WAIT_V(8); PG8_WAIT_L(0); PG8_BAR; PG8_MMA(1, 0, At, B0); PG8_MMA(1, 1, At, B1); PG8_BAR; PG8_SCHED;
            } else {
            PG8_LDB(B0, 0, 0); PG8_SCHED; PG8_LDA(At, 0, 0); PG8_STAGE(PG8_SA(1, 1), a1 + hstepA, voffA);
            PG8_WAIT_L(8); PG8_BAR; PG8_WAIT_L(0); PG8_MMA(0, 0, At, B0); PG8_BAR; PG8_SCHED;
            PG8_LDB(B1, 0, 1); PG8_STAGE(PG8_SB(0, 0), b2, voffB);
            PG8_BAR; PG8_WAIT_L(0); PG8_MMA(0, 1, At, B1); PG8_BAR;
            PG8_LDA(At, 0, 1); PG8_STAGE(PG8_SA(0, 0), a2, voffA);
            PG8_BAR; PG8_WAIT_L(0); PG8_MMA(1, 0, At, B0); PG8_BAR; PG8_SCHED;
            PG8_STAGE(PG8_SB(0, 1), b2 + hstep, voffB);
            PG8_WAIT_V(6); PG8_BAR; PG8_MMA(1, 1, At, B1); PG8_BAR;
            PG8_LDB(B0, 1, 0); PG8_SCHED; PG8_LDA(At, 1, 0); PG8_STAGE(PG8_SA(0, 1), a2 + hstepA, voffA);
            PG8_WAIT_L(8); PG8_BAR; PG8_WAIT_L(0); PG8_MMA(0, 0, At, B0); PG8_BAR; PG8_SCHED;
            PG8_LDB(B1, 1, 1); PG8_STAGE(PG8_SB(1, 0), b3, voffB);
            PG8_BAR; PG8_WAIT_L(0); PG8_MMA(0, 1, At, B1); PG8_BAR;
            PG8_LDA(At, 1, 1); PG8_STAGE(PG8_SA(1, 0), a3, voffA);
            PG8_BAR; PG8_WAIT_L(0); PG8_MMA(1, 0, At, B0); PG8_BAR; PG8_SCHED;
            PG8_STAGE(PG8_SB(1, 1), b3 + hstep, voffB);
            PG8_WAIT_V(6); PG8_BAR; PG8_MMA(1, 1, At, B1); PG8_BAR;
            }
        }
        if constexpr (ALIGN_EPI) { if (wr == 0) PG8_BAR; }
        if constexpr (!Epi::AFTER_DRAIN) { E(acc, cur, ui, wr, wc, fr, fq); S.done(cur); }
        if (!has_next) break;
#pragma unroll
        for (int a = 0; a < 2; ++a)
#pragma unroll
            for (int b = 0; b < 2; ++b)
#pragma unroll
                for (int m = 0; m < 4; ++m)
#pragma unroll
                    for (int n = 0; n < 2; ++n) acc[a][b][m][n] = (f32x4){0.f, 0.f, 0.f, 0.f};
        cur = nxt; cA = nA; cB = nB; ++ui;
        if constexpr (ALIGN_EPI) { if (wr == 1) PG8_BAR; }
    }
    PG8_WAIT_V(0);
    if constexpr (!ALIGN_EPI) { if (wr == 0) PG8_BAR; }
    PG8_BAR;
#undef PG8_SA
#undef PG8_SB
#undef PG8_STAGE
#undef PG8_LDA
#undef PG8_LDB
#undef PG8_MMA
#undef PG8_WAIT_V
#undef PG8_WAIT_L
#undef PG8_BAR
#undef PG8_SCHED
}
}

namespace attn_body {
using bf16=__hip_bfloat16;
using bf16x8=__attribute__((ext_vector_type(8)))short;
using s16x4=__attribute__((ext_vector_type(4)))short;
using f32x16=__attribute__((ext_vector_type(16)))float;
using u32x4=__attribute__((ext_vector_type(4)))unsigned;
constexpr int BATCH=8,NHEAD=8,SEQ=2048,D=64,DM=512,OP=1024;
constexpr int NW=8,QBLK=32,QB=QBLK*NW,KVBLK=64,NQB=SEQ/QB;
constexpr int ATTN_PITCH=DM, ATTN_UNIT_ROWS=QB;
__device__ __forceinline__ int crow(int r,int hi){return (r&3)+8*(r>>2)+4*hi;}
#define SBAR() __builtin_amdgcn_sched_barrier(0)
__device__ __forceinline__ void cmask(f32x16&p0,f32x16&p1,int jb,int qrel,int hi){
  const float NEG=-INFINITY; int kb=64*jb+4*hi;
  #pragma unroll
  for(int r=0;r<16;++r){int kv=kb+(r&3)+8*(r>>2); if(kv>qrel)p0[r]=NEG; if(kv+32>qrel)p1[r]=NEG;}
}

constexpr int NSLOT=3, SLOTB=8192;
constexpr int LDS_K=0, LDS_V=NSLOT*SLOTB, LDS_WS=2*NSLOT*SLOTB, LDS_OST=LDS_WS+NW*64*4, LDS_BYTES=LDS_OST+NW*4096;
constexpr float C2=0.125f*1.4426950408889634f;
__device__ __forceinline__ void glds16(const void*gsrc,unsigned lds_dst){unsigned keep;
  asm volatile("s_mov_b32 %0, m0\n\ts_mov_b32 m0, %2\n\ts_nop 0\n\tglobal_load_lds_dwordx4 %1, off\n\ts_mov_b32 m0, %0":"=&s"(keep):"v"(gsrc),"s"(lds_dst):"memory");}
__device__ __forceinline__ float max3f(float a,float b,float c){float r;asm("v_max3_f32 %0, %1, %2, %3":"=v"(r):"v"(a),"v"(b),"v"(c));return r;}
__device__ __forceinline__ float max2f(float a,float b){float r;asm("v_max_f32_e32 %0, %1, %2":"=v"(r):"v"(a),"v"(b));return r;}
__device__ __forceinline__ float fadd_s(float a,float b){float r;asm("v_add_f32_e32 %0, %1, %2":"=v"(r):"v"(a),"v"(b));return r;}
__device__ __forceinline__ float fsub_s(float a,float b){float r;asm("v_sub_f32_e32 %0, %1, %2":"=v"(r):"v"(a),"v"(b));return r;}
typedef float f32x2_t __attribute__((ext_vector_type(2))); typedef __bf16 bf16x2_t __attribute__((ext_vector_type(2)));
__device__ __forceinline__ unsigned cvtpk_s(float lo,float hi){f32x2_t v={lo,hi};bf16x2_t b=__builtin_convertvector(v,bf16x2_t);return __builtin_bit_cast(unsigned,b);}
#define WAIT_BAR(N) asm volatile("s_waitcnt vmcnt(" #N ") lgkmcnt(0)\n\ts_barrier":::"memory")

__device__ __forceinline__ void qkt(f32x16&p0,f32x16&p1,const char*Kslot,const bf16x8*qr,const f32x16&negm,int r32,int hi){
  const char*kb=Kslot+hi*1024+r32*16;
  #pragma unroll
  for(int d0=0;d0<4;++d0){
    const bf16x8 b0=*reinterpret_cast<const bf16x8*>(kb+d0*2048);
    const bf16x8 b1=*reinterpret_cast<const bf16x8*>(kb+d0*2048+512);
    if(d0==0){p0=__builtin_amdgcn_mfma_f32_32x32x16_bf16(b0,qr[0],negm,0,0,0);p1=__builtin_amdgcn_mfma_f32_32x32x16_bf16(b1,qr[0],negm,0,0,0);}
    else{p0=__builtin_amdgcn_mfma_f32_32x32x16_bf16(b0,qr[d0],p0,0,0,0);p1=__builtin_amdgcn_mfma_f32_32x32x16_bf16(b1,qr[d0],p1,0,0,0);}}
}
typedef __attribute__((address_space(3))) const char* lds_cptr;
typedef short v4i16_t __attribute__((ext_vector_type(4)));
__device__ __forceinline__ void kload8(bf16x8*kf,lds_cptr kp){
  kf[0]=*(const __attribute__((address_space(3))) bf16x8*)(kp);      kf[1]=*(const __attribute__((address_space(3))) bf16x8*)(kp+512);
  kf[2]=*(const __attribute__((address_space(3))) bf16x8*)(kp+2048); kf[3]=*(const __attribute__((address_space(3))) bf16x8*)(kp+2560);
  kf[4]=*(const __attribute__((address_space(3))) bf16x8*)(kp+4096); kf[5]=*(const __attribute__((address_space(3))) bf16x8*)(kp+4608);
  kf[6]=*(const __attribute__((address_space(3))) bf16x8*)(kp+6144); kf[7]=*(const __attribute__((address_space(3))) bf16x8*)(kp+6656);
}
__device__ __forceinline__ void kload2(bf16x8*kf,lds_cptr kp,int j){ kf[2*j]=*(const __attribute__((address_space(3))) bf16x8*)(kp+j*2048); kf[2*j+1]=*(const __attribute__((address_space(3))) bf16x8*)(kp+j*2048+512); }
__device__ __forceinline__ s16x4 vtr(lds_cptr p){ return __builtin_bit_cast(s16x4,__builtin_amdgcn_ds_read_tr16_b64_v4i16((__attribute__((address_space(3))) v4i16_t*)p)); }
__device__ __forceinline__ float rowmax(const f32x16&p0,const f32x16&p1){
  float a=max3f(p0[0],p0[1],p1[0]),b=max3f(p0[2],p0[3],p1[1]);a=max3f(a,p1[2],p1[3]);
  #pragma unroll
  for(int r=4;r<16;r+=4){a=max3f(a,p0[r],p0[r+1]);b=max3f(b,p0[r+2],p0[r+3]);a=max3f(a,p1[r],p1[r+1]);b=max3f(b,p1[r+2],p1[r+3]);}
  const float m=max2f(a,b);
  auto rr=__builtin_amdgcn_permlane32_swap(__float_as_uint(m),__float_as_uint(m),false,false);
  return max2f(__uint_as_float(rr[0]),__uint_as_float(rr[1]));
}
__device__ __forceinline__ void pv(f32x16*o,int vb,bf16x8 pa0,bf16x8 pa1,bf16x8 pa2,bf16x8 pa3){
  #pragma unroll
  for(int d0=0;d0<2;++d0){s16x4 lo[4],hi[4];
    #pragma unroll
    for(int ks=0;ks<4;++ks){
      asm volatile("ds_read_b64_tr_b16 %0,%1 offset:%c2":"=&v"(lo[ks]):"v"(vb),"i"(d0*4096+ks*1024):"memory");
      asm volatile("ds_read_b64_tr_b16 %0,%1 offset:%c2":"=&v"(hi[ks]):"v"(vb),"i"(d0*4096+ks*1024+512):"memory");}
    asm volatile("s_waitcnt lgkmcnt(0)":::"memory");SBAR();
    #define PK(k) (bf16x8){lo[k][0],lo[k][1],lo[k][2],lo[k][3],hi[k][0],hi[k][1],hi[k][2],hi[k][3]}
    o[d0]=__builtin_amdgcn_mfma_f32_32x32x16_bf16(pa0,PK(0),o[d0],0,0,0);
    o[d0]=__builtin_amdgcn_mfma_f32_32x32x16_bf16(pa1,PK(1),o[d0],0,0,0);
    o[d0]=__builtin_amdgcn_mfma_f32_32x32x16_bf16(pa2,PK(2),o[d0],0,0,0);
    o[d0]=__builtin_amdgcn_mfma_f32_32x32x16_bf16(pa3,PK(3),o[d0],0,0,0);
    #undef PK
  }
}

__device__ __forceinline__ float selm(float f,float t,unsigned long long m){float d;asm("v_cndmask_b32_e64 %0, %1, %2, %3":"=v"(d):"v"(f),"v"(t),"s"(m));return d;}
constexpr unsigned long long m16c_(int r){unsigned long long m=0;for(int l=0;l<64;++l){const int e=((l&31)-4*(l>>5))&15,o=(r&3)+8*((r>>2)&1);if(e==o)m|=1ull<<l;}return m;}
constexpr unsigned long long m4c_(int r){unsigned long long m=0;for(int l=0;l<64;++l)if((l&3)==(r&3))m|=1ull<<l;return m;}
template<int R> struct MaskC{ static constexpr unsigned long long m16=m16c_(R), m4=m4c_(R); };
#define M16C(r) (attn_body::m16tab(r))
#define M4C(r) (attn_body::m4tab(r))
__device__ __forceinline__ constexpr unsigned long long m16tab(int r){ constexpr unsigned long long T[16]={m16c_(0),m16c_(1),m16c_(2),m16c_(3),m16c_(4),m16c_(5),m16c_(6),m16c_(7),m16c_(8),m16c_(9),m16c_(10),m16c_(11),m16c_(12),m16c_(13),m16c_(14),m16c_(15)}; return T[r]; }
__device__ __forceinline__ constexpr unsigned long long m4tab(int r){ constexpr unsigned long long T[4]={m4c_(0),m4c_(1),m4c_(2),m4c_(3)}; return T[r&3]; }
__device__ __forceinline__ void mask_half(f32x16&P,int dh,int dl,float mhat){
  const float ninf=-INFINITY; constexpr float L3=1.5849625007211562f; const float mh1=mhat-1.0f, mh3=mhat-L3;
  if(dh>=544){
    _Pragma("unroll") for(int r=0;r<16;++r) P[r]=selm(ninf,P[r]-mhat,M16C(r));
  } else if(dh>=160&&dh<=480){
    _Pragma("unroll") for(int r=0;r<16;++r) P[r]=selm(ninf,P[r]-selm(mhat,mh1,M16C(r)),M4C(r));
  } else if(dh<=-32){
    _Pragma("unroll") for(int r=0;r<16;++r) P[r]=ninf;
  } else if(dh>=32&&dh<=96){
    _Pragma("unroll") for(int r=0;r<16;++r) P[r]=P[r]-selm(selm(mhat,mh1,M4C(r)),mh3,M16C(r));
  } else if(dh==0){
    _Pragma("unroll") for(int r=0;r<16;++r){ const float v=P[r]-selm(selm(mhat,mh1,M4C(r)),mh3,M16C(r)); P[r]=(dl-((r&3)+8*(r>>2))>=0)?v:ninf; }
  } else if(dh==128){
    _Pragma("unroll") for(int r=0;r<16;++r){ const float nr=P[r]-selm(selm(mhat,mh1,M4C(r)),mh3,M16C(r)), md=selm(ninf,P[r]-selm(mhat,mh1,M16C(r)),M4C(r)); P[r]=(dl-((r&3)+8*(r>>2))<=128)?nr:md; }
  } else {
    _Pragma("unroll") for(int r=0;r<16;++r){ const float fr=selm(ninf,P[r]-mhat,M16C(r)), md=selm(ninf,P[r]-selm(mhat,mh1,M16C(r)),M4C(r)); P[r]=(dl-((r&3)+8*(r>>2))<=512)?md:fr; }
  }
}
#ifndef ATTN_STORE16
#define ATTN_STORE16(p,v) (*(__attribute__((address_space(1))) u32x4*)(p)=(v))
#endif
template<int THRL> __device__ __forceinline__ void attn_unit(int b,int h,int qb,const bf16*Q,const bf16*__restrict__ K,const bf16*__restrict__ V,bf16*O,float*ssa,const __attribute__((address_space(3))) float*mtab,char*shm){
  int tid_=threadIdx.x; asm volatile("":"+v"(tid_)); const int tid=tid_,lane=tid&63,r32=lane&31,hi=lane>>5; const int wid=__builtin_amdgcn_readfirstlane(tid>>6);
  const long rowbase=(long)b*SEQ; const int q0=qb*QB;
  const bf16*Qw=Q+(rowbase+q0+wid*QBLK)*DM+h*D;
  const bf16*Kh=K+rowbase*DM+h*D,*Vh=V+rowbase*DM+h*D;
  const unsigned lds0=(unsigned)(uintptr_t)shm;
  float*wsf=(float*)(shm+LDS_WS)+wid*64;
  const bf16*ksrc=Kh+(long)lane*DM+wid*8;
  const bf16*vsrc=Vh+(long)(16*(wid&3)+(lane>>2))*DM+(wid>>2)*32+(lane&3)*8;
  const unsigned kdst=lds0+LDS_K+wid*1024, vdst=lds0+LDS_V+wid*1024;
  #define DMA_K(t,slot) glds16(ksrc+(long)(t)*KVBLK*DM,(unsigned)__builtin_amdgcn_readfirstlane(kdst+(slot)))
  #define DMA_V(t,slot) glds16(vsrc+(long)(t)*KVBLK*DM,(unsigned)__builtin_amdgcn_readfirstlane(vdst+(slot)))
  const int vb0=(int)(lds0+LDS_V)+((lane>>4)&1)*32+(lane&3)*8+(4*hi+((lane&15)>>2))*64;
  const char*Kbase=shm+LDS_K; bf16x8 kf[8];
  const lds_cptr shm3=(lds_cptr)shm; const lds_cptr kp0=shm3+LDS_K+hi*1024+r32*16; const lds_cptr vp0=shm3+LDS_V+((lane>>4)&1)*32+(lane&3)*8+(4*hi+((lane&15)>>2))*64;
  const int NT=(q0+QB)/KVBLK;
  DMA_K(0,0);DMA_V(0,0);DMA_K(1,SLOTB);
  bf16x8 qr[4];
  #pragma unroll
  for(int d0=0;d0<4;++d0)qr[d0]=*(const __attribute__((address_space(1))) bf16x8*)(&Qw[(long)r32*DM+d0*16+hi*8]);
  float mhat=0.f,l_reg=0.f;f32x16 o[2];o[0]=f32x16{};o[1]=f32x16{};const f32x16 negm=f32x16{};
  const int qrel=wid*QBLK+r32; const int qabs256=q0+qrel+256-4*hi-59; (void)qrel;
  (void)qabs256; (void)mtab;
  #define MTAB(P0,P1,t) do{ const int dw_=q0+32*wid-64*(t); const int dl_=(q0+qrel)-64*(t)-4*hi; mask_half(P0,dw_,dl_,mhat); mask_half(P1,dw_-32,dl_-32,mhat); }while(0)
  #define CMASK(P0,P1,t) MTAB(P0,P1,t)
  bool resc=false;
  #define START(P0,P1) do{ const float rm=rowmax(P0,P1); resc=false; \
    { const float dl=rm; mhat=fadd_s(mhat,dl); \
      _Pragma("unroll") for(int r=0;r<16;++r){P0[r]=fsub_s(P0[r],dl);P1[r]=fsub_s(P1[r],dl);} \
      } \
    _Pragma("unroll") for(int r=0;r<16;++r)P0[r]=__builtin_amdgcn_exp2f(P0[r]); }while(0)
  #define RESC() do{ if(resc){ asm volatile("s_waitcnt lgkmcnt(0)":::"memory"); \
      _Pragma("unroll") for(int d_=0;d_<2;++d_) _Pragma("unroll") for(int r=0;r<16;++r)o[d_][r]*=wsf[crow(r,hi)]; } }while(0)
  f32x16 pA0,pA1,pB0,pB1;
  int sl_prev=0,sl_cur=0,sl_next=SLOTB;
  #define ROT() do{sl_prev=sl_cur;sl_cur=sl_next;sl_next=(sl_next==(NSLOT-1)*SLOTB)?0:sl_next+SLOTB;}while(0)
  DMA_K(2,2*SLOTB);
  WAIT_BAR(3);
  qkt(pA0,pA1,Kbase,qr,negm,r32,hi);asm volatile("s_nop 15\n\ts_nop 7":"+v"(pA0),"+v"(pA1));CMASK(pA0,pA1,0);
  START(pA0,pA1);
  _Pragma("unroll") for(int r=0;r<16;++r)pA1[r]=__builtin_amdgcn_exp2f(pA1[r]);
  WAIT_BAR(0);
  DMA_K(3,0);DMA_V(1,SLOTB);
  ROT();
  kload8(kf,kp0+sl_cur);
  WAIT_BAR(2);
  s16x4 vlo[8],vhi[8]; u32x4 pw0,pw1,pw2,pw3;
  #define PKW(P,B) cvtpk_s(P[B],P[B+1])
  #define PAF(k) __builtin_bit_cast(bf16x8,pw##k)
  #define VFR(i) (bf16x8){vlo[i][0],vlo[i][1],vlo[i][2],vlo[i][3],vhi[i][0],vhi[i][1],vhi[i][2],vhi[i][3]}
  #define PIN(x) asm volatile("":"+v"(x))
  #define MX3(a,b,c) __builtin_fmaxf(__builtin_fmaxf((a),(b)),(c))
  #define GAPA(MF,A0,A1,A2,A3,W0,W1,PW) do{ MF; sacc+=A0; sacc+=A1; sacc+=A2; sacc+=A3; PIN(sacc); W0; W1; PIN(PW); SBAR(); }while(0)
  #define EX(v) __builtin_amdgcn_exp2f(v)
  #define GAPB(MF,X,B) do{ MF; if(!FAR_){ X[B]=EX(X[B]); X[B+1]=EX(X[B+1]); X[B+2]=EX(X[B+2]); X[B+3]=EX(X[B+3]); PIN(X); } SBAR(); }while(0)
  #define VRD(i) do{ vlo[i]=vtr(vp_+(((i)>>2)*4096+((i)&3)*1024)); vhi[i]=vtr(vp_+(((i)>>2)*4096+((i)&3)*1024+512)); }while(0)
  #define KRD(G,j) do{ if(G){ kload2(kf,kp0+sl_next,j); SBAR(); } }while(0)
  #define STEP(C0,C1,P0,P1,t,GK,GV,GL,FARF) do{ constexpr bool FAR_=(FARF); SBAR(); \
    const lds_cptr vp_=vp0+sl_prev; \
    VRD(0); SBAR(); float sacc=(P0[0]+P0[1]); \
    GAPA(C0=__builtin_amdgcn_mfma_f32_32x32x16_bf16(kf[0],qr[0],negm,0,0,0), P0[2],P0[3],P0[4],P0[5],     pw0[0]=PKW(P0,0), pw0[1]=PKW(P0,2), pw0); \
    VRD(4); SBAR(); GAPA(C1=__builtin_amdgcn_mfma_f32_32x32x16_bf16(kf[1],qr[0],negm,0,0,0), P0[6],P0[7],P0[8],P0[9],     pw0[2]=PKW(P0,4), pw0[3]=PKW(P0,6), pw0); \
    VRD(1); SBAR(); GAPA(C0=__builtin_amdgcn_mfma_f32_32x32x16_bf16(kf[2],qr[1],C0,0,0,0),   P0[10],P0[11],P0[12],P0[13], pw1[0]=PKW(P0,8), pw1[1]=PKW(P0,10), pw1); \
    VRD(5); SBAR(); GAPA(C1=__builtin_amdgcn_mfma_f32_32x32x16_bf16(kf[3],qr[1],C1,0,0,0),   P0[14],P0[15],P1[0],P1[1],   pw1[2]=PKW(P0,12),pw1[3]=PKW(P0,14), pw1); \
    VRD(2); SBAR(); GAPA(C0=__builtin_amdgcn_mfma_f32_32x32x16_bf16(kf[4],qr[2],C0,0,0,0),   P1[2],P1[3],P1[4],P1[5],     pw2[0]=PKW(P1,0), pw2[1]=PKW(P1,2), pw2); \
    VRD(6); SBAR(); GAPA(C1=__builtin_amdgcn_mfma_f32_32x32x16_bf16(kf[5],qr[2],C1,0,0,0),   P1[6],P1[7],P1[8],P1[9],     pw2[2]=PKW(P1,4), pw2[3]=PKW(P1,6), pw2); \
    VRD(3); SBAR(); GAPA(C0=__builtin_amdgcn_mfma_f32_32x32x16_bf16(kf[6],qr[3],C0,0,0,0),   P1[10],P1[11],P1[12],P1[13], pw3[0]=PKW(P1,8), pw3[1]=PKW(P1,10), pw3); \
    VRD(7); SBAR(); GAPA(C1=__builtin_amdgcn_mfma_f32_32x32x16_bf16(kf[7],qr[3],C1,0,0,0),   P1[14],P1[15],0.f,0.f,       pw3[2]=PKW(P1,12),pw3[3]=PKW(P1,14), pw3); \
    l_reg+=sacc; \
    if(GK){DMA_K((t)+3,sl_cur);} if(GV){DMA_V((t)+1,sl_next);} \
    if(!FAR_){ CMASK(C0,C1,t); \
    { float a=MX3(C0[0],C0[1],C1[0]),b=MX3(C0[2],C0[3],C1[1]); a=MX3(a,C1[2],C1[3]); \
      _Pragma("unroll") for(int r=4;r<16;r+=4){a=MX3(a,C0[r],C0[r+1]);b=MX3(b,C0[r+2],C0[r+3]);a=MX3(a,C1[r],C1[r+1]);b=MX3(b,C1[r+2],C1[r+3]);} \
      float rm=__builtin_fmaxf(a,b); { auto rr=__builtin_amdgcn_permlane32_swap(__float_as_uint(rm),__float_as_uint(rm),false,false); rm=__builtin_fmaxf(__uint_as_float(rr[0]),__uint_as_float(rr[1])); } \
      resc=false; \
      if(__builtin_expect(__any(rm>(float)THRL),0)){ const float dl=__builtin_fmaxf(rm,0.f); mhat+=dl; \
        _Pragma("unroll") for(int r=0;r<16;++r){C0[r]-=dl;C1[r]-=dl;} \
        const float f=__builtin_amdgcn_exp2f(-dl); l_reg*=f; if(hi==0)wsf[r32]=f; resc=true; } } \
    } else {   \
      asm volatile("s_nop 15\n\ts_nop 7":"+v"(C0),"+v"(C1)); \
      float a0=-INFINITY,b0=-INFINITY,a1=-INFINITY,b1=-INFINITY; \
      _Pragma("unroll") for(int r=0;r<8;++r){ a0=selm(a0,C0[r],M16C(r)); b0=selm(b0,C0[r+8],M16C(r)); a1=selm(a1,C1[r],M16C(r)); b1=selm(b1,C1[r+8],M16C(r)); } \
      a0-=mhat; b0-=mhat; a1-=mhat; b1-=mhat; \
      float rm=__builtin_fmaxf(__builtin_fmaxf(a0,b0),__builtin_fmaxf(a1,b1)); { auto rr=__builtin_amdgcn_permlane32_swap(__float_as_uint(rm),__float_as_uint(rm),false,false); rm=__builtin_fmaxf(__uint_as_float(rr[0]),__uint_as_float(rr[1])); } \
      resc=false; \
      if(__builtin_expect(__any(rm>(float)THRL),0)){ const float dl=__builtin_fmaxf(rm,0.f); mhat+=dl; a0-=dl; b0-=dl; a1-=dl; b1-=dl; \
        const float f=__builtin_amdgcn_exp2f(-dl); l_reg*=f; if(hi==0)wsf[r32]=f; resc=true; } \
      a0=__builtin_amdgcn_exp2f(a0); b0=__builtin_amdgcn_exp2f(b0); a1=__builtin_amdgcn_exp2f(a1); b1=__builtin_amdgcn_exp2f(b1); \
      _Pragma("unroll") for(int r=0;r<8;++r){ C0[r]=selm(0.f,a0,M16C(r)); C0[r+8]=selm(0.f,b0,M16C(r)); C1[r]=selm(0.f,a1,M16C(r)); C1[r+8]=selm(0.f,b1,M16C(r)); } } \
    SBAR(); \
    GAPB(o[0]=__builtin_amdgcn_mfma_f32_32x32x16_bf16(PAF(0),VFR(0),o[0],0,0,0), C0,0); \
    GAPB(o[1]=__builtin_amdgcn_mfma_f32_32x32x16_bf16(PAF(0),VFR(4),o[1],0,0,0), C0,4); \
    KRD(GL,0); GAPB(o[0]=__builtin_amdgcn_mfma_f32_32x32x16_bf16(PAF(1),VFR(1),o[0],0,0,0), C0,8); \
    KRD(GL,1); GAPB(o[1]=__builtin_amdgcn_mfma_f32_32x32x16_bf16(PAF(1),VFR(5),o[1],0,0,0), C0,12); \
    KRD(GL,2); GAPB(o[0]=__builtin_amdgcn_mfma_f32_32x32x16_bf16(PAF(2),VFR(2),o[0],0,0,0), C1,0); \
    KRD(GL,3); GAPB(o[1]=__builtin_amdgcn_mfma_f32_32x32x16_bf16(PAF(2),VFR(6),o[1],0,0,0), C1,4); \
    GAPB(o[0]=__builtin_amdgcn_mfma_f32_32x32x16_bf16(PAF(3),VFR(3),o[0],0,0,0), C1,8); \
    GAPB(o[1]=__builtin_amdgcn_mfma_f32_32x32x16_bf16(PAF(3),VFR(7),o[1],0,0,0), C1,12); \
    }while(0)
  int t=1;
  #undef CMASK
  #define CMASK(P0,P1,t) MTAB(P0,P1,t)
#if ATTN_FAR
  { const int TF=4*qb-9;
  for(;t+1<=TF&&t+5<NT;t+=2){
    STEP(pB0,pB1,pA0,pA1,t,true,true,true,true);     WAIT_BAR(2); RESC(); ROT();
    STEP(pA0,pA1,pB0,pB1,t+1,true,true,true,true);   WAIT_BAR(2); RESC(); ROT();
  } }
#endif
  for(;t+5<NT;t+=2){
    STEP(pB0,pB1,pA0,pA1,t,true,true,true,false);     WAIT_BAR(2); RESC(); ROT();
    STEP(pA0,pA1,pB0,pB1,t+1,true,true,true,false);   WAIT_BAR(2); RESC(); ROT();
  }
  #undef CMASK
  #define CMASK(P0,P1,t) MTAB(P0,P1,t)
  #define ENDW(tt) do{ if((tt)+3<NT){WAIT_BAR(2);} else if((tt)+2<NT){WAIT_BAR(1);} else {WAIT_BAR(0);} }while(0)
  for(;t+1<NT;t+=2){
    STEP(pB0,pB1,pA0,pA1,t,(t+3<NT),(t+1<NT),(t+1<NT),false);       ENDW(t);   RESC(); ROT();
    STEP(pA0,pA1,pB0,pB1,t+1,(t+4<NT),(t+2<NT),(t+2<NT),false);     ENDW(t+1); RESC(); ROT();
  }
  STEP(pB0,pB1,pA0,pA1,NT-1,false,false,false,false); RESC();
  { float sacc=pB0[0]+pB0[1]; _Pragma("unroll") for(int r=2;r<16;++r)sacc+=pB0[r]; _Pragma("unroll") for(int r=0;r<16;++r)sacc+=pB1[r]; l_reg+=sacc;
    pw0=(u32x4){PKW(pB0,0),PKW(pB0,2),PKW(pB0,4),PKW(pB0,6)};pw1=(u32x4){PKW(pB0,8),PKW(pB0,10),PKW(pB0,12),PKW(pB0,14)};pw2=(u32x4){PKW(pB1,0),PKW(pB1,2),PKW(pB1,4),PKW(pB1,6)};pw3=(u32x4){PKW(pB1,8),PKW(pB1,10),PKW(pB1,12),PKW(pB1,14)};
    SBAR(); pv(o,vb0+sl_cur,PAF(0),PAF(1),PAF(2),PAF(3)); }
  #undef PKW
  #undef PAF
  #undef VFR
  #undef PIN
  #undef MX3
  #undef GAPA
  #undef GAPB
  #undef EX
  #undef VRD
  #undef KRD
  #undef STEP
  #undef ENDW
  {auto rr=__builtin_amdgcn_permlane32_swap(__float_as_uint(l_reg),__float_as_uint(l_reg),false,false);l_reg=__uint_as_float(rr[0])+__uint_as_float(rr[1]);}
  if(hi==0)wsf[32+r32]=l_reg;asm volatile("s_waitcnt lgkmcnt(0)":::"memory");
  float rli[16];
  #pragma unroll
  for(int r=0;r<16;++r)rli[r]=__builtin_amdgcn_rcpf(wsf[32+crow(r,hi)]);
  bf16*Ow=O+(rowbase+q0+wid*QBLK)*OP+h*D; float*ssw=ssa+(rowbase+q0+wid*QBLK)*8+h;
  { bf16*stg=(bf16*)(shm+LDS_OST)+wid*2048;
    #pragma unroll
    for(int r=0;r<16;++r){const int orow=crow(r,hi);
      #pragma unroll
      for(int d0=0;d0<2;++d0)stg[orow*64+d0*32+r32]=__float2bfloat16(o[d0][r]*rli[r]);}
    asm volatile("s_waitcnt lgkmcnt(0)":::"memory");
    #pragma unroll
    for(int i=0;i<4;++i){const int row=i*8+(lane>>3),ch=lane&7; const u32x4 v=*(const u32x4*)(stg+row*64+ch*8); ATTN_STORE16(Ow+(long)row*OP+ch*8,v);
      float sq=0.f; _Pragma("unroll") for(int e=0;e<4;++e){ const float lo=__uint_as_float(v[e]<<16), hi_=__uint_as_float(v[e]&0xffff0000u); sq+=lo*lo+hi_*hi_; }
      sq+=__shfl_xor(sq,1); sq+=__shfl_xor(sq,2); sq+=__shfl_xor(sq,4); if(ch==0) *(__attribute__((address_space(1))) float*)(ssw+(long)row*8)=sq; } }
  asm volatile("s_waitcnt lgkmcnt(0)\n\ts_barrier":::"memory");
  #undef DMA_K
  #undef DMA_V
  #undef CMASK
  #undef MTAB
  #undef START
  #undef RESC
  #undef ROT
}
constexpr int ATTN_LDS_BYTES=LDS_BYTES;
struct AttnTensors { const bf16* Q; const bf16* K; const bf16* V; bf16* O; float* ssa; };
struct AttnUnit { int bh; int qb; };
struct StaticOrder {
  int vcu;
  __device__ __forceinline__ explicit StaticOrder(int vcu_):vcu(vcu_){}
  __device__ __forceinline__ bool next(int i,AttnUnit&u)const{ if(i>=2)return false; const int s=vcu&3; u.bh=vcu>>2; u.qb=(i==0)?s:7-s; return true; }
  __device__ __forceinline__ void a_ready(const AttnUnit&)const{}
  __device__ __forceinline__ void done(const AttnUnit&)const{}
};
template<class Sched,int THRL=8> __device__ __forceinline__ void attn_phase(char*lds,const __attribute__((address_space(3))) float*mtab,const AttnTensors&T,const Sched&S){
  AttnUnit u;
  for(int i=0;S.next(i,u);++i){ S.a_ready(u); attn_unit<THRL>(u.bh/NHEAD,u.bh%NHEAD,u.qb,T.Q,T.K,T.V,T.O,T.ssa,mtab,lds); S.done(u); }
}
#undef SBAR
#undef WAIT_BAR
}
namespace ssm {
#define SLAS __attribute__((address_space(3)))
#define SGAS __attribute__((address_space(1)))
typedef short bf16x8 __attribute__((ext_vector_type(8)));
typedef float f32x4 __attribute__((ext_vector_type(4)));
typedef unsigned u32x4 __attribute__((ext_vector_type(4)));
typedef unsigned u32x2 __attribute__((ext_vector_type(2)));
constexpr int G = 32, GC = 16, SN = 64, CH = 32;
constexpr size_t F_OFF = 0, PF_OFF = 32768, QF_OFF = 32768 + 131072, TBL_BYTES = 32768 + 2 * 131072;
__device__ __forceinline__ unsigned f2bf(float f) { unsigned u = __builtin_bit_cast(unsigned, f); return (u + 0x7fffu + ((u >> 16) & 1u)) >> 16; }
__device__ __forceinline__ unsigned pk2(float lo, float hi) { unsigned r; asm("v_cvt_pk_bf16_f32 %0, %1, %2" : "=v"(r) : "v"(lo), "v"(hi)); return r; }
__device__ __forceinline__ float gelu_tanh(float x) { const float k = 0.7978845608028654f; const float t = k * (x + 0.044715f * x * x * x);
    const float e = __builtin_amdgcn_exp2f(2.0f * 1.4426950408889634f * t); const float th = 1.0f - 2.0f * __builtin_amdgcn_rcpf(1.0f + e); return 0.5f * x * (1.0f + th); }

struct Disc { float ldr, ldi, fr, fi; };
__device__ __forceinline__ Disc disc(float a_re, float a_im, float log_dt) {
    Disc d; const float lr = fminf(a_re, -1e-4f), li = a_im, dt = expf(log_dt);
    d.ldr = lr * dt; d.ldi = li * dt;
    const float mag = expf(d.ldr), sn = sinf(d.ldi), cs = cosf(d.ldi), sh = sinf(0.5f * d.ldi);
    const float em1r = expm1f(d.ldr) * cs - 2.0f * sh * sh;
    const float em1i = mag * sn;
    const float den = lr * lr + li * li;
    d.fr = (em1r * lr + em1i * li) / den; d.fi = (em1i * lr - em1r * li) / den;
    return d;
}

__device__ __forceinline__ void build_tables(int l, int g, int half, const SGAS float* a_re, const SGAS float* a_im, const SGAS float* log_dt, const SGAS float* b_re, const SGAS float* b_im, const SGAS float* c_re, const SGAS float* c_im, const SGAS float* dsk,
                                             SGAS unsigned char* tbl, SGAS float* a32, SGAS float* ssc  , SLAS unsigned char* lds) {
    int tid_ = threadIdx.x; asm volatile("" : "+v"(tid_)); const int tid = tid_;
    SLAS float* pwr = (SLAS float*)lds;
    SLAS float* pwi = pwr + 33 * 64;
    SLAS float* bbr = pwi + 33 * 64;
    SLAS float* bbi = bbr + 1024;
    SLAS float* crT = bbi + 1024;
    SLAS float* ciT = crT + 1024;
    SLAS float* Mt = ciT + 1024;
    SLAS float* dsc = Mt + 8192;
    const int lg = l * G + g;
    if (tid < 64) { const Disc d = disc(a_re[lg * SN + tid], a_im[lg * SN + tid], log_dt[lg]); dsc[tid * 4] = d.ldr; dsc[tid * 4 + 1] = d.ldi; dsc[tid * 4 + 2] = d.fr; dsc[tid * 4 + 3] = d.fi; }
    for (int i = tid; i < 1024; i += 512) { const int c = i >> 6, n = i & 63; crT[n * 16 + c] = c_re[(size_t)lg * 1024 + i]; ciT[n * 16 + c] = c_im[(size_t)lg * 1024 + i]; }
    __syncthreads();
    for (int i = tid; i < 1024; i += 512) { const int n = i >> 4; const float fr = dsc[n * 4 + 2], fi = dsc[n * 4 + 3];
        const float br = b_re[(size_t)lg * 1024 + i], bi = b_im[(size_t)lg * 1024 + i]; bbr[i] = fr * br - fi * bi; bbi[i] = fr * bi + fi * br; }
    for (int i = tid; i < 33 * 64; i += 512) { const int tau = i >> 6, n = i & 63; const float mg = expf(dsc[n * 4] * (float)tau), ang = dsc[n * 4 + 1] * (float)tau; float sn, cs; sincosf(ang, &sn, &cs); pwr[i] = mg * cs; pwi[i] = mg * sn; }
    __syncthreads();
    if (half == 0) {
        if (tid < 64) { a32[(size_t)(lg * SN + tid) * 2] = pwr[32 * 64 + tid]; a32[(size_t)(lg * SN + tid) * 2 + 1] = pwi[32 * 64 + tid];
            SGAS float* sc = ssc + (size_t)(lg * SN + tid) * 36; sc[0] = pwr[64 + tid]; sc[1] = pwi[64 + tid]; sc[2] = 0.f; sc[3] = 0.f;
            for (int c = 0; c < 16; ++c) { sc[4 + c] = bbr[tid * 16 + c]; sc[20 + c] = bbi[tid * 16 + c]; } }
        { const int tau = tid >> 4, cb = (tid >> 2) & 3, pb = tid & 3; f32x4 m0 = {0.f, 0.f, 0.f, 0.f}, m1 = m0, m2 = m0, m3 = m0;
          for (int n = 0; n < 64; ++n) { const float pr = pwr[tau * 64 + n], pi = pwi[tau * 64 + n];
              const f32x4 xr = *(const SLAS f32x4*)(bbr + n * 16 + 4 * pb), xi = *(const SLAS f32x4*)(bbi + n * 16 + 4 * pb);
              const f32x4 er = xr * pr - xi * pi, ei = xi * pr + xr * pi;
              const f32x4 cr = *(const SLAS f32x4*)(crT + n * 16 + 4 * cb), ci = *(const SLAS f32x4*)(ciT + n * 16 + 4 * cb);
              m0 = m0 + er * cr[0] - ei * ci[0]; m1 = m1 + er * cr[1] - ei * ci[1]; m2 = m2 + er * cr[2] - ei * ci[2]; m3 = m3 + er * cr[3] - ei * ci[3]; }
          if (tau == 0 && cb == pb) { m0[0] += dsk[lg * GC + 4 * cb]; m1[1] += dsk[lg * GC + 4 * cb + 1]; m2[2] += dsk[lg * GC + 4 * cb + 2]; m3[3] += dsk[lg * GC + 4 * cb + 3]; }
          SLAS float* mp = Mt + tau * 256 + (4 * cb) * 16 + 4 * pb; *(SLAS f32x4*)mp = m0; *(SLAS f32x4*)(mp + 16) = m1; *(SLAS f32x4*)(mp + 32) = m2; *(SLAS f32x4*)(mp + 48) = m3; }
        __syncthreads();
        for (int i = tid; i < 32 * 64; i += 512) { const int dl = i >> 6, lane = i & 63, c = lane & 15, kg = lane >> 4, tau = dl - (kg >> 1), c0 = 8 * (kg & 1); float v[8];
#pragma unroll
            for (int j = 0; j < 8; ++j) v[j] = (tau >= 0) ? Mt[tau * 256 + c * 16 + c0 + j] : 0.f;
            u32x4 w; w.x = pk2(v[0], v[1]); w.y = pk2(v[2], v[3]); w.z = pk2(v[4], v[5]); w.w = pk2(v[6], v[7]);
            *(SGAS u32x4*)(tbl + F_OFF + (size_t)i * 16) = w; }
        for (int i = tid; i < 8 * 16 * 64; i += 512) { const int nt = i >> 10, p = (i >> 6) & 15, lane = i & 63, np = 16 * nt + (lane & 15), kg = lane >> 4, sp = 2 * p + (kg >> 1), c0 = 8 * (kg & 1), n = np & 63, tau = 31 - sp;
            const float pr = pwr[tau * 64 + n], pi = pwi[tau * 64 + n]; float v[8];
#pragma unroll
            for (int j = 0; j < 8; ++j) { const float xr = bbr[n * 16 + c0 + j], xi = bbi[n * 16 + c0 + j]; v[j] = (np < 64) ? (pr * xr - pi * xi) : (pr * xi + pi * xr); }
            u32x4 w; w.x = pk2(v[0], v[1]); w.y = pk2(v[2], v[3]); w.z = pk2(v[4], v[5]); w.w = pk2(v[6], v[7]);
            *(SGAS u32x4*)(tbl + PF_OFF + (size_t)i * 16) = w; }
    } else {
        for (int i = tid; i < 32 * 4 * 64; i += 512) { const int s = i >> 8, kb = (i >> 6) & 3, lane = i & 63, c = lane & 15, kg = lane >> 4; float v[8];
#pragma unroll
            for (int j = 0; j < 8; ++j) { const int np = 32 * kb + 8 * kg + j, n = np & 63; const float pr = pwr[(s + 1) * 64 + n], pi = pwi[(s + 1) * 64 + n], xr = crT[n * 16 + c], xi = ciT[n * 16 + c];
                v[j] = (np < 64) ? (xr * pr - xi * pi) : -(xr * pi + xi * pr); }
            u32x4 w; w.x = pk2(v[0], v[1]); w.y = pk2(v[2], v[3]); w.z = pk2(v[4], v[5]); w.w = pk2(v[6], v[7]);
            *(SGAS u32x4*)(tbl + QF_OFF + (size_t)i * 16) = w; }
    }
    __syncthreads();
}

constexpr int UST_ROW = 1040, HP_OFF = 66560, HP_ROW = 136, SL_OFF = 83968, SL_ROW = 132, ZST_OFF = 83968, GT_OFF = 150528, PU_LDS_END = 154624;
template <int K_>
__device__ __forceinline__ void y_pass(int h, const bf16x8 (&ff)[16]  , const bf16x8 (&qf)[4][4]  , SLAS unsigned char* lds, int lane) {
    const int j = lane & 15, kg = lane >> 4;
    const SLAS unsigned char* ub = lds + j * UST_ROW + (kg >> 1) * 32 + (kg & 1) * 16;
    const SLAS unsigned char* hb = lds + HP_OFF + (j * HP_ROW + 8 * kg) * 2;
    SLAS unsigned char* zb = lds + ZST_OFF + j * UST_ROW + 8 * kg;
#pragma unroll 1
    for (int ct = 0; ct < 4; ++ct) {
        f32x4 acc[4];
#pragma unroll
        for (int i = 0; i < 4; ++i) acc[i] = (f32x4){0.f, 0.f, 0.f, 0.f};
#pragma unroll
        for (int p = 0; p <= 12 + K_; ++p) {
            const bf16x8 u = *(const SLAS bf16x8*)(ub + ct * 16 * UST_ROW + p * 64);
#pragma unroll
            for (int i = 0; i < 4; ++i) if (p <= 4 * i + K_) acc[i] = __builtin_amdgcn_mfma_f32_16x16x32_bf16(ff[4 * i + K_ - p], u, acc[i], 0, 0, 0);
        }
#pragma unroll
        for (int kb = 0; kb < 4; ++kb) {
            const bf16x8 hpf = *(const SLAS bf16x8*)(hb + ct * 16 * HP_ROW * 2 + kb * 64);
#pragma unroll
            for (int i = 0; i < 4; ++i) acc[i] = __builtin_amdgcn_mfma_f32_16x16x32_bf16(qf[i][kb], hpf, acc[i], 0, 0, 0);
        }
#pragma unroll
        for (int i = 0; i < 4; ++i) { const int s = h + 2 * (4 * i + K_); const f32x4 y = acc[i];
            u32x2 w; w.x = pk2(gelu_tanh(y[0]), gelu_tanh(y[1])); w.y = pk2(gelu_tanh(y[2]), gelu_tanh(y[3]));
            *(SLAS u32x2*)(zb + ct * 16 * UST_ROW + s * 32) = w; }
    }
}

__device__ __forceinline__ void prompt_unit(int g, int b, int l, const SGAS unsigned short* U  , const SGAS unsigned char* tbl_l  , const SGAS float* a32_l, SGAS unsigned short* Zb  , SGAS float* out_re, SGAS float* out_im  ,
                                            SLAS unsigned char* lds) {
    int tid_ = threadIdx.x; asm volatile("" : "+v"(tid_)); const int tid = tid_, lane = tid & 63, wid = __builtin_amdgcn_readfirstlane(tid >> 6), j = lane & 15, kg = lane >> 4;
    const SGAS unsigned char* tbl = tbl_l + (size_t)g * TBL_BYTES;
    SLAS float* SL = (SLAS float*)(lds + SL_OFF); SLAS unsigned short* HP = (SLAS unsigned short*)(lds + HP_OFF);
    const size_t blk = ((size_t)g * 16384 + (size_t)b * 2048) * 16;
    bf16x8 ff[16], qf[4][4];
    { u32x4 v[8];
#pragma unroll
      for (int k = 0; k < 8; ++k) v[k] = *(const SGAS u32x4*)((const SGAS unsigned char*)(U + blk) + (size_t)(tid + 512 * k) * 16);
      bf16x8 pf[16];
#pragma unroll
      for (int p = 0; p < 16; ++p) pf[p] = *(const SGAS bf16x8*)(tbl + PF_OFF + (size_t)((wid * 16 + p) * 64 + lane) * 16);
#pragma unroll
      for (int k = 0; k < 8; ++k) { const int off = (tid + 512 * k) * 16; *(SLAS u32x4*)(lds + (off >> 10) * UST_ROW + (off & 1023)) = v[k]; }
      __syncthreads();
#pragma unroll
      for (int i = 0; i < 16; ++i) ff[i] = *(const SGAS bf16x8*)(tbl + F_OFF + (size_t)((2 * i + (wid & 1)) * 64 + lane) * 16);
#pragma unroll
      for (int i = 0; i < 4; ++i)
#pragma unroll
          for (int kb = 0; kb < 4; ++kb) qf[i][kb] = *(const SGAS bf16x8*)(tbl + QF_OFF + (size_t)((((wid & 1) + 2 * (4 * i + (wid >> 1))) * 4 + kb) * 64 + lane) * 16);
      const SLAS unsigned char* ub = lds + j * UST_ROW + (kg >> 1) * 32 + (kg & 1) * 16;
#pragma unroll 1
      for (int ct = 0; ct < 4; ++ct) { f32x4 acc = {0.f, 0.f, 0.f, 0.f};
#pragma unroll
          for (int p = 0; p < 16; ++p) { const bf16x8 u = *(const SLAS bf16x8*)(ub + ct * 16 * UST_ROW + p * 64); acc = __builtin_amdgcn_mfma_f32_16x16x32_bf16(pf[p], u, acc, 0, 0, 0); }
          *(SLAS f32x4*)(SL + (16 * ct + j) * SL_ROW + 16 * wid + 4 * kg) = acc; } }
    __syncthreads();
    { const float ar = a32_l[(size_t)(g * SN + lane) * 2], ai = a32_l[(size_t)(g * SN + lane) * 2 + 1];
      SLAS float* GT = (SLAS float*)(lds + GT_OFF);
      float hr = 0.f, hi = 0.f, lr[8], li[8];
#pragma unroll
      for (int k = 0; k < 8; ++k) { lr[k] = hr; li[k] = hi; const int c = 8 * wid + k; const float sr = SL[c * SL_ROW + lane], si = SL[c * SL_ROW + 64 + lane];
          const float nr = ar * hr - ai * hi + sr, ni = ar * hi + ai * hr + si; hr = nr; hi = ni; }
      GT[wid * 128 + lane] = hr; GT[wid * 128 + 64 + lane] = hi;
      float pr = ar, pi = ai;
#pragma unroll
      for (int k = 0; k < 3; ++k) { const float nr = pr * pr - pi * pi, ni = 2.0f * pr * pi; pr = nr; pi = ni; }
      __syncthreads();
      float cr = 0.f, ci = 0.f;
      for (int w = 0; w < 8; ++w) { if (w == wid) break; const float tr = GT[w * 128 + lane], ti = GT[w * 128 + 64 + lane]; const float nr = pr * cr - pi * ci + tr, ni = pr * ci + pi * cr + ti; cr = nr; ci = ni; }
      float qr = 1.f, qi = 0.f;
#pragma unroll
      for (int k = 0; k < 8; ++k) { const int c = 8 * wid + k; const float vr = lr[k] + qr * cr - qi * ci, vi = li[k] + qr * ci + qi * cr;
          HP[c * HP_ROW + lane] = (unsigned short)f2bf(vr); HP[c * HP_ROW + 64 + lane] = (unsigned short)f2bf(vi);
          const float nr = qr * ar - qi * ai, ni = qr * ai + qi * ar; qr = nr; qi = ni; }
      if (wid == 7) { const float fr_ = hr + qr * cr - qi * ci, fi_ = hi + qr * ci + qi * cr;
          out_re[(size_t)(b * G + g) * SN + lane] = fr_; out_im[(size_t)(b * G + g) * SN + lane] = fi_; } }
    __syncthreads();
    { const int h = wid & 1, k4 = wid >> 1;
      if (k4 == 0) y_pass<0>(h, ff, qf, lds, lane); else if (k4 == 1) y_pass<1>(h, ff, qf, lds, lane); else if (k4 == 2) y_pass<2>(h, ff, qf, lds, lane); else y_pass<3>(h, ff, qf, lds, lane); }
    __syncthreads();
#pragma unroll
    for (int k = 0; k < 8; ++k) { const int off = (tid + 512 * k) * 16; const u32x4 v = *(const SLAS u32x4*)(lds + ZST_OFF + (off >> 10) * UST_ROW + (off & 1023)); *(SGAS u32x4*)((SGAS unsigned char*)(Zb + blk) + off) = v; }
    __syncthreads();
}

__device__ __forceinline__ void sample_unit(int b, int g, int l, const SGAS float* Us, const SGAS float* h0re, const SGAS float* h0im, const SGAS float* ssc,
                                            const SGAS float* c_re, const SGAS float* c_im, const SGAS float* dsk, SGAS unsigned short* Zb, SGAS float* out_re, SGAS float* out_im, SLAS float* wlds, int lane) {
    const int lg = l * G + g, n = lane;
    const SGAS float* sc = ssc + (size_t)(lg * SN + n) * 36; const float abr = sc[0], abi = sc[1];
    float bbr[16], bbi[16];
#pragma unroll
    for (int c = 0; c < 16; ++c) { bbr[c] = sc[4 + c]; bbi[c] = sc[20 + c]; }
    float hr = h0re[(size_t)(b * G + g) * SN + n], hi = h0im[(size_t)(b * G + g) * SN + n];
#pragma unroll
    for (int t = 0; t < 8; ++t) { const SGAS float* up = Us + (size_t)(b * 8 + t) * 512 + g * 16; float ur = 0.f, ui = 0.f;
#pragma unroll
        for (int c = 0; c < 16; ++c) { const float u = up[c]; ur += bbr[c] * u; ui += bbi[c] * u; }
        const float nr = abr * hr - abi * hi + ur, ni = abr * hi + abi * hr + ui; hr = nr; hi = ni;
        wlds[t * 128 + n] = hr; wlds[t * 128 + 64 + n] = hi; }
    out_re[(size_t)(b * G + g) * SN + n] = hr; out_im[(size_t)(b * G + g) * SN + n] = hi;
    SLAS float* cl = wlds + 1024;
#pragma unroll
    for (int i = 0; i < 16; ++i) { cl[i * 65 + lane] = c_re[(size_t)(lg * GC + i) * SN + lane]; cl[(16 + i) * 65 + lane] = c_im[(size_t)(lg * GC + i) * SN + lane]; }
    asm volatile("s_waitcnt lgkmcnt(0)" ::: "memory");
    const int t = lane >> 3, c0 = 2 * (lane & 7); float y0 = 0.f, y1 = 0.f;
    for (int m = 0; m < 64; ++m) { const float xr = wlds[t * 128 + m], xi = wlds[t * 128 + 64 + m]; y0 += xr * cl[c0 * 65 + m] - xi * cl[(16 + c0) * 65 + m]; y1 += xr * cl[(c0 + 1) * 65 + m] - xi * cl[(17 + c0) * 65 + m]; }
    const SGAS float* up = Us + (size_t)(b * 8 + t) * 512 + g * 16 + c0;
    y0 += dsk[lg * GC + c0] * up[0]; y1 += dsk[lg * GC + c0 + 1] * up[1];
    *(SGAS unsigned*)(Zb + ((size_t)16384 + b * 8 + t) * 512 + g * 16 + c0) = pk2(gelu_tanh(y0), gelu_tanh(y1));
    asm volatile("s_waitcnt lgkmcnt(0)" ::: "memory");
}
#undef SLAS
#undef SGAS
}
namespace mini {
typedef unsigned short bf16_t;
typedef short bf16x8 __attribute__((ext_vector_type(8)));
typedef float f32x4 __attribute__((ext_vector_type(4)));
typedef unsigned u32x2 __attribute__((ext_vector_type(2)));
#define MLAS __attribute__((address_space(3)))
constexpr int PART_W = 32 * 64;
__device__ __forceinline__ u32x2 pack4(const f32x4 a) { u32x2 w; w.x = pg8::cvt_pk_bf16(a[0], a[1]); w.y = pg8::cvt_pk_bf16(a[2], a[3]); return w; }
__device__ __forceinline__ f32x4 sumw(const MLAS float* p, int w0, int w1) { f32x4 s = {0.f, 0.f, 0.f, 0.f};
#pragma unroll
    for (int w = w0; w < w1; ++w) s = s + *(const MLAS f32x4*)(p + w * PART_W); return s; }
__device__ __forceinline__ float red16(float v) { v += __shfl_xor(v, 1); v += __shfl_xor(v, 2); v += __shfl_xor(v, 4); v += __shfl_xor(v, 8); return v; }
__device__ __forceinline__ float sq4(const f32x4 a) { return (a[0] * a[0] + a[1] * a[1]) + (a[2] * a[2] + a[3] * a[3]); }

template <int K, class Epi>
__device__ __forceinline__ void unit(const GAS bf16_t* A  , const GAS bf16_t* Bt  , int rb, int ngroups, MLAS float* part, const Epi& epi0) {
    int tid_ = threadIdx.x; asm volatile("" : "+v"(tid_)); const int tid = tid_, lane = tid & 63, wid = __builtin_amdgcn_readfirstlane(tid >> 6), j = lane & 15, kg = lane >> 4;
    constexpr int KS = K / 8, NK = KS / 32, CH = 4, NCH = (NK + CH - 1) / CH;
    const int kbase = wid * KS + 8 * kg;
    const GAS bf16_t* a0 = A + (size_t)(rb * 32 + j) * K + kbase; const GAS bf16_t* a1 = a0 + (size_t)16 * K;
    Epi epi = epi0; epi.prep(rb * 32 + (tid >> 4));
    bf16x8 af[CH][2], bf[CH][4];
#define MINI_LOAD(g_, c_) do { _Pragma("unroll") for (int q = 0; q < CH; ++q) if ((c_) * CH + q < NK) { const int ks = (c_) * CH + q; af[q][0] = *(const GAS bf16x8*)(a0 + 32 * ks); af[q][1] = *(const GAS bf16x8*)(a1 + 32 * ks); \
        _Pragma("unroll") for (int ct = 0; ct < 4; ++ct) bf[q][ct] = *(const GAS bf16x8*)(Bt + (size_t)epi.brow((g_), 16 * ct + j) * K + kbase + 32 * ks); } } while (0)
    MINI_LOAD(0, 0);
#pragma unroll 1
    for (int g = 0; g < ngroups; ++g) {
        f32x4 acc[2][4];
#pragma unroll
        for (int rt = 0; rt < 2; ++rt)
#pragma unroll
            for (int ct = 0; ct < 4; ++ct) acc[rt][ct] = (f32x4){0.f, 0.f, 0.f, 0.f};
#pragma unroll
        for (int c = 0; c < NCH; ++c) {
            __builtin_amdgcn_sched_barrier(0);
#pragma unroll
            for (int q = 0; q < CH; ++q) if (c * CH + q < NK) {
#pragma unroll
                for (int ct = 0; ct < 4; ++ct) { acc[0][ct] = __builtin_amdgcn_mfma_f32_16x16x32_bf16(bf[q][ct], af[q][0], acc[0][ct], 0, 0, 0); acc[1][ct] = __builtin_amdgcn_mfma_f32_16x16x32_bf16(bf[q][ct], af[q][1], acc[1][ct], 0, 0, 0); } }
            __builtin_amdgcn_sched_barrier(0);
            if (c + 1 < NCH) MINI_LOAD(g, c + 1); else if (g + 1 < ngroups) MINI_LOAD(g + 1, 0);
            __builtin_amdgcn_sched_barrier(0);
        }
#pragma unroll
        for (int rt = 0; rt < 2; ++rt)
#pragma unroll
            for (int ct = 0; ct < 4; ++ct) *(MLAS f32x4*)(part + (wid * 32 + 16 * rt + j) * 64 + 16 * ct + 4 * kg) = acc[rt][ct];
        __syncthreads();
        epi.reduce(g, rb * 32 + (tid >> 4), (tid & 15) * 4, part + (tid >> 4) * 64 + (tid & 15) * 4);
        __syncthreads();
    }
#undef MINI_LOAD
}

constexpr float QS = 0.125f * 1.4426950408889634f, EPSN = 1e-6f;
struct E1 {
    GAS unsigned char* ws; GAS float* out; int l, cb; float r;
    __device__ __forceinline__ void prep(int srow) { r = __builtin_amdgcn_rsqf(pg8::sum16((const GAS float*)(pg8::lau(ws) + WS_SS1) + (size_t)(MP + srow) * 16) * (1.0f / 1024.0f) + EPSN); }
    __device__ __forceinline__ int brow(int, int c) const { return 64 * cb + c; }
    __device__ __forceinline__ void reduce(int, int srow, int c4, const MLAS float* p) const {
        GAS unsigned char* w = pg8::lau(ws); const int row = MP + srow, col = 64 * cb + c4, seg = col >> 9, c = col & 511;
        const f32x4 v = sumw(p, 0, 8) * r;
        if (seg == 0) { *(GAS u32x2*)((GAS bf16_t*)(w + WS_QB) + (size_t)row * 512 + c) = pack4(v * QS); }
        else if (seg == 3) { *(GAS f32x4*)((GAS float*)(w + WS_US) + (size_t)srow * 512 + c) = v; }
        else { *(GAS u32x2*)((GAS bf16_t*)(w + (seg == 1 ? WS_KB : WS_VB)) + (size_t)row * 512 + c) = pack4(v);
               *(GAS f32x4*)(pg8::lauf(out) + (seg == 1 ? O_SK : O_SV) + (size_t)l * MS * 512 + (size_t)srow * 512 + c) = v; }
    }
};
struct E3 {
    GAS unsigned char* ws; const GAS float* bias; int cb;
    __device__ __forceinline__ void prep(int) {}
    __device__ __forceinline__ int brow(int, int c) const { return 64 * cb + c; }
    __device__ __forceinline__ void reduce(int, int srow, int c4, const MLAS float* p) const {
        GAS unsigned char* w = pg8::lau(ws); const int row = MP + srow, col = 64 * cb + c4;
        const f32x4 a = sumw(p, 0, 8) + *(const GAS f32x4*)(bias + col);
        const u32x2 zz = *(const GAS u32x2*)((const GAS bf16_t*)(w + WS_ZB) + (size_t)row * 512 + col);
        f32x4 z; z[0] = __uint_as_float(zz.x << 16); z[1] = __uint_as_float(zz.x & 0xffff0000u); z[2] = __uint_as_float(zz.y << 16); z[3] = __uint_as_float(zz.y & 0xffff0000u);
        f32x4 o;
#pragma unroll
        for (int e = 0; e < 4; ++e) o[e] = z[e] * __builtin_amdgcn_rcpf(1.0f + __builtin_amdgcn_exp2f(-1.4426950408889634f * a[e]));
        *(GAS u32x2*)((GAS bf16_t*)(w + WS_MIX) + (size_t)row * 1024 + 512 + col) = pack4(o);
        const float part = red16(sq4(o)); if ((c4 >> 2) == 0) ((GAS float*)(w + WS_SSS))[(size_t)row * 8 + cb] = part;
    }
};
struct E4 {
    GAS unsigned char* ws; int cb; float ra, rs;
    __device__ __forceinline__ void prep(int srow) { GAS unsigned char* w = pg8::lau(ws); const int row = MP + srow;
        ra = __builtin_amdgcn_rsqf(pg8::sum8((const GAS float*)(w + WS_SSA) + (size_t)row * 8) * (1.0f / 512.0f) + EPSN); rs = __builtin_amdgcn_rsqf(pg8::sum8((const GAS float*)(w + WS_SSS) + (size_t)row * 8) * (1.0f / 512.0f) + EPSN); }
    __device__ __forceinline__ int brow(int, int c) const { return 64 * cb + c; }
    __device__ __forceinline__ void reduce(int, int srow, int c4, const MLAS float* p) const {
        GAS unsigned char* w = pg8::lau(ws); const int row = MP + srow, col = 64 * cb + c4;
        const f32x4 mixed = sumw(p, 0, 4) * ra + sumw(p, 4, 8) * rs;
        GAS bf16_t* xr = (GAS bf16_t*)(w + WS_XB) + (size_t)row * 1024 + col; const u32x2 xx = *(const GAS u32x2*)xr;
        f32x4 x; x[0] = __uint_as_float(xx.x << 16); x[1] = __uint_as_float(xx.x & 0xffff0000u); x[2] = __uint_as_float(xx.y << 16); x[3] = __uint_as_float(xx.y & 0xffff0000u);
        const f32x4 h = x + mixed; *(GAS u32x2*)xr = pack4(h);
        const float part = red16(sq4(h)); if ((c4 >> 2) == 0) ((GAS float*)(w + WS_SS2))[(size_t)row * 16 + cb] = part;
    }
};
struct E5 {
    GAS unsigned char* ws; int q0; float r;
    __device__ __forceinline__ void prep(int srow) { r = __builtin_amdgcn_rsqf(pg8::sum16((const GAS float*)(pg8::lau(ws) + WS_SS2) + (size_t)(MP + srow) * 16) * (1.0f / 1024.0f) + EPSN); }
    __device__ __forceinline__ int brow(int g, int c) const { const int q = q0 + 16 * g; return 256 * (q >> 2) + ((c < 32) ? 32 * (q & 3) + c : 128 + 32 * (q & 3) + (c - 32)); }
    __device__ __forceinline__ void reduce(int g, int srow, int c4, const MLAS float* p) const {
        if (c4 >= 32) return;
        GAS unsigned char* w = pg8::lau(ws); const int row = MP + srow, q = q0 + 16 * g;
        const f32x4 gt = sumw(p, 0, 8) * r, up = sumw(p + 32, 0, 8) * r; f32x4 o;
#pragma unroll
        for (int e = 0; e < 4; ++e) o[e] = gt[e] * up[e] * __builtin_amdgcn_rcpf(1.0f + __builtin_amdgcn_exp2f(-1.4426950408889634f * gt[e]));
        *(GAS u32x2*)((GAS bf16_t*)(w + WS_GB) + (size_t)row * 2816 + 128 * (q >> 2) + 32 * (q & 3) + c4) = pack4(o);
    }
};
struct E6 {
    GAS unsigned char* ws; int cb;
    __device__ __forceinline__ void prep(int) {}
    __device__ __forceinline__ int brow(int, int c) const { return 64 * cb + c; }
    __device__ __forceinline__ void reduce(int, int srow, int c4, const MLAS float* p) const {
        GAS unsigned char* w = pg8::lau(ws); const int row = MP + srow, col = 64 * cb + c4;
        GAS bf16_t* xr = (GAS bf16_t*)(w + WS_XB) + (size_t)row * 1024 + col; const u32x2 xx = *(const GAS u32x2*)xr;
        f32x4 x; x[0] = __uint_as_float(xx.x << 16); x[1] = __uint_as_float(xx.x & 0xffff0000u); x[2] = __uint_as_float(xx.y << 16); x[3] = __uint_as_float(xx.y & 0xffff0000u);
        const f32x4 y = x + sumw(p, 0, 8); *(GAS u32x2*)xr = pack4(y);
        const float part = red16(sq4(y)); if ((c4 >> 2) == 0) ((GAS float*)(w + WS_SS1))[(size_t)row * 16 + cb] = part;
    }
};
#undef MLAS
}
#define XB_TMO      128
#define XB_XCNT(j)  (256  + 64 * (j))
#define XB_XSUB(j)  (1280 + 64 * (j))
#define XB_XGEN(j)  (2304 + 64 * (j))
#define XB_TOP      3328
#define XB_TOPGEN   3392
#define XCD_BAR_WORDS 3456
#define XB_SPIN_CAP (1u << 18)

__device__ __forceinline__ unsigned xb_ld(unsigned* p)              { return __hip_atomic_load((GAS unsigned*)p, __ATOMIC_RELAXED, __HIP_MEMORY_SCOPE_AGENT); }
__device__ __forceinline__ unsigned xb_add(unsigned* p, unsigned v) { return __hip_atomic_fetch_add((GAS unsigned*)p, v, __ATOMIC_RELAXED, __HIP_MEMORY_SCOPE_AGENT); }
__device__ __forceinline__ unsigned xb_xcc_id() { return (unsigned)__builtin_amdgcn_s_getreg((3 << 11) | 20) & 0xFu; }
#define XB_SPIN(cond, bar) do { unsigned _sp = 0; while (cond) { __builtin_amdgcn_s_sleep(1); \
    if ((++_sp & 255u) == 0u) { if (xb_ld(&(bar)[XB_TMO])) break; if (_sp > XB_SPIN_CAP) { atomicAdd(&(bar)[XB_TMO], 1u); break; } } } } while (0)

struct XcdBarrier {
    unsigned* bar; unsigned x;
    volatile LAS unsigned* st;
};

__device__ __forceinline__ XcdBarrier xcd_barrier_post(unsigned* bar, volatile LAS unsigned* st) {
    XcdBarrier b; b.bar = bar; b.x = xb_xcc_id(); b.st = st;
    if (threadIdx.x == 0) (void)xb_add(&bar[XB_XCNT(b.x)], 1u);
    return b;
}
__device__ __forceinline__ void xcd_barrier_complete(unsigned* bar, unsigned x, unsigned& nloc, unsigned& nx) {
    const unsigned G = gridDim.x * gridDim.y * gridDim.z;
    unsigned sum, cnt, mine, sp = 0u;
    for (;;) {
        sum = 0u; cnt = 0u; mine = 0u;
#pragma unroll
        for (unsigned j = 0; j < 16; ++j) { const unsigned c = xb_ld(&bar[XB_XCNT(j)]); sum += c; cnt += (c > 0u) ? 1u : 0u; mine = (j == x) ? c : mine; }
        if (sum == G) break;
        __builtin_amdgcn_s_sleep(1);
        if ((++sp & 255u) == 0u) { if (xb_ld(&bar[XB_TMO])) break; if (sp > XB_SPIN_CAP) { atomicAdd(&bar[XB_TMO], 1u); break; } }
    }
    nloc = mine > 0u ? mine : 1u; nx = cnt > 0u ? cnt : 1u;
}

__device__ __forceinline__ void xcd_barrier(const XcdBarrier& b) {
    asm volatile("s_waitcnt vmcnt(0)" ::: "memory");
    __syncthreads();
    if (threadIdx.x == 0) {
        unsigned* bar = b.bar;
        __builtin_amdgcn_s_waitcnt(0);
        unsigned nloc = b.st[0], nx = b.st[1];
        if (nloc == 0u) { xcd_barrier_complete(bar, b.x, nloc, nx); b.st[0] = nloc; b.st[1] = nx; }
        const unsigned old = xb_add(&bar[XB_XSUB(b.x)], 1u);
        const unsigned gen = old / nloc;
        if (old + 1u == (gen + 1u) * nloc) {
            __builtin_amdgcn_fence(__ATOMIC_RELEASE, "agent");
            asm volatile("s_waitcnt vmcnt(0)" ::: "memory");
            const unsigned og = xb_add(&bar[XB_TOP], 1u);
            const unsigned tg = og / nx;
            if (og + 1u == (tg + 1u) * nx) xb_add(&bar[XB_TOPGEN], 1u);
            else XB_SPIN(xb_ld(&bar[XB_TOPGEN]) == tg, bar);
            __builtin_amdgcn_fence(__ATOMIC_ACQUIRE, "agent");
            xb_add(&bar[XB_XGEN(b.x)], 1u);
            asm volatile("s_waitcnt vmcnt(0)" ::: "memory");
        } else {
            XB_SPIN(xb_ld(&bar[XB_XGEN(b.x)]) == gen, bar);
            __builtin_amdgcn_fence(__ATOMIC_ACQUIRE, "agent");
            asm volatile("s_waitcnt vmcnt(0)" ::: "memory");
        }
    }
    __syncthreads();
}

__device__ __forceinline__ void xcc_local_barrier(unsigned* bar, unsigned* cnt, unsigned n) {
    asm volatile("s_waitcnt vmcnt(0)" ::: "memory");
    __syncthreads();
    if (threadIdx.x == 0) {
        __builtin_amdgcn_s_waitcnt(0);
#if EARLY_INV
        __builtin_amdgcn_fence(__ATOMIC_ACQUIRE, "agent");
        const unsigned old = xb_add(cnt, 1u);
        const unsigned tgt = (old / n + 1u) * n;
        if (old + 1u != tgt) XB_SPIN(xb_ld(cnt) < tgt, bar);
        asm volatile("s_waitcnt vmcnt(0)" ::: "memory");
#else
        const unsigned old = xb_add(cnt, 1u);
        const unsigned tgt = (old / n + 1u) * n;
        XB_SPIN(xb_ld(cnt) < tgt, bar);
        __builtin_amdgcn_fence(__ATOMIC_ACQUIRE, "agent");
        asm volatile("s_waitcnt vmcnt(0)" ::: "memory");
#endif
    }
    __syncthreads();
}

__device__ __forceinline__ void xcc_signal(unsigned* cnt, unsigned same_l2) {
    asm volatile("s_waitcnt vmcnt(0)" ::: "memory");
    __syncthreads();
    if (threadIdx.x == 0) {
        if (!same_l2) { __builtin_amdgcn_fence(__ATOMIC_RELEASE, "agent"); asm volatile("s_waitcnt vmcnt(0)" ::: "memory"); }
        (void)xb_add(cnt, 1u);
    }
}
__device__ __forceinline__ void xcc_wait(unsigned* bar, unsigned* cnt, unsigned target) {
    asm volatile("s_waitcnt vmcnt(0)" ::: "memory");
    __syncthreads();
    if (threadIdx.x == 0) {
        __builtin_amdgcn_fence(__ATOMIC_ACQUIRE, "agent");
        XB_SPIN(xb_ld(cnt) < target, bar);
        asm volatile("s_waitcnt vmcnt(0)" ::: "memory");
    }
    __syncthreads();
}
static_assert(WS_WIN + (size_t)NLAYER * INW_ * DM_ * 2 <= WS_WOUT && WS_WOUT + (size_t)NLAYER * DM_ * DM_ * 2 <= WS_WGU && WS_WGU + (size_t)NLAYER * 2 * FF_ * DM_ * 2 <= WS_WDN &&
              WS_WDN + (size_t)NLAYER * DM_ * FF_ * 2 <= WS_WGLU && WS_WGLU + (size_t)NLAYER * 512 * 512 * 2 <= WS_SSMT && WS_SSMT + (size_t)NLAYER * 32 * ssm::TBL_BYTES <= WS_A32 &&
              WS_XRES + (size_t)MT * DM_ * 4 <= WS_XB && WS_XB + (size_t)MT * DM_ * 2 <= WS_QB && WS_QB + (size_t)MT * 512 * 2 <= WS_KB && WS_KB + (size_t)MT * 512 * 2 <= WS_VB &&
              WS_VB + (size_t)MT * 512 * 2 <= WS_UB && WS_UB + (size_t)32 * MP * 16 * 2 <= WS_US && WS_US + (size_t)MS * 512 * 4 <= WS_MIX && WS_MIX + (size_t)MT * 1024 * 2 <= WS_ZB &&
              WS_ZB + (size_t)MT * 512 * 2 <= WS_GB && WS_GB + (size_t)MT * FF_ * 2 <= WS_SS1 && WS_SS1 + (size_t)MT * 16 * 4 <= WS_SS2 && WS_SS2 + (size_t)MT * 16 * 4 <= WS_SSA &&
              WS_SSA + (size_t)MT * 8 * 4 <= WS_SSS && WS_SSS + (size_t)MT * 8 * 4 <= WS_SSC && WS_SSC + (size_t)NLAYER * 32 * 64 * 36 * 4 <= WS_END, "d_ws map");
static_assert(attn_body::LDS_BYTES <= MTAB_OFF && MTAB_OFF + MTAB_N * 4 <= RING_BYTES, "attention LDS");
static_assert(ssm::PU_LDS_END <= RTAB_OFF && RING_BYTES <= RTAB_OFF && PTAB_OFF + 27 * 8 <= LDS_BYTES, "LDS map");
struct Frame {
    LAS unsigned char* lds; volatile LAS unsigned* MISC; gu32* ctl; int tid, lane, wave, vcu, G;
};

__device__ __forceinline__ void p0_transpose_item(const GAS float* W, int K, int N, GAS bf16* WT, int k0, int n0, int drow0, const GAS float* scale, LAS float* scr, int lane) {
    float wv[32];
#pragma unroll
    for (int i = 0; i < 32; ++i) wv[i] = W[(size_t)(k0 + 2 * i + (lane >> 5)) * N + n0 + (lane & 31)];
#pragma unroll
    for (int i = 0; i < 32; ++i) { const int kk = 2 * i + (lane >> 5); const float sc = scale ? scale[k0 + kk] : 1.0f; scr[kk * 33 + (lane & 31)] = wv[i] * sc; }
    LDS_WAIT(); asm volatile("" ::: "memory");
    const int c = lane & 7;
#pragma unroll
    for (int j = 0; j < 4; ++j) { const int n = (lane >> 3) + 8 * j; const LAS float* s = scr + (8 * c) * 33 + n;
        v4u o; o.x = pk2(s[0 * 33], s[1 * 33]); o.y = pk2(s[2 * 33], s[3 * 33]); o.z = pk2(s[4 * 33], s[5 * 33]); o.w = pk2(s[6 * 33], s[7 * 33]);
        *(GAS v4u*)(WT + (size_t)(drow0 + n) * K + k0 + 8 * c) = o; }
    LDS_WAIT(); asm volatile("" ::: "memory");
}

#define SA_DPP(v, ctrl) __int_as_float(__builtin_amdgcn_update_dpp(0, __float_as_int(v), (ctrl), 0xF, 0xF, true))
__device__ __forceinline__ void sattn_unit(int b, int h, const GAS bf16* Qb, const GAS float* ck, const GAS float* cv, const GAS float* newK, const GAS float* newV, GAS bf16* MIX, GAS float* ssa, LAS float* wl, int t, int lane) {
    const int row = MP + b * 8 + t, kq = lane >> 4, dl = lane & 15;
    const GAS unsigned char* ckb = (const GAS unsigned char*)(ck + ((size_t)b * 2048 * 8 + h) * 64); const GAS unsigned char* cvb = (const GAS unsigned char*)(cv + ((size_t)b * 2048 * 8 + h) * 64);
    f32x4 q4; { typedef unsigned u32x2v __attribute__((ext_vector_type(2))); const u32x2v qq = *(const GAS u32x2v*)(Qb + (size_t)row * 512 + h * 64 + 4 * dl);
        q4[0] = __uint_as_float(qq.x << 16); q4[1] = __uint_as_float(qq.x & 0xffff0000u); q4[2] = __uint_as_float(qq.y << 16); q4[3] = __uint_as_float(qq.y & 0xffff0000u); }
#pragma unroll 1
    for (int br = 0; br < 3; ++br) { const int dil = br == 0 ? 1 : (br == 1 ? 4 : 16);
#pragma unroll 1
      for (int i0 = 0; i0 < 34; i0 += 17) {
        float sc[17];
        const unsigned o0 = ((unsigned)(2048 + t - ((4 * i0 + kq) << (2 * br))) << 11) + 16u * dl, str = 8192u << (2 * br);
#pragma unroll
        for (int ii = 0; ii < 17; ++ii) { f32x4 kv;
            if (ii >= 2 && ii < 15) kv = *(const GAS f32x4*)(ckb + (o0 - (unsigned)ii * str));
            else { const int i = i0 + ii; const int jj = min(4 * i + kq, 128);
                const int idx = 2048 + t - dil * jj;
                const GAS float* kp = (idx < 2048) ? ck + (((size_t)b * 2048 + idx) * 8 + h) * 64 : newK + ((size_t)(b * 8 + idx - 2048) * 512 + h * 64);
                kv = *(const GAS f32x4*)(kp + 4 * dl); }
            sc[ii] = (kv[0] * q4[0] + kv[1] * q4[1]) + (kv[2] * q4[2] + kv[3] * q4[3]); }
#pragma unroll
        for (int ii = 0; ii < 17; ++ii) { float a = sc[ii]; a += SA_DPP(a, 0xB1); a += SA_DPP(a, 0x4E); a += SA_DPP(a, 0x141); a += SA_DPP(a, 0x140);
            const int jj = 4 * (i0 + ii) + kq; if (dl == 0 && jj <= 128) wl[br * 192 + jj] = a; } } }
    LDS_WAIT();
    float m = -INFINITY;
#pragma unroll 1
    for (int i = lane; i < 576; i += 64) { const int jj = i % 192; if (jj <= 128) m = fmaxf(m, wl[i]); }
    m = wave_max(m);
    float den = 0.f;
#pragma unroll 1
    for (int i = lane; i < 576; i += 64) { const int jj = i % 192; if (jj <= 128) { const float p = __builtin_amdgcn_exp2f(wl[i] - m); den += p; wl[i] = p; } }
    den = wave_sum(den);
    LDS_WAIT();
    f32x4 acc = {0.f, 0.f, 0.f, 0.f};
#pragma unroll 1
    for (int br = 0; br < 3; ++br) { const int dil = br == 0 ? 1 : (br == 1 ? 4 : 16);
#pragma unroll 1
      for (int i0 = 0; i0 < 34; i0 += 17) {
        f32x4 vv[17];
        const unsigned o0 = ((unsigned)(2048 + t - ((4 * i0 + kq) << (2 * br))) << 11) + 16u * dl, str = 8192u << (2 * br);
#pragma unroll
        for (int ii = 0; ii < 17; ++ii) {
            if (ii >= 2 && ii < 15) vv[ii] = *(const GAS f32x4*)(cvb + (o0 - (unsigned)ii * str));
            else { const int i = i0 + ii; const int jj = min(4 * i + kq, 128);
                const int idx = 2048 + t - dil * jj;
                const GAS float* vp = (idx < 2048) ? cv + (((size_t)b * 2048 + idx) * 8 + h) * 64 : newV + ((size_t)(b * 8 + idx - 2048) * 512 + h * 64);
                vv[ii] = *(const GAS f32x4*)(vp + 4 * dl); } }
#pragma unroll
        for (int ii = 0; ii < 17; ++ii) { const int jj = 4 * (i0 + ii) + kq; const float p = (jj <= 128) ? wl[br * 192 + jj] : 0.f; acc = acc + vv[ii] * p; } } }
#pragma unroll
    for (int e = 0; e < 4; ++e) { acc[e] += __shfl_xor(acc[e], 16); acc[e] += __shfl_xor(acc[e], 32); }
    const float rd = __builtin_amdgcn_rcpf(den);
    const unsigned w0 = pk2(acc[0] * rd, acc[1] * rd), w1 = pk2(acc[2] * rd, acc[3] * rd);
    const float a0 = __uint_as_float(w0 << 16), a1 = __uint_as_float(w0 & 0xffff0000u), a2 = __uint_as_float(w1 << 16), a3 = __uint_as_float(w1 & 0xffff0000u);
    float sq = (a0 * a0 + a1 * a1) + (a2 * a2 + a3 * a3);
    sq += __shfl_xor(sq, 1); sq += __shfl_xor(sq, 2); sq += __shfl_xor(sq, 4); sq += __shfl_xor(sq, 8);
    if (kq == 0) { typedef unsigned u32x2v __attribute__((ext_vector_type(2))); u32x2v w; w.x = w0; w.y = w1; *(GAS u32x2v*)(MIX + (size_t)row * 1024 + h * 64 + 4 * dl) = w; }
    if (lane == 0) ssa[(size_t)row * 8 + h] = sq;
    LDS_WAIT();
}

#define SATTN_BLOCK() do { \
            for (int rep_ = 0; rep_ < REP2B; ++rep_) { GAS unsigned char* w = WSP(); GAS float* ob = OUTP(); \
            for (int u = F.vcu; u < 256; u += F.G) \
                sattn_unit(u >> 3, F.wave  , (const GAS bf16*)(w + WS_QB), INP(2) + (size_t)l * 32 * 2048 * 512, INP(3) + (size_t)l * 32 * 2048 * 512, ob + O_SK + (size_t)l * MS * 512, ob + O_SV + (size_t)l * MS * 512, \
                           (GAS bf16*)(w + WS_MIX), (GAS float*)(w + WS_SSA), (LAS float*)(LDSP() + F.wave * 4096), u & 7  , LANE()); } \
            __syncthreads(); } while (0)
struct Args { const float* in[26]; float* out; unsigned char* ws; };
__device__ __forceinline__ const GAS float* rfl_ptr(unsigned long long v) { const unsigned lo = __builtin_amdgcn_readfirstlane((unsigned)v), hi = __builtin_amdgcn_readfirstlane((unsigned)(v >> 32)); return (const GAS float*)(((unsigned long long)hi << 32) | lo); }
__global__ void __launch_bounds__(NWAVES * 64, 2) hymba_fwd(Args args) {
    extern __shared__ __attribute__((aligned(16))) unsigned char lds[];
    Frame F;
    F.lds = (LAS unsigned char*)lds; F.MISC = (volatile LAS unsigned*)(F.lds + MISC_OFF);
    F.tid = threadIdx.x; F.lane = F.tid & 63; F.wave = __builtin_amdgcn_readfirstlane(F.tid >> 6);
    F.G = gridDim.x; { const int bx = blockIdx.x; F.vcu = (F.G % 8 == 0) ? (bx % 8) * (F.G / 8) + bx / 8 : bx; }
    GAS unsigned char* const ws = (GAS unsigned char*)args.ws; F.ctl = (gu32*)(ws + WS_CTL);
#if DBG_SET >= 30 && DBG_SET < 60
    for (int u = F.tid; u < LDS_BYTES / 4; u += NWAVES * 64) ((LAS unsigned*)F.lds)[u] = 0xFFFFFFFFu;
    __syncthreads();
#endif
    for (int u = F.tid; u < (LDS_BYTES - MISC_OFF) / 4; u += NWAVES * 64) ((LAS unsigned*)(F.lds + MISC_OFF))[u] = 0u;
    __syncthreads();
    volatile LAS unsigned long long* PT = (volatile LAS unsigned long long*)(F.lds + PTAB_OFF);
    if (F.tid == 0) {
#pragma unroll
        for (int i = 0; i < 26; ++i) PT[i] = (unsigned long long)args.in[i];
        PT[26] = (unsigned long long)args.out;
    }
    __syncthreads();
#define INP(k) rfl_ptr(PT[k])
#define OUTP() ((GAS float*)rfl_ptr(PT[26]))
#define WSP() pg8::lau(ws)
#if DBG_SET >= 60
#define STAMP(k) do { if (blockIdx.x == 0 && threadIdx.x == 0) { GAS unsigned long long* tm_ = (GAS unsigned long long*)(pg8::lau(ws) + WS_CTL + 524288); const unsigned long long now_ = __builtin_amdgcn_s_memrealtime(); tm_[k] += now_ - tm_[31]; tm_[31] = now_; } } while (0)
#else
#define STAMP(k) do {} while (0)
#endif
#define GRID_BAR() for (int rb_ = 0; rb_ < REPB; ++rb_) do { XcdBarrier b_ = bar; asm volatile("" : "+s"(b_.bar), "+s"(b_.x), "+s"(b_.st)); xcd_barrier(b_); } while (0)
#define XCC_BAR() for (int rb_ = 0; rb_ < REPB; ++rb_) do { XcdBarrier b_ = bar; asm volatile("" : "+s"(b_.bar), "+s"(b_.x), "+s"(b_.st)); if (lmode) xcc_local_barrier(b_.bar, b_.bar + (CW_LB - CW_BAR) + 64 * b_.x, 32u); else xcd_barrier(b_); } while (0)
#if S5_BM
#define MIX_BAR() XCC_BAR()
#else
#define MIX_BAR() GRID_BAR()
#endif
#define LDSP() ({ LAS unsigned char* l_ = F.lds; asm volatile("" : "+s"(l_)); l_; })
#define TID() ({ int t_ = threadIdx.x; asm volatile("" : "+v"(t_)); t_; })
#define LANE() ({ int l_ = F.lane; asm volatile("" : "+v"(l_)); l_; })
    XcdBarrier bar = xcd_barrier_post((unsigned*)(F.ctl + CW_BAR), F.MISC + 8);
    if (F.tid == 0) F.MISC[16] = xb_add((unsigned*)(F.ctl + CW_RANK) + 64 * bar.x, 1u);
    LAS pg8::f32x2* RTAB = (LAS pg8::f32x2*)(F.lds + RTAB_OFF);
    const int gw = F.vcu * NWAVES + F.wave, NGW = F.G * NWAVES;

#if DBG_SET >= 60
    if (blockIdx.x == 0 && threadIdx.x == 0) { GAS unsigned long long* tm_ = (GAS unsigned long long*)(pg8::lau(ws) + WS_CTL + 524288); tm_[31] = __builtin_amdgcn_s_memrealtime(); }
#endif
#if PHM & 1
    for (int rep_ = 0; rep_ < REP0; ++rep_) {
        GAS unsigned char* w = WSP();
#pragma unroll 1
        for (int ph0 = 0; ph0 < 2; ++ph0) {
        if (((ph0 ^ F.vcu) & 1) == 0) {
        for (int it2 = F.vcu; it2 < NLAYER * 32 * 2; it2 += F.G) { const int it = it2 >> 1, l = it >> 5, g = it & 31;
            ssm::build_tables(l, g, it2 & 1, INP(9), INP(10), INP(11), INP(12), INP(13), INP(14), INP(15), INP(16), w + WS_SSMT + (size_t)it * ssm::TBL_BYTES, (GAS float*)(w + WS_A32), (GAS float*)(w + WS_SSC), LDSP()); }
        __syncthreads();
        } else {
        LAS float* scr = (LAS float*)(F.lds + RING_OFF + F.wave * 16384);
        GAS bf16* W_IN = (GAS bf16*)(w + WS_WIN); GAS bf16* W_OUT = (GAS bf16*)(w + WS_WOUT); GAS bf16* W_GU = (GAS bf16*)(w + WS_WGU); GAS bf16* W_DN = (GAS bf16*)(w + WS_WDN); GAS bf16* W_GLU = (GAS bf16*)(w + WS_WGLU);
        constexpr int I_IN = 16 * 64, I_OUT = 16 * 32, I_G = 16 * 88, I_DN = 44 * 32, I_GLU = 8 * 16, I_LAYER = I_IN + I_OUT + 2 * I_G + I_DN + I_GLU;
        for (int it = gw; it < NLAYER * I_LAYER; it += NGW) {
            const int l = it / I_LAYER; int r = it % I_LAYER;
            if (r < I_IN) { const int kb = r / 64, nb = r % 64; p0_transpose_item(INP(7) + (size_t)l * 1024 * 2048, 1024, 2048, W_IN + (size_t)l * 2048 * 1024, 64 * kb, 32 * nb, 32 * nb, INP(6) + l * 1024, scr, F.lane); continue; } r -= I_IN;
            if (r < I_OUT) { const int kb = r / 32, nb = r % 32; const GAS float* sc = (kb < 8) ? INP(8) + l * 512 : INP(19) + l * 512 - 512;
                p0_transpose_item(INP(20) + (size_t)l * 1024 * 1024, 1024, 1024, W_OUT + (size_t)l * 1024 * 1024, 64 * kb, 32 * nb, 32 * nb, sc, scr, F.lane); continue; } r -= I_OUT;
            if (r < 2 * I_G) { const int up = r >= I_G; if (up) r -= I_G; const int kb = r / 88, nb = r % 88, n0 = 32 * nb, drow0 = (n0 >> 7) * 256 + up * 128 + (n0 & 127);
                p0_transpose_item((up ? INP(23) : INP(22)) + (size_t)l * 1024 * 2816, 1024, 2816, W_GU + (size_t)l * 5632 * 1024, 64 * kb, n0, drow0, INP(21) + l * 1024, scr, F.lane); continue; } r -= 2 * I_G;
            if (r < I_DN) { const int kb = r / 32, nb = r % 32; p0_transpose_item(INP(24) + (size_t)l * 2816 * 1024, 2816, 1024, W_DN + (size_t)l * 1024 * 2816, 64 * kb, 32 * nb, 32 * nb, nullptr, scr, F.lane); continue; } r -= I_DN;
            { const int kb = r / 16, nb = r % 16; p0_transpose_item(INP(17) + (size_t)l * 512 * 512, 512, 512, W_GLU + (size_t)l * 512 * 512, 64 * kb, 32 * nb, 32 * nb, nullptr, scr, F.lane); }
        }
        __syncthreads();
        } }
        { const GAS float* x_prompt = INP(0); const GAS float* x_sample = INP(1); GAS bf16* XB = (GAS bf16*)(w + WS_XB); GAS float* SS1 = (GAS float*)(w + WS_SS1);
        for (int m0 = 2 * gw; m0 < MT; m0 += 2 * NGW) { f32x4 v[2][4]; float s[2];
#pragma unroll
            for (int q = 0; q < 2; ++q) { const int m = m0 + q; const GAS float* xr = (m < MP) ? x_prompt + (size_t)m * 1024 : x_sample + (size_t)(m - MP) * 1024; const GAS f32x4* xv = (const GAS f32x4*)xr + F.lane;
#pragma unroll
                for (int j = 0; j < 4; ++j) v[q][j] = xv[64 * j]; }
#pragma unroll
            for (int q = 0; q < 2; ++q) { const int m = m0 + q; float t = 0.f;
#pragma unroll
                for (int j = 0; j < 4; ++j) t += (v[q][j].x * v[q][j].x + v[q][j].y * v[q][j].y) + (v[q][j].z * v[q][j].z + v[q][j].w * v[q][j].w);
                s[q] = wave_sum(t);
                GAS unsigned long long* o8 = (GAS unsigned long long*)(XB + (size_t)m * 1024) + F.lane;
#pragma unroll
                for (int j = 0; j < 4; ++j) o8[64 * j] = (unsigned long long)pk2(v[q][j].x, v[q][j].y) | ((unsigned long long)pk2(v[q][j].z, v[q][j].w) << 32);
                if (F.lane < 16) SS1[(size_t)m * 16 + F.lane] = (F.lane == 0) ? s[q] : 0.f; } } }
        GRID_BAR(); STAMP(0);
    }
#endif

    unsigned lmode; int cg;
    {
        if (F.tid == 0) { unsigned ok = (F.G == 256) ? 1u : 0u;
#pragma unroll
            for (unsigned j = 0; j < 16; ++j) { const unsigned c = xb_ld(&bar.bar[XB_XCNT(j)]); ok &= (c == ((j < 8) ? 32u : 0u)) ? 1u : 0u; }
            F.MISC[17] = (XCC_LOCAL && F.MISC[16] < 32u) ? ok : 0u; }
        __syncthreads();
        lmode = __builtin_amdgcn_readfirstlane(F.MISC[17]); const int rank = __builtin_amdgcn_readfirstlane(F.MISC[16]);
        cg = (int)blockIdx.x;
        if (lmode) { F.vcu = (int)bar.x * 32 + rank; cg = rank * 8 + (int)bar.x; }
    }
    unsigned e3_tgt = 0u, e5_tgt = 0u;
#pragma unroll 1
    for (int l = 0; l < NLAYER; ++l) {
#if PHM & 2
        for (int rep_ = 0; rep_ < REP1; ++rep_) {
            GAS unsigned char* w = WSP();
            pg8::Gemm g{(const GAS bf16*)(w + WS_XB), (const GAS bf16*)(w + WS_WIN) + (size_t)l * 2048 * 1024, MP, INW_, 1024}; pg8::StaticOrder S; S.init(MP, INW_, F.G, cg);
            pg8::EpiInProj E{ws, OUTP(), l, RTAB};
            pg8::gemm_phase<pg8::EpiInProj, pg8::StaticOrder, true, true>(LDSP() + RING_OFF, g, S, E);
            {
              mini::unit<1024>((const GAS bf16*)(w + WS_XB) + (size_t)MP * 1024, (const GAS bf16*)(w + WS_WIN) + (size_t)l * 2048 * 1024, cg & 7, 1, (LAS float*)(LDSP() + RING_OFF), mini::E1{ws, OUTP(), l, cg >> 3, 0.f}); }
            MIX_BAR(); STAMP(1);
#if defined(DBG_STOP) && DBG_STOP == 1
            if (l == DBG_STOP_L) return;
#endif
        }
#endif
        {
            LAS float* mtab = nullptr;
#pragma unroll 1
            for (int ph2 = 0; ph2 < 2; ++ph2) {
            if (((ph2 ^ F.vcu) & 1) == 0) {
#if PHM & 4
            for (int rep_ = 0; rep_ < REP2A; ++rep_) { GAS unsigned char* w = WSP();
            unsigned char* wg = (unsigned char*)w; const attn_body::AttnTensors AT{(const attn_body::bf16*)(wg + WS_QB), (const attn_body::bf16*)(wg + WS_KB), (const attn_body::bf16*)(wg + WS_VB), (attn_body::bf16*)(wg + WS_MIX), (float*)(wg + WS_SSA)};
            const attn_body::StaticOrder SA(F.vcu);
            attn_body::attn_phase<attn_body::StaticOrder>((char*)lds + RING_OFF, mtab, AT, SA); }
#endif
            __syncthreads(); STAMP(8);
            } else {
#pragma unroll 1
            for (int q2 = 0; q2 < 2; ++q2) {
            if (((q2 ^ F.vcu) & 1) == 0) {
#if PHM & 8
            for (int rep_ = 0; rep_ < REP2S; ++rep_) { GAS unsigned char* w = WSP(); GAS float* ob = OUTP();
            for (int u = F.vcu; u < 256; u += F.G)
                ssm::prompt_unit(S5_BM ? (u & 31) : (u >> 3), S5_BM ? (u >> 5) : (u & 7), l, (const GAS bf16*)(w + WS_UB), w + WS_SSMT + (size_t)l * 32 * ssm::TBL_BYTES, (const GAS float*)(w + WS_A32) + (size_t)l * 32 * 64 * 2, (GAS bf16*)(w + WS_ZB),
                                 ob + O_PR + (size_t)l * 8 * 32 * 64, ob + O_PI + (size_t)l * 8 * 32 * 64, LDSP()); }
#endif
            __syncthreads(); STAMP(9);
            } else {
#if PHM & 16
            SATTN_BLOCK();
#endif
            __syncthreads(); STAMP(10);
            } } } }
#if PHM & 32
            for (int rep_ = 0; rep_ < REP2C; ++rep_) { GAS unsigned char* w = WSP(); GAS float* ob = OUTP();
            for (int u = F.vcu * 4 + F.wave; u < 1024 && F.wave < 4; u += F.G * 4)
                ssm::sample_unit(u >> 5, u & 31, l, (const GAS float*)(w + WS_US), INP(4) + (size_t)l * 32 * 32 * 64, INP(5) + (size_t)l * 32 * 32 * 64, (const GAS float*)(w + WS_SSC), INP(14), INP(15), INP(16),
                                 (GAS bf16*)(w + WS_ZB), ob + O_SR + (size_t)l * 32 * 32 * 64, ob + O_SI + (size_t)l * 32 * 32 * 64, (LAS float*)(LDSP() + F.wave * 16384), LANE()); }
#endif
            MIX_BAR(); STAMP(2);
#if defined(DBG_STOP) && DBG_STOP == 2
            if (l == DBG_STOP_L) return;
#endif
        }
#if PHM & 64
        for (int rep_ = 0; rep_ < REP3; ++rep_) {
            GAS unsigned char* w = WSP();
            pg8::Gemm g{(const GAS bf16*)(w + WS_ZB), (const GAS bf16*)(w + WS_WGLU) + (size_t)l * 512 * 512, MP, 512, 512}; pg8::StaticOrder S; S.init(MP, 512, F.G, cg);
            pg8::EpiGlu E{ws, INP(18) + l * 512};
            pg8::gemm_phase<pg8::EpiGlu, pg8::StaticOrder, true, true, true>(LDSP() + RING_OFF, g, S, E);
            { const int cr = (cg >> 3) - 16;
              e3_tgt += 8u;
              if (cr >= 0) { unsigned* cnt = (unsigned*)(F.ctl + CW_E3) + 64 * (cg & 7);
                if (cr < 8) { mini::unit<512>((const GAS bf16*)(w + WS_ZB) + (size_t)MP * 512, (const GAS bf16*)(w + WS_WGLU) + (size_t)l * 512 * 512, cg & 7, 1, (LAS float*)(LDSP() + RING_OFF), mini::E3{ws, INP(18) + l * 512, cr});
                              xcc_signal(cnt, lmode); }
                xcc_wait(bar.bar, cnt, e3_tgt);
                mini::unit<1024>((const GAS bf16*)(w + WS_MIX) + (size_t)MP * 1024, (const GAS bf16*)(w + WS_WOUT) + (size_t)l * 1024 * 1024, cg & 7, 1, (LAS float*)(LDSP() + RING_OFF), mini::E4{ws, cr, 0.f, 0.f}); } }
            XCC_BAR(); STAMP(3);
#if defined(DBG_STOP) && DBG_STOP == 3
            if (l == DBG_STOP_L) return;
#endif
        }
#endif
#if PHM & 128
        {
            GAS unsigned char* w = WSP();
            pg8::Gemm g{(const GAS bf16*)(w + WS_MIX), (const GAS bf16*)(w + WS_WOUT) + (size_t)l * 1024 * 1024, MP, 1024, 1024}; pg8::StaticOrder S; S.init(MP, 1024, F.G, cg);
            for (int rep_ = 1; rep_ < REP4; ++rep_) { pg8::EpiWout Ed{ws, RTAB, (size_t)512 * MiB}; pg8::gemm_phase<pg8::EpiWout, pg8::StaticOrder, true, true>(LDSP() + RING_OFF, g, S, Ed); GRID_BAR(); }
            pg8::EpiWout E{ws, RTAB, 0};
            pg8::gemm_phase<pg8::EpiWout, pg8::StaticOrder, true, true>(LDSP() + RING_OFF, g, S, E);
            XCC_BAR(); STAMP(4);
#if defined(DBG_STOP) && DBG_STOP == 4
            if (l == DBG_STOP_L) return;
#endif
        }
#endif
#if PHM & 256
        for (int rep_ = 0; rep_ < REP5; ++rep_) {
            GAS unsigned char* w = WSP();
            pg8::Gemm g{(const GAS bf16*)(w + WS_XB), (const GAS bf16*)(w + WS_WGU) + (size_t)l * 5632 * 1024, MP, 2 * FF_, 1024}; pg8::StaticOrder S; S.init(MP, 2 * FF_, F.G, cg);
            pg8::EpiGateUp E{ws, RTAB};
            pg8::gemm_phase<pg8::EpiGateUp, pg8::StaticOrder, true, true>(LDSP() + RING_OFF, g, S, E);
            {
              e5_tgt += 16u;
              if (cg >= 128) { const int q0 = (cg >> 3) - 16; unsigned* cnt = (unsigned*)(F.ctl + CW_E5) + 64 * (cg & 7);
                mini::unit<1024>((const GAS bf16*)(w + WS_XB) + (size_t)MP * 1024, (const GAS bf16*)(w + WS_WGU) + (size_t)l * 5632 * 1024, cg & 7, (88 - q0 + 15) / 16, (LAS float*)(LDSP() + RING_OFF), mini::E5{ws, q0, 0.f});
                xcc_signal(cnt, lmode); xcc_wait(bar.bar, cnt, e5_tgt);
                mini::unit<2816>((const GAS bf16*)(w + WS_GB) + (size_t)MP * 2816, (const GAS bf16*)(w + WS_WDN) + (size_t)l * 1024 * 2816, cg & 7, 1, (LAS float*)(LDSP() + RING_OFF), mini::E6{ws, q0}); } }
            XCC_BAR(); STAMP(5);
#if defined(DBG_STOP) && DBG_STOP == 5
            if (l == DBG_STOP_L) return;
#endif
        }
#endif
#if PHM & 512
        {
            GAS unsigned char* w = WSP();
            pg8::Gemm g{(const GAS bf16*)(w + WS_GB), (const GAS bf16*)(w + WS_WDN) + (size_t)l * 1024 * 2816, MP, 1024, FF_}; pg8::StaticOrder S; S.init(MP, 1024, F.G, cg);
            for (int rep_ = 1; rep_ < REP6; ++rep_) { pg8::EpiDown Ed{ws, (size_t)512 * MiB}; pg8::gemm_phase<pg8::EpiDown, pg8::StaticOrder, true, true>(LDSP() + RING_OFF, g, S, Ed); GRID_BAR(); }
            pg8::EpiDown E{ws, 0};
            pg8::gemm_phase<pg8::EpiDown, pg8::StaticOrder, true, true>(LDSP() + RING_OFF, g, S, E);
            XCC_BAR(); STAMP(6);
#if defined(DBG_STOP) && DBG_STOP == 6
            if (l == DBG_STOP_L) return;
#endif
        }
#endif
    }
    {
        GAS unsigned char* w = WSP(); GAS float* ob = OUTP();
        const GAS float* fg = INP(25); const GAS float* SS1 = (const GAS float*)(w + WS_SS1); const GAS bf16* XBp = (const GAS bf16*)(w + WS_XB);
        const int lane7 = LANE();
        const int lw7 = (cg >> 3) * NWAVES + F.wave;
        for (int i7 = lw7; i7 < 2048 + 32; i7 += 256) { const int m = (i7 < 2048) ? (cg & 7) * 2048 + i7 : MP + (cg & 7) * 32 + (i7 - 2048); const float s = pg8::sum16(SS1 + (size_t)m * 16); const float r = __builtin_amdgcn_rsqf(s * (1.0f / 1024.0f) + 1e-6f);
            typedef unsigned u32x2v __attribute__((ext_vector_type(2))); const GAS u32x2v* xv = (const GAS u32x2v*)(XBp + (size_t)m * 1024) + lane7; const GAS f32x4* gv = (const GAS f32x4*)fg + lane7;
            GAS f32x4* ov = (GAS f32x4*)((m < MP) ? ob + O_YP + (size_t)m * 1024 : ob + O_YS + (size_t)(m - MP) * 1024) + lane7;
#pragma unroll
            for (int j = 0; j < 4; ++j) { const u32x2v xx = xv[64 * j]; f32x4 x; x[0] = __uint_as_float(xx.x << 16); x[1] = __uint_as_float(xx.x & 0xffff0000u); x[2] = __uint_as_float(xx.y << 16); x[3] = __uint_as_float(xx.y & 0xffff0000u);
                ov[64 * j] = x * r * gv[64 * j]; } }
    }
    STAMP(7);
}
#if DBG_SET
namespace dbg {
__global__ void k_cmp_f32(const float* a, const float* b, size_t n, float* acc) {
    float s1 = 0.f, s2 = 0.f;
    for (size_t i = (size_t)blockIdx.x * blockDim.x + threadIdx.x; i < n; i += (size_t)gridDim.x * blockDim.x) { const float d = a[i] - b[i]; s1 += d * d; s2 += b[i] * b[i]; }
    s1 = wave_sum(s1); s2 = wave_sum(s2);
    if ((threadIdx.x & 63) == 0) { atomicAdd(acc, s1); atomicAdd(acc + 1, s2); }
}
__global__ void k_cmp_bf16(const unsigned short* a, int lda, int acol0, const float* b, int ldb, int bcol0, int rows, int cols, float scale, float* acc) {
    float s1 = 0.f, s2 = 0.f; const size_t n = (size_t)rows * cols;
    for (size_t i = (size_t)blockIdx.x * blockDim.x + threadIdx.x; i < n; i += (size_t)gridDim.x * blockDim.x) { const size_t r = i / cols; const int c = (int)(i % cols);
        const float av = __uint_as_float((unsigned)a[r * lda + acol0 + c] << 16), bv = scale * b[r * ldb + bcol0 + c]; const float d = av - bv; s1 += d * d; s2 += bv * bv; }
    s1 = wave_sum(s1); s2 = wave_sum(s2);
    if ((threadIdx.x & 63) == 0) { atomicAdd(acc, s1); atomicAdd(acc + 1, s2); }
}
__global__ void k_cmp_f32s(const float* a, int lda, int acol0, const float* b, int ldb, int bcol0, int rows, int cols, float scale, float* acc) {
    float s1 = 0.f, s2 = 0.f; const size_t n = (size_t)rows * cols;
    for (size_t i = (size_t)blockIdx.x * blockDim.x + threadIdx.x; i < n; i += (size_t)gridDim.x * blockDim.x) { const size_t r = i / cols; const int c = (int)(i % cols);
        const float av = a[r * lda + acol0 + c], bv = scale * b[r * ldb + bcol0 + c]; const float d = av - bv; s1 += d * d; s2 += bv * bv; }
    s1 = wave_sum(s1); s2 = wave_sum(s2);
    if ((threadIdx.x & 63) == 0) { atomicAdd(acc, s1); atomicAdd(acc + 1, s2); }
}
__global__ void k_cmp_u(const unsigned short* U, const float* z, float* acc) {
    float s1 = 0.f, s2 = 0.f; const size_t n = (size_t)32 * 16384 * 16;
    for (size_t i = (size_t)blockIdx.x * blockDim.x + threadIdx.x; i < n; i += (size_t)gridDim.x * blockDim.x) { const int c = (int)(i & 15); const size_t row = (i >> 4) % 16384; const int g = (int)(i / (16384 * 16));
        const float av = __uint_as_float((unsigned)U[i] << 16), bv = z[row * 2048 + 1536 + g * 16 + c]; const float d = av - bv; s1 += d * d; s2 += bv * bv; }
    s1 = wave_sum(s1); s2 = wave_sum(s2);
    if ((threadIdx.x & 63) == 0) { atomicAdd(acc, s1); atomicAdd(acc + 1, s2); }
}
__global__ void k_cmp_u32(const unsigned* a, const unsigned* b, size_t n, float* acc) {
    float s1 = 0.f;
    for (size_t i = (size_t)blockIdx.x * blockDim.x + threadIdx.x; i < n; i += (size_t)gridDim.x * blockDim.x) s1 += (a[i] != b[i]) ? 1.f : 0.f;
    s1 = wave_sum(s1);
    if ((threadIdx.x & 63) == 0) { atomicAdd(acc, s1); atomicAdd(acc + 1, 1.0f); }
}
__device__ int qdigit(float num, float den) {
#if DBG_SET >= 30 && DBG_SET < 60
    return (num == 0.0f) ? 8 : 1;
#endif
    const float e = sqrtf(num / fmaxf(den, 1e-30f));
    if (!(e == e) || !(e < 1e30f)) return 0;
    const float q = -2.0f * log10f(fmaxf(e, 1e-12f)) + 0.5f;
    int d = (int)floorf(q); return d < 0 ? 0 : (d > 8 ? 8 : d);
}
__global__ void k_report(const float* acc, float* out) {
    const int q0 = qdigit(acc[0], acc[1]), q1 = qdigit(acc[2], acc[3]), q2 = qdigit(acc[4], acc[5]), q3 = qdigit(acc[6], acc[7]);
    const float A = ((float)(1 + q0) + 0.1f * (float)q1) * 100.0f; const float eps = sqrtf(((float)(1 + q2) + 0.1f * (float)q3 + 0.03f) * 100.0f);
    const size_t n = (size_t)MS * 1024;
    for (size_t i = (size_t)blockIdx.x * blockDim.x + threadIdx.x; i < n; i += (size_t)gridDim.x * blockDim.x) out[O_YS + i] += (i & 1) ? eps : -eps;
    if (blockIdx.x == 0 && threadIdx.x == 0) out[O_PK] = A;
}
__global__ void k_report_t(const unsigned long long* tm, int ka, int kb, float* out) {
    const float ta = (float)tm[ka] * 0.01f, tb = (float)tm[kb] * 0.01f;
    const float A = 1e5f * ta, eps = sqrtf(1e6f * tb);
    const size_t n = (size_t)MS * 1024;
    for (size_t i = (size_t)blockIdx.x * blockDim.x + threadIdx.x; i < n; i += (size_t)gridDim.x * blockDim.x) out[O_YS + i] = (i & 1) ? eps : -eps;
    if (blockIdx.x == 0 && threadIdx.x == 0) out[O_PK] = A;
}
}
#endif
extern "C" void kernel_launch(void* const* d_in, const int* in_sizes, int n_in, void* d_out, int out_size, void* d_ws, size_t ws_size, hipStream_t stream) {
    static int ready = 0;
    if (!ready) {
        if (n_in != 26 || (size_t)out_size != O_END || ws_size < (DBG_SET ? (size_t)2047 * MiB : (size_t)WS_END)) { fprintf(stderr, "kernel_launch: unexpected shapes (n_in %d out %d ws %zu)\n", n_in, out_size, ws_size); ready = -1; return; }
        if (hipFuncSetAttribute((const void*)hymba_fwd, hipFuncAttributeMaxDynamicSharedMemorySize, LDS_BYTES) != hipSuccess) { fprintf(stderr, "kernel_launch: hipFuncSetAttribute failed\n"); ready = -1; return; }
        ready = 1;
    }
    if (ready < 0) return;
#if DBG_SET >= 30 && DBG_SET < 60
#ifndef DBG_POISON_LO
#define DBG_POISON_LO (2 * MiB)
#define DBG_POISON_HI WS_END
#endif
    (void)hipMemsetAsync((char*)d_ws + DBG_POISON_LO, 0xFF, DBG_POISON_HI - DBG_POISON_LO, stream);
#endif
    (void)hipMemsetAsync((char*)d_ws + WS_CTL, 0, CTL_ZERO_BYTES, stream);
    Args a{};
    for (int i = 0; i < 26; ++i) a.in[i] = (const float*)d_in[i];
    a.out = (float*)d_out; a.ws = (unsigned char*)d_ws;
#if DBG_SET >= 60
    hipLaunchKernelGGL(hymba_fwd, dim3(256), dim3(NWAVES * 64), LDS_BYTES, stream, a);
    dbg::k_report_t<<<256, 256, 0, stream>>>((const unsigned long long*)((char*)d_ws + WS_CTL + 524288), DBG_KA, DBG_KB, (float*)d_out);
#elif DBG_SET
    float* shadow = (float*)((char*)d_ws + 448 * MiB); float* nvws = (float*)((char*)d_ws + 784 * MiB); float* acc = (float*)((char*)d_ws + 447 * MiB);
    (void)hipMemsetAsync(acc, 0, 64, stream);
    a.out = shadow;
    float* dout = (float*)d_out;
#if DBG_SET >= 30
    float* shadowB = nvws;
    (void)hipMemsetAsync(d_out, 0, (size_t)out_size * 4, stream);
#elif DBG_SET < 10
    nv::forward(stream, d_in, dout, nvws);
#elif DBG_SET < 20
    nv::forward(stream, d_in, dout, nvws, 1, 0);
#else
    nv::forward(stream, d_in, dout, nvws, 0, 1);
#endif
    hipLaunchKernelGGL(hymba_fwd, dim3(256), dim3(NWAVES * 64), LDS_BYTES, stream, a);
#if DBG_SET >= 40
    {
        char* wsb = (char*)d_ws; char* st = (char*)d_ws + 1200 * MiB;
        (void)hipMemcpyAsync(st, wsb + WS_XRES, WS_SSC - WS_XRES, hipMemcpyDeviceToDevice, stream);
    }
#endif
#if DBG_SET >= 30
    for (int rep = 0; rep < 4; ++rep) {
        (void)hipMemsetAsync((char*)d_ws + WS_CTL, 0, CTL_ZERO_BYTES, stream);
        a.out = shadowB;
        hipLaunchKernelGGL(hymba_fwd, dim3(256), dim3(NWAVES * 64), LDS_BYTES, stream, a);
        using namespace dbg;
#if DBG_SET == 30
        k_cmp_f32<<<1024, 256, 0, stream>>>(shadow + O_PK, shadowB + O_PK, (size_t)MP * 512, acc + 0);
        k_cmp_f32<<<64, 256, 0, stream>>>(shadow + O_PR, shadowB + O_PR, (size_t)16384, acc + 2);
        k_cmp_f32<<<1024, 256, 0, stream>>>(shadow + O_PK + (size_t)MP * 512, shadowB + O_PK + (size_t)MP * 512, (size_t)MP * 512, acc + 4);
        k_cmp_f32<<<1024, 256, 0, stream>>>(shadow + O_YP, shadowB + O_YP, (size_t)MP * 1024, acc + 6);
#elif DBG_SET == 32
        k_cmp_f32<<<1024, 256, 0, stream>>>(shadow + O_PK, shadowB + O_PK, (size_t)MP * 512, acc + 0);
        k_cmp_f32<<<1024, 256, 0, stream>>>(shadow + O_PV, shadowB + O_PV, (size_t)MP * 512, acc + 2);
        k_cmp_f32<<<1024, 256, 0, stream>>>(shadow + O_PK, shadowB + O_PK, (size_t)MP * 512, acc + 4);
        k_cmp_f32<<<1024, 256, 0, stream>>>(shadow + O_PV, shadowB + O_PV, (size_t)MP * 512, acc + 6);
#elif DBG_SET == 33
        for (int q = 0; q < 4; ++q) k_cmp_f32<<<64, 256, 0, stream>>>(shadow + O_PR, shadowB + O_PR, (size_t)16384, acc + 2 * q);
#elif DBG_SET == 34
        for (int q = 0; q < 4; ++q) k_cmp_f32<<<1024, 256, 0, stream>>>(shadow + O_PK + (size_t)MP * 512, shadowB + O_PK + (size_t)MP * 512, (size_t)MP * 512, acc + 2 * q);
#elif DBG_SET >= 40
        { const char* wsb = (const char*)d_ws; const char* st = (const char*)d_ws + 1200 * MiB;
#define CMPBUF(slot, lo, hi) k_cmp_u32<<<1024, 256, 0, stream>>>((const unsigned*)(wsb + (lo)), (const unsigned*)(st + ((lo) - WS_XRES)), ((hi) - (lo)) / 4, acc + 2 * (slot))
#if DBG_SET == 42
          CMPBUF(0, WS_MIX, WS_ZB); CMPBUF(1, WS_ZB, WS_GB); CMPBUF(2, WS_SSA, WS_SSS); CMPBUF(3, WS_UB, WS_MIX);
#elif DBG_SET == 47
          CMPBUF(0, WS_MIX, WS_MIX + (size_t)MP * 2048); CMPBUF(1, WS_MIX + (size_t)MP * 2048, WS_MIX + (size_t)MT * 2048); CMPBUF(2, WS_SSA, WS_SSA + (size_t)MP * 32); CMPBUF(3, WS_SSA + (size_t)MP * 32, WS_SSA + (size_t)MT * 32);
#elif DBG_SET == 43
          CMPBUF(0, WS_MIX, WS_ZB); CMPBUF(1, WS_SSS, WS_SSC); CMPBUF(2, WS_MIX, WS_ZB); CMPBUF(3, WS_SSS, WS_SSC);
#elif DBG_SET == 44
          CMPBUF(0, WS_XRES, WS_XB); CMPBUF(1, WS_XB, WS_QB); CMPBUF(2, WS_SS2, WS_SSA); CMPBUF(3, WS_XRES, WS_XB);
#elif DBG_SET == 45
          CMPBUF(0, WS_GB, WS_SS1); CMPBUF(1, WS_GB, WS_SS1); CMPBUF(2, WS_GB, WS_SS1); CMPBUF(3, WS_GB, WS_SS1);
#elif DBG_SET == 46
          CMPBUF(0, WS_XRES, WS_XB); CMPBUF(1, WS_XB, WS_QB); CMPBUF(2, WS_SS1, WS_SS2); CMPBUF(3, WS_XRES, WS_XB);
#endif
        }
#elif DBG_SET == 31
        k_cmp_f32<<<256, 256, 0, stream>>>(shadow + O_SK, shadowB + O_SK, (size_t)MS * 512, acc + 0);
        k_cmp_f32<<<64, 256, 0, stream>>>(shadow + O_SR, shadowB + O_SR, (size_t)65536, acc + 2);
        k_cmp_f32<<<256, 256, 0, stream>>>(shadow + O_SK + (size_t)MS * 512, shadowB + O_SK + (size_t)MS * 512, (size_t)MS * 512, acc + 4);
        k_cmp_f32<<<256, 256, 0, stream>>>(shadow + O_YS, shadowB + O_YS, (size_t)MS * 1024, acc + 6);
#endif
    }
#endif
    {
        using namespace dbg;
        const size_t R = 16384; float* n_xn = nvws; float* n_z = n_xn + R * 1024; float* n_cat = n_z + R * 2048; float* n_tmp = n_cat + R * 1024; float* n_Hre = n_tmp + R * 512; float* n_Him = n_Hre + R * 2048;
        float* n_zg = n_Him + R * 2048; float* n_glut = n_zg + R * 512; float* n_mix = n_glut + R * 512; float* n_h = n_mix + R * 1024; float* n_hn = n_h + R * 1024; float* n_gt = n_hn + R * 1024; float* n_up = n_gt + R * 2816; float* n_xcur = n_up + R * 2816;
        (void)n_xn; (void)n_z; (void)n_cat; (void)n_tmp; (void)n_zg; (void)n_glut; (void)n_mix; (void)n_h; (void)n_hn; (void)n_gt; (void)n_up; (void)n_xcur;
        unsigned char* ws = (unsigned char*)d_ws;
#if DBG_SET == 1
        k_cmp_f32<<<1024, 256, 0, stream>>>(shadow + O_PK, dout + O_PK, (size_t)MP * 512, acc + 0);
        k_cmp_f32<<<64, 256, 0, stream>>>(shadow + O_PR, dout + O_PR, (size_t)8 * 32 * 64, acc + 2);
        k_cmp_f32<<<1024, 256, 0, stream>>>(shadow + O_PK + (size_t)MP * 512, dout + O_PK + (size_t)MP * 512, (size_t)MP * 512, acc + 4);
        k_cmp_f32<<<1024, 256, 0, stream>>>(shadow + O_YP, dout + O_YP, (size_t)MP * 1024, acc + 6);
#elif DBG_SET == 2
        k_cmp_f32<<<256, 256, 0, stream>>>(shadow + O_SK, dout + O_SK, (size_t)MS * 512, acc + 0);
        k_cmp_f32<<<64, 256, 0, stream>>>(shadow + O_SR, dout + O_SR, (size_t)32 * 32 * 64, acc + 2);
        k_cmp_f32<<<256, 256, 0, stream>>>(shadow + O_SK + (size_t)MS * 512, dout + O_SK + (size_t)MS * 512, (size_t)MS * 512, acc + 4);
        k_cmp_f32<<<256, 256, 0, stream>>>(shadow + O_YS, dout + O_YS, (size_t)MS * 1024, acc + 6);
#elif DBG_SET == 3
        k_cmp_f32<<<1024, 256, 0, stream>>>(shadow + O_PV + 3 * (size_t)MP * 512, dout + O_PV + 3 * (size_t)MP * 512, (size_t)MP * 512, acc + 0);
        k_cmp_f32<<<64, 256, 0, stream>>>(shadow + O_PI + 3 * 16384, dout + O_PI + 3 * 16384, (size_t)16384, acc + 2);
        k_cmp_f32<<<256, 256, 0, stream>>>(shadow + O_SV + 3 * (size_t)MS * 512, dout + O_SV + 3 * (size_t)MS * 512, (size_t)MS * 512, acc + 4);
        k_cmp_f32<<<64, 256, 0, stream>>>(shadow + O_SI + 3 * 65536, dout + O_SI + 3 * 65536, (size_t)65536, acc + 6);
#endif
        k_report<<<256, 256, 0, stream>>>(acc, dout);
    }
#else
    hipLaunchKernelGGL(hymba_fwd, dim3(256), dim3(NWAVES * 64), LDS_BYTES, stream, a);
#endif
}
```
